# Optimizing an MI355X kernel written in HIP

```python
import math, functools
import jax, jax.numpy as jnp
from jax import lax
import numpy as np

D_MODEL = 1024
BATCH = 16
SEQ = 256
DEPTH = 2
DEC_BATCH = 8
DEC_SEQ = 2048
PAST_LEN = 512

GRID_W = 64
HEAD_DIM = 64
AXIS_DIM = HEAD_DIM // 2
A_HEADS = 4
A_VDIM = 2 * HEAD_DIM
CONV_DIM = 512
CONV_WIDTH = 3
C_HEADS = 16
C_KV_HEADS = 4
WINDOW = 128
Q_BLOCK = 128
D_FF = 2816
ROPE_BASE = 10000.0
N_MOD = 9
EPS = 1e-6
N_EVEN = (DEPTH + 1) // 2
N_ODD = DEPTH // 2
A_QK = A_HEADS * 2 * HEAD_DIM
A_V = A_HEADS * A_VDIM
EVEN_SPLITS = [A_QK, 2 * A_QK, 2 * A_QK + A_V, 2 * A_QK + A_V + CONV_DIM, 2 * A_QK + A_V + 2 * CONV_DIM]
EVEN_IN = 2 * A_QK + A_V + 3 * CONV_DIM
EVEN_OUT = A_V + CONV_DIM
ODD_IN = (C_HEADS + 2 * C_KV_HEADS) * HEAD_DIM
ODD_OUT = C_HEADS * HEAD_DIM

kernel_name = "hybrid_diff_conv_swa_prefix_dit_step"


def _rms_norm(x, g):
    xf = x.astype(jnp.float32)
    y = xf * lax.rsqrt(jnp.mean(xf * xf, axis=-1, keepdims=True) + EPS)
    return (y * g.astype(jnp.float32)).astype(x.dtype)


def _adaln(cvec, w, b):
    m = jax.nn.silu(cvec) @ w + b
    return m.reshape(cvec.shape[0], N_MOD, D_MODEL)


def _swiglu(h, w13, w2):
    gate, up = jnp.split(h @ w13, 2, axis=-1)
    return (jax.nn.silu(gate) * up) @ w2


def _axial_rope(n):
    rows = n // GRID_W
    row = jnp.repeat(jnp.arange(rows, dtype=jnp.float32), GRID_W)
    col = jnp.tile(jnp.arange(GRID_W, dtype=jnp.float32), rows)
    inv = ROPE_BASE ** (-jnp.arange(0, AXIS_DIM, 2, dtype=jnp.float32) / AXIS_DIM)
    ang_r = row[:, None] * inv[None, :]
    ang_c = col[:, None] * inv[None, :]
    ang = jnp.concatenate([ang_r, ang_r, ang_c, ang_c], axis=-1)
    return jnp.cos(ang), jnp.sin(ang)


def _rope(x, cos, sin):
    shape = (1, x.shape[1]) + (1,) * (x.ndim - 3) + (HEAD_DIM,)
    cos = cos.reshape(shape).astype(x.dtype)
    sin = sin.reshape(shape).astype(x.dtype)
    x1, x2, x3, x4 = jnp.split(x, 4, axis=-1)
    rot = jnp.concatenate([-x2, x1, -x4, x3], axis=-1)
    return x * cos + rot * sin


def _short_conv(u, w):
    up = jnp.pad(u, ((0, 0), (1, 1), (0, 0)))
    return w[0] * up[:, :-2] + w[1] * up[:, 1:-1] + w[2] * up[:, 2:]


def _query_blocks(q):
    b, s = q.shape[:2]
    nb = s // Q_BLOCK
    return jnp.moveaxis(q.reshape((b, nb, Q_BLOCK) + q.shape[2:]), 1, 0)


def _merge_blocks(o):
    nb, b = o.shape[:2]
    return jnp.moveaxis(o, 0, 1).reshape((b, nb * Q_BLOCK) + o.shape[3:])


def _diff_attention(q, k, v, lam):
    scale = HEAD_DIM ** -0.5

    def block(qi):
        s = jnp.einsum("bqhmd,bkhmd->bhmqk", qi, k, preferred_element_type=jnp.float32) * scale
        p = jax.nn.softmax(s, axis=-1)
        a = p[:, :, 0] - lam * p[:, :, 1]
        return jnp.einsum("bhqk,bkhe->bqhe", a.astype(v.dtype), v, preferred_element_type=jnp.float32).astype(v.dtype)

    return _merge_blocks(lax.map(block, _query_blocks(q)))


def _sink_column(sink, s):
    col = sink.astype(jnp.float32).reshape(1, C_KV_HEADS, -1, 1, 1)
    return jnp.broadcast_to(col, s.shape[:-1] + (1,))


def _dense_sink_attention(q, k, v, sink):
    b, s_len, h, dh = q.shape
    qg = q.reshape(b, s_len, C_KV_HEADS, h // C_KV_HEADS, dh)
    scale = HEAD_DIM ** -0.5

    def block(qi):
        s = jnp.einsum("bqgrd,btgd->bgrqt", qi, k, preferred_element_type=jnp.float32) * scale
        p = jax.nn.softmax(jnp.concatenate([s, _sink_column(sink, s)], axis=-1), axis=-1)[..., :-1]
        return jnp.einsum("bgrqt,btgd->bqgrd", p.astype(v.dtype), v, preferred_element_type=jnp.float32).astype(v.dtype)

    return _merge_blocks(lax.map(block, _query_blocks(qg))).reshape(b, s_len, h, dh)


def _window_sink_attention(q, k, v, k_ctx, v_ctx, sink):
    b, n, h, dh = q.shape
    p_len = k_ctx.shape[1]
    nb = n // Q_BLOCK
    qg = q.reshape(b, n, C_KV_HEADS, h // C_KV_HEADS, dh)
    pad = ((0, 0), (Q_BLOCK, Q_BLOCK), (0, 0), (0, 0))
    k_pad = jnp.pad(k, pad)
    v_pad = jnp.pad(v, pad)
    offs_q = jnp.arange(Q_BLOCK)
    offs_k = jnp.arange(3 * Q_BLOCK) - Q_BLOCK
    scale = HEAD_DIM ** -0.5

    def block(args):
        i, qi = args
        start = i * Q_BLOCK
        ks = lax.dynamic_slice_in_dim(k_pad, start, 3 * Q_BLOCK, axis=1)
        vs = lax.dynamic_slice_in_dim(v_pad, start, 3 * Q_BLOCK, axis=1)
        qpos = start + offs_q
        kpos = start + offs_k
        valid = (jnp.abs(qpos[:, None] - kpos[None, :]) <= WINDOW) & (kpos[None, :] >= 0) & (kpos[None, :] < n)
        s_c = jnp.einsum("bqgrd,bcgd->bgrqc", qi, k_ctx, preferred_element_type=jnp.float32) * scale
        s_l = jnp.einsum("bqgrd,bkgd->bgrqk", qi, ks, preferred_element_type=jnp.float32) * scale
        s_l = jnp.where(valid, s_l, -jnp.inf)
        p = jax.nn.softmax(jnp.concatenate([s_c, s_l, _sink_column(sink, s_c)], axis=-1), axis=-1)
        o = (jnp.einsum("bgrqc,bcgd->bqgrd", p[..., :p_len].astype(v.dtype), v_ctx, preferred_element_type=jnp.float32)
             + jnp.einsum("bgrqk,bkgd->bqgrd", p[..., p_len:-1].astype(v.dtype), vs, preferred_element_type=jnp.float32))
        return o.astype(v.dtype)

    o = lax.map(block, (jnp.arange(nb), _query_blocks(qg)))
    return _merge_blocks(o).reshape(b, n, h, dh)


def _even_mixer(h, w_in, w_out, qk_g, lam_vec, subln_g, conv_w, lam_init, rope=None, kv_ctx=None):
    b, s, _ = h.shape
    q, k, v, bg, cg, xin = jnp.split(h @ w_in, EVEN_SPLITS, axis=-1)
    q = _rms_norm(q.reshape(b, s, A_HEADS, 2, HEAD_DIM), qk_g[0])
    k = _rms_norm(k.reshape(b, s, A_HEADS, 2, HEAD_DIM), qk_g[1])
    v = v.reshape(b, s, A_HEADS, A_VDIM)
    lf = lam_vec.astype(jnp.float32)
    lam = jnp.exp(jnp.sum(lf[0] * lf[1])) - jnp.exp(jnp.sum(lf[2] * lf[3])) + lam_init
    if kv_ctx is None:
        aux = (k.reshape(b, s, A_HEADS, 2 * HEAD_DIM), v)
        o = _diff_attention(q, k, v, lam)
    else:
        cos, sin = rope
        k_ctx, v_ctx = kv_ctx
        k_all = jnp.concatenate([k_ctx.reshape(b, -1, A_HEADS, 2, HEAD_DIM).astype(k.dtype), _rope(k, cos, sin)], axis=1)
        v_all = jnp.concatenate([v_ctx.astype(v.dtype), v], axis=1)
        o = _diff_attention(_rope(q, cos, sin), k_all, v_all, lam)
        aux = None
    o = _rms_norm(o, subln_g) * (1.0 - lam_init)
    y = bg * _short_conv(cg * xin, conv_w)
    out = jnp.concatenate([o.reshape(b, s, A_V), y], axis=-1) @ w_out
    return out, aux


def _odd_mixer(h, w_in, w_out, qk_g, sink, rope=None, kv_ctx=None):
    b, s, _ = h.shape
    q, k, v = jnp.split(h @ w_in, [C_HEADS * HEAD_DIM, (C_HEADS + C_KV_HEADS) * HEAD_DIM], axis=-1)
    q = _rms_norm(q.reshape(b, s, C_HEADS, HEAD_DIM), qk_g[0])
    k = _rms_norm(k.reshape(b, s, C_KV_HEADS, HEAD_DIM), qk_g[1])
    v = v.reshape(b, s, C_KV_HEADS, HEAD_DIM)
    if kv_ctx is None:
        aux = (k, v)
        o = _dense_sink_attention(q, k, v, sink)
    else:
        cos, sin = rope
        k_ctx, v_ctx = kv_ctx
        o = _window_sink_attention(_rope(q, cos, sin), _rope(k, cos, sin), v,
                                   k_ctx.astype(k.dtype), v_ctx.astype(v.dtype), sink)
        aux = None
    return o.reshape(b, s, ODD_OUT) @ w_out, aux


def _layer(x, m, g, w13, w2, mixer):
    m = m[:, None]
    h = _rms_norm(x, g[0]) * (1 + m[:, :, 1]) + m[:, :, 0]
    x = x + 0.5 * m[:, :, 2] * _swiglu(h, w13[0], w2[0])
    h = _rms_norm(x, g[1]) * (1 + m[:, :, 4]) + m[:, :, 3]
    mix, aux = mixer(h)
    x = x + m[:, :, 5] * mix
    h = _rms_norm(x, g[2]) * (1 + m[:, :, 7]) + m[:, :, 6]
    x = x + 0.5 * m[:, :, 8] * _swiglu(h, w13[1], w2[1])
    return x, aux


def setup_inputs(seed: int = 0) -> dict:
    key = jax.random.key(seed)
    ks = jax.random.split(key, 24)

    def nrm(k, shape, s=1.0):
        return jax.random.normal(k, shape, jnp.float32) * s

    return {
        "x_prompt": nrm(ks[0], (BATCH, SEQ, D_MODEL)),
        "x_sample": nrm(ks[1], (DEC_BATCH, DEC_SEQ, D_MODEL)),
        "cache_even_k": nrm(ks[2], (DEC_BATCH, N_EVEN, PAST_LEN, A_HEADS, 2 * HEAD_DIM)),
        "cache_even_v": nrm(ks[3], (DEC_BATCH, N_EVEN, PAST_LEN, A_HEADS, A_VDIM)),
        "cache_odd_k": nrm(ks[4], (DEC_BATCH, N_ODD, PAST_LEN, C_KV_HEADS, HEAD_DIM)),
        "cache_odd_v": nrm(ks[5], (DEC_BATCH, N_ODD, PAST_LEN, C_KV_HEADS, HEAD_DIM)),
        "c": nrm(ks[6], (DEC_BATCH, D_MODEL)),
        "c_ctx": nrm(ks[7], (D_MODEL,)),
        "w_mod": nrm(ks[8], (DEPTH, D_MODEL, N_MOD * D_MODEL), 0.5 * D_MODEL ** -0.5),
        "b_mod": nrm(ks[9], (DEPTH, N_MOD * D_MODEL), 0.02),
        "norm_g": 1.0 + nrm(ks[10], (DEPTH, 3, D_MODEL), 0.02),
        "ffn_w13": nrm(ks[11], (DEPTH, 2, D_MODEL, 2 * D_FF), D_MODEL ** -0.5),
        "ffn_w2": nrm(ks[12], (DEPTH, 2, D_FF, D_MODEL), D_FF ** -0.5),
        "even_w_in": nrm(ks[13], (N_EVEN, D_MODEL, EVEN_IN), D_MODEL ** -0.5),
        "even_w_out": nrm(ks[14], (N_EVEN, EVEN_OUT, D_MODEL), EVEN_OUT ** -0.5),
        "even_qk_norm": 1.0 + nrm(ks[15], (N_EVEN, 2, HEAD_DIM), 0.02),
        "even_lambda": nrm(ks[16], (N_EVEN, 4, HEAD_DIM), 0.1),
        "even_subln": 1.0 + nrm(ks[17], (N_EVEN, A_VDIM), 0.02),
        "even_conv_w": nrm(ks[18], (N_EVEN, CONV_WIDTH, CONV_DIM), CONV_WIDTH ** -0.5),
        "odd_w_in": nrm(ks[19], (N_ODD, D_MODEL, ODD_IN), D_MODEL ** -0.5),
        "odd_w_out": nrm(ks[20], (N_ODD, ODD_OUT, D_MODEL), ODD_OUT ** -0.5),
        "odd_qk_norm": 1.0 + nrm(ks[21], (N_ODD, 2, HEAD_DIM), 0.02),
        "odd_sink": nrm(ks[22], (N_ODD, C_HEADS), 0.5),
    }


def reference(x_prompt, x_sample, cache_even_k, cache_even_v, cache_odd_k, cache_odd_v, c, c_ctx,
              w_mod, b_mod, norm_g, ffn_w13, ffn_w2,
              even_w_in, even_w_out, even_qk_norm, even_lambda, even_subln, even_conv_w,
              odd_w_in, odd_w_out, odd_qk_norm, odd_sink):
    rope = _axial_rope(x_sample.shape[1])
    yp, ys = x_prompt, x_sample
    even_k, even_v, odd_k, odd_v = [], [], [], []
    for l in range(DEPTH):
        m_ctx = _adaln(c_ctx[None, :], w_mod[l], b_mod[l])
        m_lat = _adaln(c, w_mod[l], b_mod[l])
        if l % 2 == 0:
            e = l // 2
            lam_init = 0.8 - 0.6 * math.exp(-0.3 * l)
            mix = functools.partial(_even_mixer, w_in=even_w_in[e], w_out=even_w_out[e], qk_g=even_qk_norm[e],
                                    lam_vec=even_lambda[e], subln_g=even_subln[e], conv_w=even_conv_w[e],
                                    lam_init=lam_init)
            yp, (kc, vc) = _layer(yp, m_ctx, norm_g[l], ffn_w13[l], ffn_w2[l], mix)
            ys, _ = _layer(ys, m_lat, norm_g[l], ffn_w13[l], ffn_w2[l],
                           functools.partial(mix, rope=rope, kv_ctx=(cache_even_k[:, e], cache_even_v[:, e])))
            even_k.append(kc)
            even_v.append(vc)
        else:
            o = l // 2
            mix = functools.partial(_odd_mixer, w_in=odd_w_in[o], w_out=odd_w_out[o], qk_g=odd_qk_norm[o],
                                    sink=odd_sink[o])
            yp, (kc, vc) = _layer(yp, m_ctx, norm_g[l], ffn_w13[l], ffn_w2[l], mix)
            ys, _ = _layer(ys, m_lat, norm_g[l], ffn_w13[l], ffn_w2[l],
                           functools.partial(mix, rope=rope, kv_ctx=(cache_odd_k[:, o], cache_odd_v[:, o])))
            odd_k.append(kc)
            odd_v.append(vc)
    return (yp, ys, jnp.stack(even_k, axis=1), jnp.stack(even_v, axis=1), jnp.stack(odd_k, axis=1), jnp.stack(odd_v, axis=1))
```

```cpp
#include <hip/hip_runtime.h>
#include <cstdio>
#include <cstdint>
#include <cmath>

__device__ const float ROPE_COS[64 * 16] = {
  1.000000000e+00f, 1.000000000e+00f, 1.000000000e+00f, 1.000000000e+00f, 1.000000000e+00f, 1.000000000e+00f, 1.000000000e+00f, 1.000000000e+00f, 1.000000000e+00f, 1.000000000e+00f, 1.000000000e+00f, 1.000000000e+00f, 1.000000000e+00f, 1.000000000e+00f, 1.000000000e+00f, 1.000000000e+00f,
  5.403023059e-01f, 8.460091103e-01f, 9.504152803e-01f, 9.842302345e-01f, 9.950041653e-01f, 9.984192778e-01f, 9.995000417e-01f, 9.998418903e-01f, 9.999500004e-01f, 9.999841887e-01f, 9.999950000e-01f, 9.999984189e-01f, 9.999995000e-01f, 9.999998419e-01f, 9.999999500e-01f, 9.999999842e-01f,
  -4.161468365e-01f, 4.314628294e-01f, 8.065784099e-01f, 9.374183089e-01f, 9.800665778e-01f, 9.936821085e-01f, 9.980006666e-01f, 9.993676111e-01f, 9.998000067e-01f, 9.999367551e-01f, 9.999800001e-01f, 9.999936755e-01f, 9.999980000e-01f, 9.999993675e-01f, 9.999998000e-01f, 9.999999368e-01f,
  -9.899924966e-01f, -1.159661415e-01f, 5.827536107e-01f, 8.610406494e-01f, 9.553364891e-01f, 9.858034685e-01f, 9.955033740e-01f, 9.985773125e-01f, 9.995500337e-01f, 9.998577009e-01f, 9.999550003e-01f, 9.999857698e-01f, 9.999955000e-01f, 9.999985770e-01f, 9.999995500e-01f, 9.999998577e-01f,
  -6.536436209e-01f, -6.276796538e-01f, 3.011374626e-01f, 7.575061717e-01f, 9.210609940e-01f, 9.748082656e-01f, 9.920106610e-01f, 9.974712444e-01f, 9.992001067e-01f, 9.997470285e-01f, 9.999200011e-01f, 9.999747019e-01f, 9.999920000e-01f, 9.999974702e-01f, 9.999992000e-01f, 9.999997470e-01f,
  2.836621855e-01f, -9.460792693e-01f, -1.034231891e-02f, 6.300803045e-01f, 8.775825619e-01f, 9.607312606e-01f, 9.875260200e-01f, 9.960497564e-01f, 9.987502604e-01f, 9.996047413e-01f, 9.998750026e-01f, 9.999604718e-01f, 9.999875000e-01f, 9.999960472e-01f, 9.999987500e-01f, 9.999996047e-01f,
  9.601702867e-01f, -9.731037080e-01f, -3.207964584e-01f, 4.827820000e-01f, 8.253356149e-01f, 9.436169571e-01f, 9.820539352e-01f, 9.943132982e-01f, 9.982005399e-01f, 9.994308440e-01f, 9.998200054e-01f, 9.999430795e-01f, 9.999820001e-01f, 9.999943079e-01f, 9.999982000e-01f, 9.999994308e-01f,
  7.539022543e-01f, -7.004299352e-01f, -5.994373930e-01f, 3.202569776e-01f, 7.648421873e-01f, 9.235194611e-01f, 9.755998784e-01f, 9.922624187e-01f, 9.975510003e-01f, 9.992253420e-01f, 9.997550100e-01f, 9.999225252e-01f, 9.999755001e-01f, 9.999922524e-01f, 9.999975500e-01f, 9.999992252e-01f,
  -1.455000338e-01f, -2.120365045e-01f, -8.186324573e-01f, 1.476312003e-01f, 6.967067093e-01f, 9.005023096e-01f, 9.681703030e-01f, 9.898977666e-01f, 9.968017063e-01f, 9.989882418e-01f, 9.996800171e-01f, 9.998988088e-01f, 9.999680002e-01f, 9.999898807e-01f, 9.999968000e-01f, 9.999989881e-01f,
  -9.111302619e-01f, 3.416603061e-01f, -9.566441996e-01f, -2.965079584e-02f, 6.216099683e-01f, 8.746382701e-01f, 9.597726380e-01f, 9.872200896e-01f, 9.959527330e-01f, 9.987195509e-01f, 9.995950273e-01f, 9.998719305e-01f, 9.999595003e-01f, 9.999871928e-01f, 9.999959500e-01f, 9.999987193e-01f,
  -8.390715291e-01f, 7.901319677e-01f, -9.997860729e-01f, -2.059976198e-01f, 5.403023059e-01f, 8.460091103e-01f, 9.504152803e-01f, 9.842302345e-01f, 9.950041653e-01f, 9.984192778e-01f, 9.995000417e-01f, 9.998418903e-01f, 9.999500004e-01f, 9.999841887e-01f, 9.999950000e-01f, 9.999984189e-01f,
  4.425697988e-03f, 9.952573799e-01f, -9.437797217e-01f, -3.758473754e-01f, 4.535961214e-01f, 8.147053397e-01f, 9.401075865e-01f, 9.809291466e-01f, 9.939560980e-01f, 9.980874320e-01f, 9.993950610e-01f, 9.998086883e-01f, 9.999395006e-01f, 9.999808683e-01f, 9.999939500e-01f, 9.999980868e-01f,
  8.438539587e-01f, 8.938616532e-01f, -7.941792645e-01f, -5.338430810e-01f, 3.623577545e-01f, 7.808259235e-01f, 9.288598634e-01f, 9.773178698e-01f, 9.928086359e-01f, 9.977240240e-01f, 9.992800864e-01f, 9.997723246e-01f, 9.999280009e-01f, 9.999772317e-01f, 9.999928000e-01f, 9.999977232e-01f,
  9.074467815e-01f, 5.171728240e-01f, -5.658204948e-01f, -6.750016262e-01f, 2.674988286e-01f, 7.444779696e-01f, 9.166833580e-01f, 9.733975461e-01f, 9.915618937e-01f, 9.973290652e-01f, 9.991551190e-01f, 9.997327994e-01f, 9.999155012e-01f, 9.999732789e-01f, 9.999915500e-01f, 9.999973279e-01f,
  1.367372182e-01f, -1.879581181e-02f, -2.813496238e-01f, -7.948709366e-01f, 1.699671429e-01f, 7.057763899e-01f, 9.035902455e-01f, 9.691694153e-01f, 9.902159962e-01f, 9.969025682e-01f, 9.990201601e-01f, 9.996901128e-01f, 9.999020016e-01f, 9.999690098e-01f, 9.999902000e-01f, 9.999969010e-01f,
  -7.596879129e-01f, -5.489756801e-01f, 3.102253171e-02f, -8.896703905e-01f, 7.073720167e-02f, 6.648435374e-01f, 8.895936181e-01f, 9.646348142e-01f, 9.887710779e-01f, 9.964445465e-01f, 9.988752109e-01f, 9.996442649e-01f, 9.998875021e-01f, 9.999644246e-01f, 9.999887500e-01f, 9.999964424e-01f,
  -9.576594803e-01f, -9.100810415e-01f, 3.403182001e-01f, -9.564100574e-01f, -2.919952230e-02f, 6.218088190e-01f, 8.747074712e-01f, 9.597951768e-01f, 9.872272834e-01f, 9.959550145e-01f, 9.987202730e-01f, 9.995952558e-01f, 9.998720027e-01f, 9.999595231e-01f, 9.999872000e-01f, 9.999959523e-01f,
  -2.751633381e-01f, -9.908980244e-01f, 6.158647034e-01f, -9.929849996e-01f, -1.288444943e-01f, 5.768082866e-01f, 8.589466897e-01f, 9.546520336e-01f, 9.855847669e-01f, 9.954339878e-01f, 9.985553480e-01f, 9.995430857e-01f, 9.998555035e-01f, 9.999543054e-01f, 9.999855500e-01f, 9.999954305e-01f,
  6.603167082e-01f, -7.665364704e-01f, 8.303362493e-01f, -9.982416606e-01f, -2.272020947e-01f, 5.299842069e-01f, 8.423270331e-01f, 9.492070108e-01f, 9.838436928e-01f, 9.948814827e-01f, 9.983804374e-01f, 9.994877548e-01f, 9.998380044e-01f, 9.999487715e-01f, 9.999838000e-01f, 9.999948771e-01f,
  9.887046182e-01f, -3.060956503e-01f, 9.624638147e-01f, -9.720142477e-01f, -3.232895669e-01f, 4.814846115e-01f, 8.248651197e-01f, 9.434618303e-01f, 9.820042351e-01f, 9.942975168e-01f, 9.981955429e-01f, 9.994292632e-01f, 9.998195054e-01f, 9.999429214e-01f, 9.999819501e-01f, 9.999942921e-01f,
  4.080820618e-01f, 2.486170528e-01f, 9.991443830e-01f, -9.151299613e-01f, -4.161468365e-01f, 4.314628294e-01f, 8.065784099e-01f, 9.374183089e-01f, 9.800665778e-01f, 9.936821085e-01f, 9.980006666e-01f, 9.993676111e-01f, 9.998000067e-01f, 9.999367551e-01f, 9.999800001e-01f, 9.999936755e-01f,
  -5.477292602e-01f, 7.267602337e-01f, 9.367403630e-01f, -8.293829050e-01f, -5.048461046e-01f, 3.800770014e-01f, 7.874851889e-01f, 9.310783576e-01f, 9.780309147e-01f, 9.930352774e-01f, 9.977958102e-01f, 9.993027988e-01f, 9.997795081e-01f, 9.999302726e-01f, 9.999779501e-01f, 9.999930272e-01f,
  -9.999608264e-01f, 9.810745045e-01f, 7.814403262e-01f, -7.174775009e-01f, -5.885011173e-01f, 3.274895812e-01f, 7.676045483e-01f, 9.244439812e-01f, 9.758974493e-01f, 9.923570438e-01f, 9.975809759e-01f, 9.992348264e-01f, 9.997580098e-01f, 9.999234739e-01f, 9.999758001e-01f, 9.999923473e-01f,
  -5.328330203e-01f, 9.332357037e-01f, 5.486452902e-01f, -5.829431928e-01f, -6.662760213e-01f, 2.738668208e-01f, 7.469563671e-01f, 9.175172776e-01f, 9.736663950e-01f, 9.916474291e-01f, 9.973561658e-01f, 9.991636942e-01f, 9.997355117e-01f, 9.999163589e-01f, 9.999735501e-01f, 9.999916358e-01f,
  4.241790073e-01f, 5.979773102e-01f, 2.614414084e-01f, -4.300231298e-01f, -7.373937155e-01f, 2.193782457e-01f, 7.255612918e-01f, 9.103004373e-01f, 9.713379749e-01f, 9.909064559e-01f, 9.971213821e-01f, 9.990894023e-01f, 9.997120138e-01f, 9.999089278e-01f, 9.999712001e-01f, 9.999908927e-01f,
  9.912028119e-01f, 7.855280068e-02f, -5.168947139e-02f, -2.635403389e-01f, -8.011436155e-01f, 1.641961185e-01f, 7.034407157e-01f, 9.027957423e-01f, 9.689124217e-01f, 9.901341476e-01f, 9.968766273e-01f, 9.990119510e-01f, 9.996875163e-01f, 9.999011805e-01f, 9.999687502e-01f, 9.999901179e-01f,
  6.469193223e-01f, -4.650645402e-01f, -3.596943353e-01f, -8.874560929e-02f, -8.568887534e-01f, 1.084948944e-01f, 6.806167575e-01f, 8.950055657e-01f, 9.663899781e-01f, 9.893305286e-01f, 9.966219036e-01f, 9.989313405e-01f, 9.996620190e-01f, 9.998931169e-01f, 9.999662002e-01f, 9.999893115e-01f,
  -2.921388087e-01f, -8.654504764e-01f, -6.320285135e-01f, 8.884811520e-02f, -9.040721420e-01f, 5.245066969e-02f, 6.571122393e-01f, 8.869323709e-01f, 9.637708964e-01f, 9.884956243e-01f, 9.963572138e-01f, 9.988475712e-01f, 9.996355221e-01f, 9.998847372e-01f, 9.999635502e-01f, 9.999884735e-01f,
  -9.626058663e-01f, -9.992934349e-01f, -8.416847784e-01f, 2.636396118e-01f, -9.422223407e-01f, -3.759374883e-03f, 6.329506635e-01f, 8.785787110e-01f, 9.610554383e-01f, 9.876294611e-01f, 9.960825604e-01f, 9.987606432e-01f, 9.996080256e-01f, 9.998760413e-01f, 9.999608003e-01f, 9.999876039e-01f,
  -7.480575297e-01f, -8.253722231e-01f, -9.678716355e-01f, 4.301160387e-01f, -9.709581651e-01f, -5.995753440e-02f, 6.081561899e-01f, 8.699472273e-01f, 9.582438755e-01f, 9.867320664e-01f, 9.957979462e-01f, 9.986705569e-01f, 9.995795295e-01f, 9.998670292e-01f, 9.999579503e-01f, 9.999867027e-01f,
  1.542514499e-01f, -3.972514054e-01f, -9.980752051e-01f, 5.830268074e-01f, -9.899924966e-01f, -1.159661415e-01f, 5.827536107e-01f, 8.610406494e-01f, 9.553364891e-01f, 9.858034685e-01f, 9.955033740e-01f, 9.985773125e-01f, 9.995500337e-01f, 9.998577009e-01f, 9.999550003e-01f, 9.999857698e-01f,
  9.147423578e-01f, 1.532156071e-01f, -9.293002159e-01f, 7.175491840e-01f, -9.991351503e-01f, -1.716081281e-01f, 5.567683265e-01f, 8.518617938e-01f, 9.523335699e-01f, 9.848436969e-01f, 9.951988468e-01f, 9.984809103e-01f, 9.995195385e-01f, 9.998480564e-01f, 9.999519504e-01f, 9.999848053e-01f,
  8.342233605e-01f, 6.564950042e-01f, -7.683670453e-01f, 8.294403958e-01f, -9.982947758e-01f, -2.267075851e-01f, 5.302263203e-01f, 8.424135629e-01f, 9.492354181e-01f, 9.838527819e-01f, 9.948843676e-01f, 9.983813507e-01f, 9.994880437e-01f, 9.998380958e-01f, 9.999488004e-01f, 9.999838092e-01f,
  -1.327674722e-02f, 9.575859018e-01f, -5.312353455e-01f, 9.151714465e-01f, -9.874797699e-01f, -2.810903188e-01f, 5.031541321e-01f, 8.326989444e-01f, 9.460423435e-01f, 9.828307548e-01f, 9.945599395e-01f, 9.982786339e-01f, 9.994555494e-01f, 9.998278189e-01f, 9.999455505e-01f, 9.999827814e-01f,
  -8.485702748e-01f, 9.637577894e-01f, -2.414213342e-01f, 9.720384190e-01f, -9.667981926e-01f, -3.345844009e-01f, 4.755788316e-01f, 8.227210104e-01f, 9.427546655e-01f, 9.817776480e-01f, 9.942255659e-01f, 9.981727603e-01f, 9.994220557e-01f, 9.998172259e-01f, 9.999422006e-01f, 9.999817221e-01f,
  -9.036922051e-01f, 6.731098380e-01f, 7.233429552e-02f, 9.982477555e-01f, -9.364566873e-01f, -3.870207132e-01f, 4.475279919e-01f, 8.124829160e-01f, 9.393727128e-01f, 9.806934947e-01f, 9.938812501e-01f, 9.980637301e-01f, 9.993875625e-01f, 9.998063167e-01f, 9.999387506e-01f, 9.999806311e-01f,
  -1.279636896e-01f, 1.751563210e-01f, 3.789165737e-01f, 9.929728260e-01f, -8.967584163e-01f, -4.382334809e-01f, 4.190296615e-01f, 8.019878987e-01f, 9.358968237e-01f, 9.795783292e-01f, 9.935269954e-01f, 9.979515438e-01f, 9.993520700e-01f, 9.997950914e-01f, 9.999352007e-01f, 9.999795085e-01f,
  7.654140519e-01f, -3.767421515e-01f, 6.479219076e-01f, 9.563799991e-01f, -8.481000317e-01f, -4.880607978e-01f, 3.901123364e-01f, 7.912392773e-01f, 9.323273456e-01f, 9.784321869e-01f, 9.931628054e-01f, 9.978362017e-01f, 9.993155781e-01f, 9.997835499e-01f, 9.999315508e-01f, 9.999783543e-01f,
  9.550736440e-01f, -8.126109057e-01f, 8.526731891e-01f, 8.896233956e-01f, -7.909677119e-01f, -5.363451377e-01f, 3.608049314e-01f, 7.802404506e-01f, 9.286646356e-01f, 9.772551038e-01f, 9.927886839e-01f, 9.977177042e-01f, 9.992780869e-01f, 9.997716922e-01f, 9.999278009e-01f, 9.999771684e-01f,
  2.666429324e-01f, -9.982103072e-01f, 9.728653484e-01f, 7.948084874e-01f, -7.259323042e-01f, -5.829338522e-01f, 3.311367516e-01f, 7.689948967e-01f, 9.249090599e-01f, 9.760471174e-01f, 9.924046345e-01f, 9.975960516e-01f, 9.992395964e-01f, 9.997595184e-01f, 9.999239510e-01f, 9.999759510e-01f,
  -6.669380617e-01f, -8.763791221e-01f, 9.965789963e-01f, 6.749256921e-01f, -6.536436209e-01f, -6.276796538e-01f, 3.011374626e-01f, 7.575061717e-01f, 9.210609940e-01f, 9.748082656e-01f, 9.920106610e-01f, 9.974712444e-01f, 9.992001067e-01f, 9.997470285e-01f, 9.999200011e-01f, 9.999747019e-01f,
  -9.873392775e-01f, -4.846391354e-01f, 9.214624639e-01f, 5.337560571e-01f, -5.748239465e-01f, -6.704410810e-01f, 2.708370612e-01f, 7.457779085e-01f, 9.171208228e-01f, 9.735385879e-01f, 9.916067674e-01f, 9.973432828e-01f, 9.991596177e-01f, 9.997342223e-01f, 9.999159512e-01f, 9.999734212e-01f,
  -3.999853150e-01f, 5.636087450e-02f, 7.549650153e-01f, 3.757520063e-01f, -4.902608213e-01f, -7.110829460e-01f, 2.402658454e-01f, 7.338138159e-01f, 9.130889403e-01f, 9.722381242e-01f, 9.911929578e-01f, 9.972121674e-01f, 9.991181296e-01f, 9.997211001e-01f, 9.999118013e-01f, 9.999721088e-01f,
  5.551133015e-01f, 5.800027620e-01f, 5.135981094e-01f, 2.058969135e-01f, -4.007991721e-01f, -7.494767618e-01f, 2.094543837e-01f, 7.216176770e-01f, 9.089657497e-01f, 9.709069157e-01f, 9.907692362e-01f, 9.970778985e-01f, 9.990756424e-01f, 9.997076617e-01f, 9.999075514e-01f, 9.999707649e-01f,
  9.998433086e-01f, 9.250143668e-01f, 2.212979668e-01f, 2.954792850e-02f, -3.073328700e-01f, -7.855011484e-01f, 1.784334851e-01f, 7.091933487e-01f, 9.047516632e-01f, 9.695450046e-01f, 9.903356070e-01f, 9.969404766e-01f, 9.990321562e-01f, 9.996939071e-01f, 9.999032016e-01f, 9.999693893e-01f,
  5.253219888e-01f, 9.851384009e-01f, -9.294817111e-02f, -1.477329843e-01f, -2.107957994e-01f, -8.190422169e-01f, 1.472341679e-01f, 6.965447596e-01f, 9.004471024e-01f, 9.681524338e-01f, 9.898920744e-01f, 9.967999021e-01f, 9.989876708e-01f, 9.996798365e-01f, 9.998987517e-01f, 9.999679821e-01f,
  -4.321779449e-01f, 7.418577573e-01f, -3.979766910e-01f, -3.203544680e-01f, -1.121525269e-01f, -8.499939289e-01f, 1.158876288e-01f, 6.836759095e-01f, 8.960524975e-01f, 9.667292474e-01f, 9.894386429e-01f, 9.966561754e-01f, 9.989421865e-01f, 9.996654497e-01f, 9.998942019e-01f, 9.999665433e-01f,
  -9.923354692e-01f, 2.700984415e-01f, -6.635380855e-01f, -4.828721220e-01f, -1.238866346e-02f, -8.782584324e-01f, 8.442521171e-02f, 6.705908678e-01f, 8.915682882e-01f, 9.652754904e-01f, 9.889753170e-01f, 9.965092971e-01f, 9.988957033e-01f, 9.996507468e-01f, 9.998895520e-01f, 9.999650728e-01f,
  -6.401443395e-01f, -2.848462729e-01f, -8.632967800e-01f, -6.301602158e-01f, 8.749898344e-02f, -9.037463706e-01f, 5.287837645e-02f, 6.572937723e-01f, 8.869949228e-01f, 9.637912089e-01f, 9.885021014e-01f, 9.963592674e-01f, 9.988482212e-01f, 9.996357277e-01f, 9.998848022e-01f, 9.999635708e-01f,
  3.005925437e-01f, -7.520635254e-01f, -9.774428167e-01f, -7.575733518e-01f, 1.865123694e-01f, -9.263771649e-01f, 2.127866722e-02f, 6.437888276e-01f, 8.823328586e-01f, 9.622764496e-01f, 9.880190008e-01f, 9.962060871e-01f, 9.987997402e-01f, 9.996203926e-01f, 9.998799524e-01f, 9.999620371e-01f,
  9.649660285e-01f, -9.876589150e-01f, -9.946563971e-01f, -8.610929796e-01f, 2.836621855e-01f, -9.460792693e-01f, -1.034231891e-02f, 6.300803045e-01f, 8.775825619e-01f, 9.607312606e-01f, 9.875260200e-01f, 9.960497564e-01f, 9.987502604e-01f, 9.996047413e-01f, 9.998750026e-01f, 9.999604718e-01f,
  7.421541968e-01f, -9.190733545e-01f, -9.132304601e-01f, -9.374541386e-01f, 3.779777427e-01f, -9.627903967e-01f, -4.195296357e-02f, 6.161725377e-01f, 8.727445076e-01f, 9.591556907e-01f, 9.870231639e-01f, 9.958902760e-01f, 9.986997819e-01f, 9.995887740e-01f, 9.998699528e-01f, 9.999588749e-01f,
  -1.629907808e-01f, -5.674299469e-01f, -7.412399703e-01f, -9.842484337e-01f, 4.685166713e-01f, -9.764577158e-01f, -7.352165877e-02f, 6.020699252e-01f, 8.678191797e-01f, 9.575497897e-01f, 9.865104376e-01f, 9.957276462e-01f, 9.986483046e-01f, 9.995724905e-01f, 9.998648030e-01f, 9.999572463e-01f,
  -9.182827862e-01f, -4.102845452e-02f, -4.957411282e-01f, -9.999999947e-01f, 5.543743362e-01f, -9.870380181e-01f, -1.050168384e-01f, 5.877769265e-01f, 8.628070705e-01f, 9.559136084e-01f, 9.859878462e-01f, 9.955618678e-01f, 9.985958287e-01f, 9.995558910e-01f, 9.998595533e-01f, 9.999555861e-01f,
  -8.293098329e-01f, 4.980090543e-01f, -2.010799162e-01f, -9.842120249e-01f, 6.346928759e-01f, -9.944978545e-01f, -1.364070100e-01f, 5.732980613e-01f, 8.577086814e-01f, 9.542471985e-01f, 9.854553950e-01f, 9.953929410e-01f, 9.985423543e-01f, 9.995389753e-01f, 9.998542035e-01f, 9.999538943e-01f,
  2.212675626e-02f, 8.836688484e-01f, 1.135222784e-01f, -9.373824693e-01f, 7.086697743e-01f, -9.988136413e-01f, -1.676607860e-01f, 5.586379081e-01f, 8.525245221e-01f, 9.525506128e-01f, 9.849130892e-01f, 9.952208666e-01f, 9.984878812e-01f, 9.995217436e-01f, 9.998487538e-01f, 9.999521709e-01f,
  8.532201077e-01f, 9.971747381e-01f, 4.168665323e-01f, -8.609883102e-01f, 7.755658785e-01f, -9.999717342e-01f, -1.987469151e-01f, 5.438011027e-01f, 8.472551110e-01f, 9.508239048e-01f, 9.843609343e-01f, 9.950456450e-01f, 9.984324097e-01f, 9.995041958e-01f, 9.998432041e-01f, 9.999504159e-01f,
  8.998668270e-01f, 8.035689776e-01f, 6.788703658e-01f, -7.574389836e-01f, 8.347127848e-01f, -9.979684721e-01f, -2.296343139e-01f, 5.287923369e-01f, 8.419009752e-01f, 9.490671292e-01f, 9.837989357e-01f, 9.948672768e-01f, 9.983759398e-01f, 9.994863320e-01f, 9.998375544e-01f, 9.999486292e-01f,
  1.191801354e-01f, 3.624786135e-01f, 8.735510056e-01f, -6.300003866e-01f, 8.855195169e-01f, -9.928101881e-01f, -2.602920974e-01f, 5.136163566e-01f, 8.364626499e-01f, 9.472803416e-01f, 9.832270992e-01f, 9.946857625e-01f, 9.983184715e-01f, 9.994681520e-01f, 9.998318047e-01f, 9.999468110e-01f,
  -7.710802230e-01f, -1.902485591e-01f, 9.816020819e-01f, -4.826918728e-01f, 9.274784307e-01f, -9.845131900e-01f, -2.906896106e-01f, 4.982779609e-01f, 8.309406791e-01f, 9.454635984e-01f, 9.826454305e-01f, 9.945011028e-01f, 9.982600048e-01f, 9.994496561e-01f, 9.998259550e-01f, 9.999449611e-01f,
  -9.524129804e-01f, -6.843826418e-01f, 9.923082299e-01f, -3.201594838e-01f, 9.601702867e-01f, -9.731037080e-01f, -3.207964584e-01f, 4.827820000e-01f, 8.253356149e-01f, 9.436169571e-01f, 9.820539352e-01f, 9.943132982e-01f, 9.982005399e-01f, 9.994308440e-01f, 9.998200054e-01f, 9.999430795e-01f,
  -2.581016359e-01f, -9.677393408e-01f, 9.046077269e-01f, -1.475294147e-01f, 9.832684384e-01f, -9.586178129e-01f, -3.505825365e-01f, 4.671333740e-01f, 8.196480178e-01f, 9.417404761e-01f, 9.814526195e-01f, 9.941223493e-01f, 9.981400768e-01f, 9.994117159e-01f, 9.998139558e-01f, 9.999411664e-01f,
  6.735071623e-01f, -9.530499555e-01f, 7.271977827e-01f, 2.975366287e-02f, 9.965420970e-01f, -9.411013007e-01f, -3.800180612e-01f, 4.513370314e-01f, 8.138784567e-01f, 9.398342148e-01f, 9.808414892e-01f, 9.939282566e-01f, 9.980786156e-01f, 9.993922718e-01f, 9.998078062e-01f, 9.999392216e-01f,
  9.858965816e-01f, -6.448385490e-01f, 4.776720420e-01f, 2.060983239e-01f, 9.998586364e-01f, -9.206095492e-01f, -4.090735996e-01f, 4.353979673e-01f, 8.080275083e-01f, 9.378982333e-01f, 9.802205506e-01f, 9.937310210e-01f, 9.980161563e-01f, 9.993725116e-01f, 9.998015566e-01f, 9.999372453e-01f,
};
__device__ const float ROPE_SIN[64 * 16] = {
  0.000000000e+00f, 0.000000000e+00f, 0.000000000e+00f, 0.000000000e+00f, 0.000000000e+00f, 0.000000000e+00f, 0.000000000e+00f, 0.000000000e+00f, 0.000000000e+00f, 0.000000000e+00f, 0.000000000e+00f, 0.000000000e+00f, 0.000000000e+00f, 0.000000000e+00f, 0.000000000e+00f, 0.000000000e+00f,
  8.414709848e-01f, 5.331684399e-01f, 3.109835929e-01f, 1.768921862e-01f, 9.983341665e-02f, 5.620449921e-02f, 3.161750640e-02f, 1.778185688e-02f, 9.999833334e-03f, 5.623383614e-03f, 3.162272390e-03f, 1.778278473e-03f, 9.999998333e-04f, 5.623412956e-04f, 3.162277607e-04f, 1.778279401e-04f,
  9.092974268e-01f, 9.021307150e-01f, 5.911271172e-01f, 3.482052759e-01f, 1.986693308e-01f, 1.122313110e-01f, 6.320339793e-02f, 3.555809079e-02f, 1.999866669e-02f, 1.124658940e-02f, 6.324513157e-03f, 3.556551322e-03f, 1.999998667e-03f, 1.124682413e-03f, 6.324554899e-04f, 3.556558745e-04f,
  1.411200081e-01f, 9.932531671e-01f, 8.126488966e-01f, 5.085361344e-01f, 2.955202067e-01f, 1.679033098e-01f, 9.472609133e-02f, 5.332308054e-02f, 2.999550020e-02f, 1.686943954e-02f, 9.486690679e-03f, 5.334812925e-03f, 2.999995500e-03f, 1.687023175e-03f, 9.486831557e-04f, 5.334837977e-04f,
  -7.568024953e-01f, 7.784717415e-01f, 9.535807405e-01f, 6.528280017e-01f, 3.894183423e-01f, 2.230444916e-01f, 1.261540665e-01f, 7.107120850e-02f, 3.998933419e-02f, 2.249175622e-02f, 1.264877333e-02f, 7.113057657e-03f, 3.999989333e-03f, 2.249363404e-03f, 1.264910727e-03f, 7.113117040e-04f,
  -9.589242747e-01f, 3.239352036e-01f, 9.999465168e-01f, 7.765299800e-01f, 4.794255386e-01f, 2.774805306e-01f, 1.574558982e-01f, 8.879686236e-02f, 4.997916927e-02f, 2.811336166e-02f, 1.581072950e-02f, 8.891279896e-03f, 4.999979167e-03f, 2.811702921e-03f, 1.581138171e-03f, 8.891395879e-04f,
  -2.794154982e-01f, -2.303674747e-01f, 9.471481575e-01f, 8.757405669e-01f, 5.646424734e-01f, 3.310393303e-01f, 1.886002871e-01f, 1.064944369e-01f, 5.996400648e-02f, 3.373407807e-02f, 1.897252756e-02f, 1.066947402e-02f, 5.999964000e-03f, 3.374041549e-03f, 1.897365458e-03f, 1.066967444e-03f,
  6.569865987e-01f, -7.137211682e-01f, 8.004216463e-01f, 9.473307069e-01f, 6.442176872e-01f, 3.835515676e-01f, 2.195560914e-01f, 1.241583359e-01f, 6.994284734e-02f, 3.935372772e-02f, 2.213413590e-02f, 1.244763440e-02f, 6.999942833e-03f, 3.936379111e-03f, 2.213592554e-03f, 1.244795266e-03f,
  9.893582466e-01f, -9.772617463e-01f, 5.743177691e-01f, 9.890424807e-01f, 7.173560909e-01f, 4.348512280e-01f, 2.502923579e-01f, 1.417829736e-01f, 7.991469397e-02f, 4.497213290e-02f, 2.529552289e-02f, 1.422575542e-02f, 7.999914667e-03f, 4.498715427e-03f, 2.529819430e-03f, 1.422623048e-03f,
  4.121184852e-01f, -9.398235128e-01f, 2.912591207e-01f, 9.995603185e-01f, 7.833269096e-01f, 4.847761303e-01f, 2.807783529e-01f, 1.593627767e-01f, 8.987854920e-02f, 5.058911594e-02f, 2.845665693e-02f, 1.600383145e-02f, 8.999878500e-03f, 5.061050321e-03f, 2.846046052e-03f, 1.600450786e-03f,
  -5.440211109e-01f, -6.129367615e-01f, -2.068353153e-02f, 9.785524925e-01f, 8.414709848e-01f, 5.331684399e-01f, 3.109835929e-01f, 1.768921862e-01f, 9.983341665e-02f, 5.620449921e-02f, 3.161750640e-02f, 1.778185688e-02f, 9.999833334e-03f, 5.623383614e-03f, 3.162272390e-03f, 1.778278473e-03f,
  -9.999902066e-01f, -9.727665569e-02f, -3.305750095e-01f, 9.266815798e-01f, 8.912073601e-01f, 5.798751671e-01f, 3.408778753e-01f, 1.943656590e-01f, 1.097783008e-01f, 6.181810515e-02f, 3.477803970e-02f, 1.955982607e-02f, 1.099977817e-02f, 6.185715129e-03f, 3.478498411e-03f, 1.956106104e-03f,
  -5.365729180e-01f, 4.483428876e-01f, -6.076835491e-01f, 8.455835647e-01f, 9.320390860e-01f, 6.247486512e-01f, 3.704313082e-01f, 2.117776696e-01f, 1.197122073e-01f, 6.742975624e-02f, 3.793822522e-02f, 2.133773341e-02f, 1.199971200e-02f, 6.748044688e-03f, 3.794724085e-03f, 2.133933673e-03f,
  4.201670368e-01f, 8.558809906e-01f, -8.245284517e-01f, 7.378162404e-01f, 9.635581854e-01f, 6.676470271e-01f, 3.996143406e-01f, 2.291227120e-01f, 1.296341426e-01f, 7.303927501e-02f, 4.109803135e-02f, 2.311557328e-02f, 1.299963384e-02f, 7.310372113e-03f, 4.110949379e-03f, 2.311761174e-03f,
  9.906073557e-01f, 9.998233431e-01f, -9.596053299e-01f, 6.067785379e-01f, 9.854497300e-01f, 7.084346741e-01f, 4.283977921e-01f, 2.463953013e-01f, 1.395431146e-01f, 7.864648408e-02f, 4.425742651e-02f, 2.489334005e-02f, 1.399954267e-02f, 7.872697226e-03f, 4.427174262e-03f, 2.489588602e-03f,
  6.502878402e-01f, 8.358383233e-01f, -9.995186854e-01f, 4.566033249e-01f, 9.974949866e-01f, 7.469826442e-01f, 4.567528814e-01f, 2.635899757e-01f, 1.494381325e-01f, 8.425120614e-02f, 4.741637909e-02f, 2.667102809e-02f, 1.499943751e-02f, 8.435019850e-03f, 4.743398702e-03f, 2.667415952e-03f,
  -2.879033167e-01f, 4.144303293e-01f, -9.403103332e-01f, 2.920270571e-01f, 9.995736030e-01f, 7.831690702e-01f, 4.846512559e-01f, 2.807012978e-01f, 1.593182066e-01f, 8.985326395e-02f, 5.057485751e-02f, 2.844863180e-02f, 1.599931734e-02f, 8.997339806e-03f, 5.059622668e-03f, 2.845243217e-03f,
  -9.613974919e-01f, -1.346146549e-01f, -7.878519322e-01f, 1.182403929e-01f, 9.916648105e-01f, 8.168795508e-01f, 5.120650195e-01f, 2.977238566e-01f, 1.691823491e-01f, 9.545248036e-02f, 5.373283018e-02f, 3.022614554e-02f, 1.699918118e-02f, 9.559656917e-03f, 5.375846129e-03f, 3.023070392e-03f,
  -7.509872468e-01f, -6.422007782e-01f, -5.572626967e-01f, -5.927551787e-02f, 9.738476309e-01f, 8.480075120e-01f, 5.389667608e-01f, 3.146522694e-01f, 1.790295734e-01f, 1.010486783e-01f, 5.689026552e-02f, 3.200356370e-02f, 1.799902802e-02f, 1.012197101e-02f, 5.692069051e-03f, 3.200897472e-03f,
  1.498772097e-01f, -9.520007631e-01f, -2.714100320e-01f, -2.349219066e-01f, 9.463000877e-01f, 8.764545447e-01f, 5.653295802e-01f, 3.314811830e-01f, 1.888588950e-01f, 1.066416808e-01f, 6.004713196e-02f, 3.378088066e-02f, 1.899885685e-02f, 1.068428189e-02f, 6.008291404e-03f, 3.378724451e-03f,
  9.129452507e-01f, -9.686018589e-01f, 4.135821352e-02f, -4.031589686e-01f, 9.092974268e-01f, 9.021307150e-01f, 5.911271172e-01f, 3.482052759e-01f, 1.986693308e-01f, 1.122313110e-01f, 6.320339793e-02f, 3.555809079e-02f, 1.999866669e-02f, 1.124658940e-02f, 6.324513157e-03f, 3.556551322e-03f,
  8.366556385e-01f, -6.868912307e-01f, 3.500249882e-01f, -5.586805857e-01f, 8.632093666e-01f, 9.249548492e-01f, 6.163335763e-01f, 3.648192595e-01f, 2.084598998e-01f, 1.178173922e-01f, 6.635903187e-02f, 3.733518848e-02f, 2.099845653e-02f, 1.180889335e-02f, 6.640734277e-03f, 3.734378081e-03f,
  -8.851309290e-03f, -1.936306189e-01f, 6.239799809e-01f, -6.965816792e-01f, 8.084964038e-01f, 9.448547900e-01f, 6.409237532e-01f, 3.813178801e-01f, 2.182296231e-01f, 1.233997476e-01f, 6.951400222e-02f, 3.911216810e-02f, 2.199822538e-02f, 1.237119357e-02f, 6.956954733e-03f, 3.912204722e-03f,
  -8.462204042e-01f, 3.592646954e-01f, 8.360552287e-01f, -8.125129131e-01f, 7.457052122e-01f, 9.617676250e-01f, 6.648730598e-01f, 3.976959206e-01f, 2.279775235e-01f, 1.289782009e-01f, 7.266827742e-02f, 4.088902404e-02f, 2.299797222e-02f, 1.293348988e-02f, 7.273174493e-03f, 4.090031240e-03f,
  -9.055783620e-01f, 8.015130295e-01f, 9.652193481e-01f, -9.028178708e-01f, 6.754631806e-01f, 9.756398851e-01f, 6.881575487e-01f, 4.139482019e-01f, 2.377026264e-01f, 1.345525755e-01f, 7.582182595e-02f, 4.266575068e-02f, 2.399769607e-02f, 1.349578209e-02f, 7.589393526e-03f, 4.267857628e-03f,
  -1.323517501e-01f, 9.969099546e-01f, 9.986632058e-01f, -9.646483762e-01f, 5.984721441e-01f, 9.864277139e-01f, 7.107539373e-01f, 4.300695848e-01f, 2.474039593e-01f, 1.401226951e-01f, 7.897461625e-02f, 4.444234239e-02f, 2.499739591e-02f, 1.405807004e-02f, 7.905611800e-03f, 4.445683881e-03f,
  7.625584505e-01f, 8.852767779e-01f, 9.330701931e-01f, -9.960543242e-01f, 5.155013718e-01f, 9.940970063e-01f, 7.326396313e-01f, 4.460549713e-01f, 2.570805519e-01f, 1.456883837e-01f, 8.212661682e-02f, 4.621879357e-02f, 2.599707077e-02f, 1.462035354e-02f, 8.221829283e-03f, 4.623509993e-03f,
  9.563759284e-01f, 5.009944839e-01f, 7.749451323e-01f, -9.960451859e-01f, 4.273798802e-01f, 9.986235163e-01f, 7.537927467e-01f, 4.618993065e-01f, 2.667314367e-01f, 1.512494653e-01f, 8.527779611e-02f, 4.799509859e-02f, 2.699671962e-02f, 1.518263242e-02f, 8.538045944e-03f, 4.801335960e-03f,
  2.709057883e-01f, -3.758498280e-02f, 5.399691971e-01f, -9.646212496e-01f, 3.349881502e-01f, 9.999929335e-01f, 7.741921322e-01f, 4.775975802e-01f, 2.763556486e-01f, 1.568057639e-01f, 8.842812263e-02f, 4.977125184e-02f, 2.799634148e-02f, 1.574490650e-02f, 8.854261752e-03f, 4.979161774e-03f,
  -6.636338842e-01f, -5.645889596e-01f, 2.514448194e-01f, -9.027736113e-01f, 2.392493292e-01f, 9.982009287e-01f, 7.938173900e-01f, 4.931448283e-01f, 2.859522251e-01f, 1.623571039e-01f, 9.157756487e-02f, 5.154724769e-02f, 2.899593534e-02f, 1.630717560e-02f, 9.170476674e-03f, 5.156987431e-03f,
  -9.880316241e-01f, -9.177098239e-01f, -6.201520023e-02f, -8.124529167e-01f, 1.411200081e-01f, 9.932531671e-01f, 8.126488966e-01f, 5.085361344e-01f, 2.955202067e-01f, 1.679033098e-01f, 9.472609133e-02f, 5.332308054e-02f, 2.999550020e-02f, 1.686943954e-02f, 9.486690679e-03f, 5.334812925e-03f,
  -4.040376453e-01f, -9.881927837e-01f, -3.693252072e-01f, -6.965078381e-01f, 4.158066243e-02f, 9.851652909e-01f, 8.306678221e-01f, 5.237666315e-01f, 3.050586364e-01f, 1.734442061e-01f, 9.787367054e-02f, 5.509874477e-02f, 3.099503507e-02f, 1.743169815e-02f, 9.802903735e-03f, 5.512638250e-03f,
  5.514266812e-01f, -7.543303715e-01f, -6.400094403e-01f, -5.585952289e-01f, -5.837414343e-02f, 9.739628693e-01f, 8.478561489e-01f, 5.388315034e-01f, 3.145665606e-01f, 1.789796176e-01f, 1.010202710e-01f, 5.687423476e-02f, 3.199453895e-02f, 1.799395124e-02f, 1.011911581e-02f, 5.690463401e-03f,
  9.999118601e-01f, -2.881479492e-01f, -8.472242960e-01f, -4.030647882e-01f, -1.577456941e-01f, 9.596813183e-01f, 8.641966902e-01f, 5.537259863e-01f, 3.240430284e-01f, 1.845093693e-01f, 1.041658613e-01f, 5.864954490e-02f, 3.299401083e-02f, 1.855619865e-02f, 1.043532687e-02f, 5.868288372e-03f,
  5.290826861e-01f, 2.667787912e-01f, -9.704203931e-01f, -2.348218730e-01f, -2.555411020e-01f, 9.423657881e-01f, 8.796731069e-01f, 5.684453703e-01f, 3.334870921e-01f, 1.900332863e-01f, 1.073104099e-01f, 6.042466957e-02f, 3.399344971e-02f, 1.911844019e-02f, 1.075153690e-02f, 6.046113157e-03f,
  -4.281826695e-01f, 7.395425248e-01f, -9.973804438e-01f, -5.917278607e-02f, -3.507832277e-01f, 9.220710209e-01f, 8.942699237e-01f, 5.829850008e-01f, 3.428978075e-01f, 1.955511940e-01f, 1.104538854e-01f, 6.219960316e-02f, 3.499285460e-02f, 1.968067568e-02f, 1.106774584e-02f, 6.223937751e-03f,
  -9.917788534e-01f, 9.845406356e-01f, -9.254308349e-01f, 1.183425828e-01f, -4.425204433e-01f, 8.988611774e-01f, 9.079725452e-01f, 5.973402802e-01f, 3.522742333e-01f, 2.010629178e-01f, 1.135962563e-01f, 6.397434006e-02f, 3.599222450e-02f, 2.024290495e-02f, 1.138395368e-02f, 6.401762149e-03f,
  -6.435381334e-01f, 9.263181696e-01f, -7.617067688e-01f, 2.921254821e-01f, -5.298361409e-01f, 8.728096342e-01f, 9.207672697e-01f, 6.115066689e-01f, 3.616154320e-01f, 2.065682834e-01f, 1.167374914e-01f, 6.574887465e-02f, 3.699155841e-02f, 2.080512781e-02f, 1.170016038e-02f, 6.579586343e-03f,
  2.963685787e-01f, 5.828065854e-01f, -5.224446694e-01f, 4.566948806e-01f, -6.118578909e-01f, 8.439987519e-01f, 9.326413038e-01f, 6.254796874e-01f, 3.709204694e-01f, 2.120671168e-01f, 1.198775590e-01f, 6.752320133e-02f, 3.799085533e-02f, 2.136734410e-02f, 1.201636591e-02f, 6.757410330e-03f,
  9.637953863e-01f, 5.980119189e-02f, -2.313720250e-01f, 6.068603368e-01f, -6.877661592e-01f, 8.125196145e-01f, 9.435827742e-01f, 6.392549170e-01f, 3.801884151e-01f, 2.175592441e-01f, 1.230164278e-01f, 6.929731449e-02f, 3.899011425e-02f, 2.192955363e-02f, 1.233257024e-02f, 6.935234103e-03f,
  7.451131605e-01f, -4.816218791e-01f, 8.264565347e-02f, 7.378857026e-01f, -7.568024953e-01f, 7.784717415e-01f, 9.535807405e-01f, 6.528280017e-01f, 3.894183423e-01f, 2.230444916e-01f, 1.261540665e-01f, 7.107120850e-02f, 3.998933419e-02f, 2.249175622e-02f, 1.264877333e-02f, 7.113057657e-03f,
  -1.586226688e-01f, -8.747141867e-01f, 3.884674088e-01f, 8.456384993e-01f, -8.182771111e-01f, 7.419627733e-01f, 9.626252055e-01f, 6.661946496e-01f, 3.986093280e-01f, 2.285226858e-01f, 1.292904437e-01f, 7.284487777e-02f, 4.098851413e-02f, 2.305395171e-02f, 1.296497516e-02f, 7.290880986e-03f,
  -9.165215479e-01f, -9.984104626e-01f, 6.557650689e-01f, 9.267202543e-01f, -8.715757724e-01f, 7.031081310e-01f, 9.707071255e-01f, 6.793506338e-01f, 4.077604531e-01f, 2.339936535e-01f, 1.324255279e-01f, 7.461831668e-02f, 4.198765309e-02f, 2.361613990e-02f, 1.328117570e-02f, 7.468704084e-03f,
  -8.317747426e-01f, -8.146145076e-01f, 8.580308748e-01f, 9.785736871e-01f, -9.161659367e-01f, 6.620306515e-01f, 9.778184193e-01f, 6.922917941e-01f, 4.168708024e-01f, 2.394572216e-01f, 1.355592879e-01f, 7.639151963e-02f, 4.298675006e-02f, 2.417832062e-02f, 1.359737490e-02f, 7.646526947e-03f,
  1.770192511e-02f, -3.799321270e-01f, 9.752062397e-01f, 9.995633646e-01f, -9.516020739e-01f, 6.188601989e-01f, 9.839519762e-01f, 7.050140383e-01f, 4.259394651e-01f, 2.449132175e-01f, 1.386916923e-01f, 7.816448100e-02f, 4.398580404e-02f, 2.474049370e-02f, 1.391357275e-02f, 7.824349567e-03f,
  8.509035245e-01f, 1.717624261e-01f, 9.956709484e-01f, 9.890272824e-01f, -9.775301177e-01f, 5.737332542e-01f, 9.891016630e-01f, 7.175133434e-01f, 4.349655341e-01f, 2.503614686e-01f, 1.418227098e-01f, 7.993719520e-02f, 4.498481404e-02f, 2.530265896e-02f, 1.422976920e-02f, 8.002171940e-03f,
  9.017883476e-01f, 6.705572816e-01f, 9.173955273e-01f, 9.472977435e-01f, -9.936910036e-01f, 5.267924836e-01f, 9.932623307e-01f, 7.297857568e-01f, 4.439481070e-01f, 2.558018026e-01f, 1.449523091e-01f, 8.170965662e-02f, 4.598377905e-02f, 2.586481621e-02f, 1.454596424e-02f, 8.179994060e-03f,
  1.235731227e-01f, 9.628327123e-01f, 7.481425059e-01f, 8.756908780e-01f, -9.999232576e-01f, 4.781862879e-01f, 9.964298187e-01f, 7.418273977e-01f, 4.528862854e-01f, 2.612340474e-01f, 1.480804588e-01f, 8.348185965e-02f, 4.698269808e-02f, 2.642696529e-02f, 1.486215781e-02f, 8.357815921e-03f,
  -7.682546613e-01f, 9.585732110e-01f, 5.046966116e-01f, 7.764651328e-01f, -9.961646088e-01f, 4.280683329e-01f, 9.986009600e-01f, 7.536344584e-01f, 4.617791755e-01f, 2.666580314e-01f, 1.512071278e-01f, 8.525379868e-02f, 4.798157012e-02f, 2.698910600e-02f, 1.517834990e-02f, 8.535637518e-03f,
  -9.537526528e-01f, 6.590906264e-01f, 2.112002371e-01f, 6.527500415e-01f, -9.824526126e-01f, 3.765970636e-01f, 9.997735835e-01f, 7.652032053e-01f, 4.706258882e-01f, 2.720735828e-01f, 1.543322846e-01f, 8.702546812e-02f, 4.898039419e-02f, 2.755123819e-02f, 1.549454048e-02f, 8.713458845e-03f,
  -2.623748537e-01f, 1.566201379e-01f, -1.032407464e-01f, 5.084475199e-01f, -9.589242747e-01f, 3.239352036e-01f, 9.999465168e-01f, 7.765299800e-01f, 4.794255386e-01f, 2.774805306e-01f, 1.574558982e-01f, 8.879686236e-02f, 4.997916927e-02f, 2.811336166e-02f, 1.581072950e-02f, 8.891279896e-03f,
  6.702291758e-01f, -3.940864994e-01f, -4.074434030e-01f, 3.481088020e-01f, -9.258146823e-01f, 2.702492405e-01f, 9.991195869e-01f, 7.876112009e-01f, 4.881772469e-01f, 2.828787037e-01f, 1.605779372e-01f, 9.056797580e-02f, 5.097789438e-02f, 2.867547624e-02f, 1.612691694e-02f, 9.069100666e-03f,
  9.866275920e-01f, -8.234216753e-01f, -6.712401257e-01f, 1.767908958e-01f, -8.834546557e-01f, 2.157088994e-01f, 9.972936206e-01f, 7.984433638e-01f, 4.968801378e-01f, 2.882679314e-01f, 1.636983704e-01f, 9.233880284e-02f, 5.197656850e-02f, 2.923758175e-02f, 1.644310277e-02f, 9.246921150e-03f,
  3.959251502e-01f, -9.991579785e-01f, -8.684703414e-01f, -1.029124367e-04f, -8.322674422e-01f, 1.604866066e-01f, 9.944704438e-01f, 8.090230434e-01f, 5.055333412e-01f, 2.936480433e-01f, 1.668171666e-01f, 9.410933788e-02f, 5.297519065e-02f, 2.979967802e-02f, 1.675928696e-02f, 9.424741341e-03f,
  -5.587890489e-01f, -8.671718295e-01f, -9.795748401e-01f, -1.769934748e-01f, -7.727644876e-01f, 1.047569444e-01f, 9.906528795e-01f, 8.193468942e-01f, 5.141359917e-01f, 2.990188692e-01f, 1.699342947e-01f, 9.587957531e-02f, 5.397375983e-02f, 3.036176486e-02f, 1.707546947e-02f, 9.602561234e-03f,
  -9.997551734e-01f, -4.681125574e-01f, -9.935354510e-01f, -3.483017460e-01f, -7.055403256e-01f, 4.869609889e-02f, 9.858447448e-01f, 8.294116515e-01f, 5.226872289e-01f, 3.043802394e-01f, 1.730497234e-01f, 9.764950955e-02f, 5.497227503e-02f, 3.092384210e-02f, 1.739165027e-02f, 9.780380823e-03f,
  -5.215510021e-01f, 7.511685313e-02f, -9.089677080e-01f, -5.086247435e-01f, -6.312666379e-01f, -7.518696635e-03f, 9.800508475e-01f, 8.392141328e-01f, 5.311861979e-01f, 3.097319842e-01f, 1.761634216e-01f, 9.941913500e-02f, 5.597073526e-02f, 3.148590956e-02f, 1.770782933e-02f, 9.958200103e-03f,
  4.361647552e-01f, 5.952116415e-01f, -7.342581470e-01f, -6.529059551e-01f, -5.506855426e-01f, -6.370972221e-02f, 9.732769811e-01f, 8.487512383e-01f, 5.396320487e-01f, 3.150739345e-01f, 1.792753582e-01f, 1.011884461e-01f, 5.696913951e-02f, 3.204796707e-02f, 1.802400663e-02f, 1.013601907e-02f,
  9.928726481e-01f, 9.319920894e-01f, -4.867326171e-01f, -7.765948190e-01f, -4.646021794e-01f, -1.196993330e-01f, 9.655299188e-01f, 8.580199521e-01f, 5.480239368e-01f, 3.204059213e-01f, 1.823855020e-01f, 1.029574371e-01f, 5.796748680e-02f, 3.261001444e-02f, 1.834018212e-02f, 1.031383771e-02f,
  6.367380071e-01f, 9.817359552e-01f, -1.909380864e-01f, -8.757902465e-01f, -3.738766648e-01f, -1.753105211e-01f, 9.568174070e-01f, 8.670173434e-01f, 5.563610229e-01f, 3.257277760e-01f, 1.854938220e-01f, 1.047261026e-01f, 5.896577612e-02f, 3.317205150e-02f, 1.865635577e-02f, 1.049165603e-02f,
  -3.048106211e-01f, 7.291230346e-01f, 1.237916674e-01f, -9.473636604e-01f, -2.794154982e-01f, -2.303674747e-01f, 9.471481575e-01f, 8.757405669e-01f, 5.646424734e-01f, 3.310393303e-01f, 1.886002871e-01f, 1.064944369e-01f, 5.996400648e-02f, 3.373407807e-02f, 1.897252756e-02f, 1.066947402e-02f,
  -9.661177700e-01f, 2.519535043e-01f, 4.262450708e-01f, -9.890576686e-01f, -1.821625043e-01f, -2.846961343e-01f, 9.365318388e-01f, 8.841868642e-01f, 5.728674601e-01f, 3.363404163e-01f, 1.917048661e-01f, 1.082624345e-01f, 6.096217687e-02f, 3.429609397e-02f, 1.928869745e-02f, 1.084729167e-02f,
  -7.391806966e-01f, -3.028131145e-01f, 6.864279895e-01f, -9.995572618e-01f, -8.308940282e-02f, -3.381247429e-01f, 9.249790663e-01f, 8.923535645e-01f, 5.810351605e-01f, 3.416308663e-01f, 1.948075281e-01f, 1.100300897e-01f, 6.196028630e-02f, 3.485809903e-02f, 1.960486542e-02f, 1.102510897e-02f,
  1.673557003e-01f, -7.643188115e-01f, 8.785382293e-01f, -9.785312876e-01f, 1.681390048e-02f, -3.904843889e-01f, 9.125013918e-01f, 9.002380852e-01f, 5.891447579e-01f, 3.469105129e-01f, 1.979082420e-01f, 1.117973969e-01f, 6.295833377e-02f, 3.542009306e-02f, 1.992103142e-02f, 1.120292593e-02f,
};

namespace pg8 {
#define PG8_LAS __attribute__((address_space(3)))
typedef unsigned short bf16_t;
typedef short bf16x8 __attribute__((ext_vector_type(8)));
typedef float f32x4 __attribute__((ext_vector_type(4)));
typedef unsigned u32x4 __attribute__((ext_vector_type(4)));
constexpr int BM = 256, BK = 64, HALF = 128, HTB = HALF * BK * 2  , STAGE_BYTES = 8 * HTB, NXCD = 8, WGM = 8;

__host__ __device__ __forceinline__ int lds_byte(int r, int c) { const int st = (r >> 4) * 2 + (c >> 5), rr = r & 15, cc = c & 31, ob = rr * 64 + cc * 2; return st * 1024 + (ob ^ (((ob >> 9) & 1) << 5)); }
__host__ __device__ __forceinline__ void stage_rc(int b, int& R, int& C) { const int st = b / 1024, sb = b % 1024, swz = sb ^ (((sb >> 9) & 1) << 5); R = (st >> 1) * 16 + swz / 64; C = (st & 1) * 32 + (swz % 64) / 2; }
__host__ __device__ __forceinline__ int perm32(int rho) { const int n = rho >> 4, i = rho & 15; return 8 * (i >> 2) + 4 * n + (i & 3); }

struct Unit { int pm, pn; };
struct Gemm { const bf16_t* A; const bf16_t* Bt; int M, N, K; };

struct StaticOrder {
    int nM, nN, nwg, G, c;
    __host__ __device__ void init(int M, int N, int G_, int c_) { nM = M / BM; nN = N / BM; nwg = nM * nN; G = G_; c = c_; }
    __host__ __device__ bool next(int i, Unit& u) const {
        const long L = (long)i * G + c; if (L >= nwg) return false;
        int wgid = (int)L; { const int q = nwg / NXCD, r = nwg % NXCD, xcd = wgid % NXCD, off = wgid / NXCD; wgid = (xcd < r ? xcd * (q + 1) : r * (q + 1) + (xcd - r) * q) + off; }
        const int nig = WGM * nN, gid = wgid / nig, fm = gid * WGM, gsz = (nM - fm) < WGM ? (nM - fm) : WGM;
        u.pm = fm + ((wgid % nig) % gsz); u.pn = (wgid % nig) / gsz; return true;
    }
    __device__ __forceinline__ void a_ready(const Unit&) const {}
    __device__ __forceinline__ void done(const Unit&) const {}
};

__device__ __forceinline__ unsigned cvt_pk_bf16(float lo, float hi) { unsigned r; asm volatile("v_cvt_pk_bf16_f32 %0, %1, %2" : "=v"(r) : "v"(lo), "v"(hi)); return r; }
typedef float f32x2 __attribute__((ext_vector_type(2)));

__device__ __forceinline__ int opaque_tid() { int t = threadIdx.x; asm volatile("" : "+v"(t)); return t; }
#define EPI_FENCE() asm volatile("" ::: "memory")
constexpr int MOD_STRIDE = 9 * 1024;
__device__ __forceinline__ int cond_of_panel(int pm) { return pm < 16 ? 8 : ((pm - 16) >> 3); }
__device__ __forceinline__ float fast_silu(float g) { return g * __builtin_amdgcn_rcpf(1.0f + __builtin_amdgcn_exp2f(-1.4426950408889634f * g)); }

struct EpiSwiGLU {
    static constexpr bool PERM = true, AFTER_DRAIN = false;
    bf16_t* H; int ldh;
    __device__ __forceinline__ void operator()(const f32x4 (&acc)[2][2][4][2], const Unit& u, int wr, int wc, int fr, int fq) const {
        const int row0 = u.pm * BM + wr * 64 + fr, col0 = u.pn * HALF + wc * 32 + 8 * fq;
#pragma unroll
        for (int ai = 0; ai < 2; ++ai)
#pragma unroll
            for (int m = 0; m < 4; ++m) {
                bf16_t* rowp = H + (size_t)(row0 + ai * HALF + m * 16) * ldh + col0;
                const f32x4 g0 = acc[ai][0][m][0], g1 = acc[ai][0][m][1], u0 = acc[ai][1][m][0], u1 = acc[ai][1][m][1];
                u32x4 w;
                w.x = cvt_pk_bf16(fast_silu(g0[0]) * u0[0], fast_silu(g0[1]) * u0[1]);
                w.y = cvt_pk_bf16(fast_silu(g0[2]) * u0[2], fast_silu(g0[3]) * u0[3]);
                w.z = cvt_pk_bf16(fast_silu(g1[0]) * u1[0], fast_silu(g1[1]) * u1[1]);
                w.w = cvt_pk_bf16(fast_silu(g1[2]) * u1[2], fast_silu(g1[3]) * u1[3]);
                *(u32x4*)rowp = w;
            }
    }
};

struct EpiResid {
    static constexpr bool PERM = false, AFTER_DRAIN = false;
    const float* xinP; const float* xinS; float* out; const float* gate; float gs;
    __device__ __forceinline__ void operator()(const f32x4 (&acc)[2][2][4][2], const Unit& u, int wr, int wc, int fr, int fq) const {
        const int col0 = u.pn * BM + wc * 32 + 4 * fq;
        const float* gp = gate + (size_t)cond_of_panel(u.pm) * MOD_STRIDE + col0;
        const float* xb = (u.pm < 16) ? xinP + (size_t)u.pm * BM * 1024 : xinS + (size_t)(u.pm - 16) * BM * 1024;
        float* ob = out + (size_t)u.pm * BM * 1024;
        f32x4 gv[2][2];
#pragma unroll
        for (int bj = 0; bj < 2; ++bj)
#pragma unroll
            for (int n = 0; n < 2; ++n) gv[bj][n] = *(const f32x4*)(gp + bj * HALF + n * 16) * gs;
#pragma unroll
        for (int ai = 0; ai < 2; ++ai)
#pragma unroll
            for (int m = 0; m < 4; ++m) {
                EPI_FENCE();
                const size_t off = (size_t)(ai * HALF + wr * 64 + m * 16 + fr) * 1024 + col0;
#pragma unroll
                for (int bj = 0; bj < 2; ++bj)
#pragma unroll
                    for (int n = 0; n < 2; ++n) {
                        const f32x4 xv = *(const f32x4*)(xb + off + bj * HALF + n * 16);
                        *(f32x4*)(ob + off + bj * HALF + n * 16) = xv + gv[bj][n] * acc[ai][bj][m][n];
                    }
            }
    }
};

typedef unsigned u32x2 __attribute__((ext_vector_type(2)));
__device__ __forceinline__ void store_bf16x4(bf16_t* p, f32x4 v) { u32x2 w; w.x = cvt_pk_bf16(v[0], v[1]); w.y = cvt_pk_bf16(v[2], v[3]); *(u32x2*)p = w; }

__device__ __forceinline__ void plain_tile(const f32x4 (&acc)[2][2][4][2], int pm, int wr, int wc, int fr, int fq, bf16_t* dst, int dpitch, int dcol0, float* fdst, int fpitch, int fcol0) {
    const int row0 = pm * BM + wr * 64 + fr, c0 = wc * 32 + 4 * fq;
#pragma unroll
    for (int ai = 0; ai < 2; ++ai)
#pragma unroll
        for (int m = 0; m < 4; ++m) {
            EPI_FENCE();
            int row = row0 + ai * HALF + m * 16; asm volatile("" : "+v"(row));
#pragma unroll
            for (int bj = 0; bj < 2; ++bj)
#pragma unroll
                for (int n = 0; n < 2; ++n) {
                    const int c = c0 + bj * HALF + n * 16;
                    store_bf16x4(dst + (size_t)row * dpitch + dcol0 + c, acc[ai][bj][m][n]);
                    if (fdst) *(f32x4*)(fdst + (size_t)row * fpitch + fcol0 + c) = acc[ai][bj][m][n];
                }
        }
}
__device__ __forceinline__ void prod_tile(const f32x4 (&acc)[2][2][4][2], int pm, int wr, int wc, int fr, int fq, bf16_t* dst, int dpitch, int dcol0) {
    const int row0 = pm * BM + wr * 64 + fr, c0 = wc * 32 + 4 * fq;
#pragma unroll
    for (int ai = 0; ai < 2; ++ai)
#pragma unroll
        for (int m = 0; m < 4; ++m) {
            const int row = row0 + ai * HALF + m * 16;
#pragma unroll
            for (int n = 0; n < 2; ++n) store_bf16x4(dst + (size_t)row * dpitch + dcol0 + c0 + n * 16, acc[ai][0][m][n] * acc[ai][1][m][n]);
        }
}
__device__ __forceinline__ void head_tile(const f32x4 (&acc)[2][2][4][2], int pm, int wr, int wc, int fr, int fq, const float* gq, bool rope, float outscale,
                                          bf16_t* dst, int dpitch, int dcol, float* fdst, int fpitch, int fcol, const float* rcos, const float* rsin) {
#pragma unroll
    for (int ai = 0; ai < 2; ++ai)
#pragma unroll
        for (int m = 0; m < 4; ++m) {
            EPI_FENCE();
            int row = pm * BM + ai * HALF + wr * 64 + m * 16 + fr; asm volatile("" : "+v"(row));
            f32x4 gv[2][2];
#pragma unroll
            for (int bj = 0; bj < 2; ++bj)
#pragma unroll
                for (int n = 0; n < 2; ++n) gv[bj][n] = *(const f32x4*)(gq + 32 * bj + 16 * n + 4 * fq);
            f32x4 v[2][2]; float ss = 0.f;
#pragma unroll
            for (int bj = 0; bj < 2; ++bj)
#pragma unroll
                for (int n = 0; n < 2; ++n) { v[bj][n] = acc[ai][bj][m][n]; const f32x4 q = v[bj][n] * v[bj][n]; ss += (q[0] + q[1]) + (q[2] + q[3]); }
            ss += __shfl_xor(ss, 16); ss += __shfl_xor(ss, 32);
            const float r = 1.0f / sqrtf(ss * (1.0f / 64.0f) + 1e-6f);
#pragma unroll
            for (int bj = 0; bj < 2; ++bj)
#pragma unroll
                for (int n = 0; n < 2; ++n) v[bj][n] = v[bj][n] * r * gv[bj][n];
            if (fdst) {
#pragma unroll
                for (int bj = 0; bj < 2; ++bj)
#pragma unroll
                    for (int n = 0; n < 2; ++n) *(f32x4*)(fdst + (size_t)row * fpitch + fcol + 32 * bj + 16 * n + 4 * fq) = v[bj][n];
            }
            if (rope) {
                const int pos = (row - 4096) & 2047;
#pragma unroll
                for (int bj = 0; bj < 2; ++bj) {
                    const int p = bj == 0 ? (pos >> 6) : (pos & 63);
                    const f32x4 cs = *(const f32x4*)(rcos + p * 16 + 4 * fq), sn = *(const f32x4*)(rsin + p * 16 + 4 * fq);
                    const f32x4 a = v[bj][0], b = v[bj][1];
                    v[bj][0] = a * cs - b * sn; v[bj][1] = b * cs + a * sn;
                }
            }
#pragma unroll
            for (int bj = 0; bj < 2; ++bj)
#pragma unroll
                for (int n = 0; n < 2; ++n) store_bf16x4(dst + (size_t)row * dpitch + dcol + 32 * bj + 16 * n + 4 * fq, v[bj][n] * outscale);
        }
}
constexpr float QSCALE = 0.125f * 1.4426950408889634f;

struct EpiQKVEven {
    static constexpr bool PERM = false, AFTER_DRAIN = false;
    bf16_t *Q, *K, *V, *BG, *U;
    float *newk, *newv;
    const float* qkg;
    const float *rcos, *rsin;
    __device__ __forceinline__ void operator()(const f32x4 (&acc)[2][2][4][2], const Unit& u, int wr, int wc, int fr, int fq) const {
        const int pn = u.pn; const bool sample = u.pm >= 16;
        if (pn < 2)      head_tile(acc, u.pm, wr, wc, fr, fq, qkg, sample, QSCALE, Q, 512, 64 * (4 * pn + wc), nullptr, 0, 0, rcos, rsin);
        else if (pn < 4) head_tile(acc, u.pm, wr, wc, fr, fq, qkg + 64, sample, 1.0f, K, 512, 64 * (4 * (pn - 2) + wc), sample ? nullptr : newk, 512, 64 * (4 * (pn - 2) + wc), rcos, rsin);
        else if (pn < 6) plain_tile(acc, u.pm, wr, wc, fr, fq, V, 512, 256 * (pn - 4), sample ? nullptr : newv, 512, 256 * (pn - 4));
        else if (pn < 8) plain_tile(acc, u.pm, wr, wc, fr, fq, BG, 512, 256 * (pn - 6), nullptr, 0, 0);
        else             prod_tile(acc, u.pm, wr, wc, fr, fq, U, 512, 128 * (pn - 8));
    }
};
struct EpiQKVOdd {
    static constexpr bool PERM = false, AFTER_DRAIN = false;
    bf16_t *Q, *K, *V;
    float *newk, *newv;
    const float* qkg; const float *rcos, *rsin;
    __device__ __forceinline__ void operator()(const f32x4 (&acc)[2][2][4][2], const Unit& u, int wr, int wc, int fr, int fq) const {
        const int pn = u.pn; const bool sample = u.pm >= 16;
        if (pn < 4)       head_tile(acc, u.pm, wr, wc, fr, fq, qkg, sample, QSCALE, Q, 1024, 64 * (4 * pn + wc), nullptr, 0, 0, rcos, rsin);
        else if (pn == 4) head_tile(acc, u.pm, wr, wc, fr, fq, qkg + 64, sample, 1.0f, K, 256, 64 * wc, sample ? nullptr : newk, 256, 64 * wc, rcos, rsin);
        else              plain_tile(acc, u.pm, wr, wc, fr, fq, V, 256, 0, sample ? nullptr : newv, 256, 0);
    }
};

template <class Epi, class Sched, bool ALIGN_EPI = false, bool SP2 = false>
__device__ __forceinline__ void gemm_phase(PG8_LAS unsigned char* lds, const Gemm g, const Sched& S, const Epi& E) {
    const int tid = opaque_tid(), wid = __builtin_amdgcn_readfirstlane(tid >> 6), lane = tid & 63, wr = wid >> 2, wc = wid & 3, fr = lane & 15, fq = lane >> 4;
    const int K = g.K, nt = K / BK;
    unsigned voffA[2], voffB[2];
#pragma unroll
    for (int i = 0; i < 2; ++i) { int R, C; stage_rc(tid * 16 + i * 8192, R, C); const int Rb = Epi::PERM ? ((R & ~31) + perm32(R & 31)) : R;
        voffA[i] = (unsigned)(R * K + C) * 2u; voffB[i] = (unsigned)(Rb * K + C) * 2u; }
    const size_t kstep = (size_t)(BK * 2);
    const size_t hstep = (size_t)HALF * K * 2;
    const size_t tstep = 2 * hstep;
    const unsigned ldsw = (unsigned)wid * 1024u;
    const int aoff = lds_byte(wr * 64 + fr, fq * 8), boff = lds_byte(wc * 32 + fr, fq * 8);
#define PG8_SA(b, h) (((b) * 2 + (h)) * HTB)
#define PG8_SB(b, h) ((4 + (b) * 2 + (h)) * HTB)
#define PG8_STAGE(bufoff, gbase, voff) do { _Pragma("unroll") for (int _i = 0; _i < 2; ++_i) \
        __builtin_amdgcn_global_load_lds((const unsigned*)((const char*)(gbase) + (voff)[_i]), (PG8_LAS unsigned*)(lds + (bufoff) + ldsw + _i * 8192), 16, 0, 0); } while (0)
#define PG8_LDA(dst, b, h) do { _Pragma("unroll") for (int m = 0; m < 4; ++m) _Pragma("unroll") for (int k = 0; k < 2; ++k) dst[m][k] = *(const PG8_LAS bf16x8*)(lds + PG8_SA(b, h) + aoff + m * 2048 + k * 1024); } while (0)
#define PG8_LDB(dst, b, h) do { _Pragma("unroll") for (int n = 0; n < 2; ++n) _Pragma("unroll") for (int k = 0; k < 2; ++k) dst[n][k] = *(const PG8_LAS bf16x8*)(lds + PG8_SB(b, h) + boff + n * 2048 + k * 1024); } while (0)
#define PG8_MMA(ai, bj, At, Bt) do { __builtin_amdgcn_s_setprio(1); _Pragma("unroll") for (int m = 0; m < 4; ++m) _Pragma("unroll") for (int n = 0; n < 2; ++n) _Pragma("unroll") for (int k = 0; k < 2; ++k) \
        acc[ai][bj][m][n] = __builtin_amdgcn_mfma_f32_16x16x32_bf16(Bt[n][k], At[m][k], acc[ai][bj][m][n], 0, 0, 0); __builtin_amdgcn_s_setprio(0); } while (0)
#define PG8_WAIT_V(n) asm volatile("s_waitcnt vmcnt(" #n ")" ::: "memory")
#define PG8_WAIT_L(n) asm volatile("s_waitcnt lgkmcnt(" #n ")" ::: "memory")
#define PG8_BAR __builtin_amdgcn_s_barrier()
#define PG8_SCHED __builtin_amdgcn_sched_barrier(0)
    Unit cur, nxt; int ui = 0;
    if (!S.next(0, cur)) return;
    f32x4 acc[2][2][4][2];
#pragma unroll
    for (int a = 0; a < 2; ++a)
#pragma unroll
        for (int b = 0; b < 2; ++b)
#pragma unroll
            for (int m = 0; m < 4; ++m)
#pragma unroll
                for (int n = 0; n < 2; ++n) acc[a][b][m][n] = (f32x4){0.f, 0.f, 0.f, 0.f};
    bf16x8 At[4][2], B0[2][2], B1[2][2];
    const char* cA = (const char*)g.A + (size_t)cur.pm * tstep; const char* cB = (const char*)g.Bt + (size_t)cur.pn * tstep;
    S.a_ready(cur);
    if constexpr (SP2) {
        PG8_STAGE(PG8_SB(0, 0), cB, voffB); PG8_STAGE(PG8_SB(0, 1), cB + hstep, voffB); PG8_STAGE(PG8_SA(0, 0), cA, voffA); PG8_STAGE(PG8_SA(0, 1), cA + hstep, voffA);
        if (wr == 1) PG8_BAR;
        PG8_WAIT_V(2); PG8_BAR;
        PG8_STAGE(PG8_SB(1, 0), cB + kstep, voffB); PG8_STAGE(PG8_SA(1, 0), cA + kstep, voffA); PG8_STAGE(PG8_SB(1, 1), cB + hstep + kstep, voffB);
        PG8_WAIT_V(6); PG8_BAR;
    } else {
        PG8_STAGE(PG8_SB(0, 0), cB, voffB); PG8_STAGE(PG8_SA(0, 0), cA, voffA); PG8_STAGE(PG8_SB(0, 1), cB + hstep, voffB); PG8_STAGE(PG8_SA(0, 1), cA + hstep, voffA);
        if (wr == 1) PG8_BAR;
        PG8_WAIT_V(4); PG8_BAR;
        PG8_STAGE(PG8_SB(1, 0), cB + kstep, voffB); PG8_STAGE(PG8_SA(1, 0), cA + kstep, voffA); PG8_STAGE(PG8_SB(1, 1), cB + hstep + kstep, voffB);
        PG8_WAIT_V(6); PG8_BAR;
    }
    for (;;) {
        const bool has_next = S.next(ui + 1, nxt);
        const char* nA = has_next ? (const char*)g.A + (size_t)nxt.pm * tstep : cA; const char* nB = has_next ? (const char*)g.Bt + (size_t)nxt.pn * tstep : cB;
        for (int t = 0; t < nt; t += 2) {
            const bool last = (t == nt - 2);
            const char* a1 = cA + (size_t)(t + 1) * kstep;
            const char* a2 = last ? nA : cA + (size_t)(t + 2) * kstep; const char* b2 = last ? nB : cB + (size_t)(t + 2) * kstep;
            const char* a3 = a2 + kstep; const char* b3 = b2 + kstep;
            if (last && has_next) S.a_ready(nxt);
            if constexpr (SP2) {
            PG8_LDB(B0, 0, 0); PG8_LDB(B1, 0, 1); PG8_SCHED; PG8_LDA(At, 0, 0); PG8_STAGE(PG8_SA(1, 1), a1 + hstep, voffA);
            PG8_WAIT_V(8); PG8_WAIT_L(0); PG8_BAR; PG8_MMA(0, 0, At, B0); PG8_MMA(0, 1, At, B1); PG8_BAR; PG8_SCHED;
            PG8_LDA(At, 0, 1); PG8_STAGE(PG8_SB(0, 0), b2, voffB); PG8_STAGE(PG8_SB(0, 1), b2 + hstep, voffB); PG8_STAGE(PG8_SA(0, 0), a2, voffA);
            PG8_WAIT_V(8); PG8_WAIT_L(0); PG8_BAR; PG8_MMA(1, 0, At, B0); PG8_MMA(1, 1, At, B1); PG8_BAR; PG8_SCHED;
            PG8_LDB(B0, 1, 0); PG8_LDB(B1, 1, 1); PG8_SCHED; PG8_LDA(At, 1, 0); PG8_STAGE(PG8_SA(0, 1), a2 + hstep, voffA);
            PG8_WAIT_V(8); PG8_WAIT_L(0); PG8_BAR; PG8_MMA(0, 0, At, B0); PG8_MMA(0, 1, At, B1); PG8_BAR; PG8_SCHED;
            PG8_LDA(At, 1, 1); PG8_STAGE(PG8_SB(1, 0), b3, voffB); PG8_STAGE(PG8_SB(1, 1), b3 + hstep, voffB); PG8_STAGE(PG8_SA(1, 0), a3, voffA);
            PG8_WAIT_V(8); PG8_WAIT_L(0); PG8_BAR; PG8_MMA(1, 0, At, B0); PG8_MMA(1, 1, At, B1); PG8_BAR; PG8_SCHED;
            } else {
            PG8_LDB(B0, 0, 0); PG8_SCHED; PG8_LDA(At, 0, 0); PG8_STAGE(PG8_SA(1, 1), a1 + hstep, voffA);
            PG8_WAIT_L(8); PG8_BAR; PG8_WAIT_L(0); PG8_MMA(0, 0, At, B0); PG8_BAR; PG8_SCHED;
            PG8_LDB(B1, 0, 1); PG8_STAGE(PG8_SB(0, 0), b2, voffB);
            PG8_BAR; PG8_WAIT_L(0); PG8_MMA(0, 1, At, B1); PG8_BAR;
            PG8_LDA(At, 0, 1); PG8_STAGE(PG8_SA(0, 0), a2, voffA);
            PG8_BAR; PG8_WAIT_L(0); PG8_MMA(1, 0, At, B0); PG8_BAR; PG8_SCHED;
            PG8_STAGE(PG8_SB(0, 1), b2 + hstep, voffB);
            PG8_WAIT_V(6); PG8_BAR; PG8_MMA(1, 1, At, B1); PG8_BAR;
            PG8_LDB(B0, 1, 0); PG8_SCHED; PG8_LDA(At, 1, 0); PG8_STAGE(PG8_SA(0, 1), a2 + hstep, voffA);
            PG8_WAIT_L(8); PG8_BAR; PG8_WAIT_L(0); PG8_MMA(0, 0, At, B0); PG8_BAR; PG8_SCHED;
            PG8_LDB(B1, 1, 1); PG8_STAGE(PG8_SB(1, 0), b3, voffB);
            PG8_BAR; PG8_WAIT_L(0); PG8_MMA(0, 1, At, B1); PG8_BAR;
            PG8_LDA(At, 1, 1); PG8_STAGE(PG8_SA(1, 0), a3, voffA);
            PG8_BAR; PG8_WAIT_L(0); PG8_MMA(1, 0, At, B0); PG8_BAR; PG8_SCHED;
            PG8_STAGE(PG8_SB(1, 1), b3 + hstep, voffB);
            PG8_WAIT_V(6); PG8_BAR; PG8_MMA(1, 1, At, B1); PG8_BAR;
            }
        }
        if constexpr (ALIGN_EPI) { if (wr == 0) PG8_BAR; }
        if constexpr (!Epi::AFTER_DRAIN) { E(acc, cur, wr, wc, fr, fq); S.done(cur); }
        if (!has_next) break;
#pragma unroll
        for (int a = 0; a < 2; ++a)
#pragma unroll
            for (int b = 0; b < 2; ++b)
#pragma unroll
                for (int m = 0; m < 4; ++m)
#pragma unroll
                    for (int n = 0; n < 2; ++n) acc[a][b][m][n] = (f32x4){0.f, 0.f, 0.f, 0.f};
        cur = nxt; cA = nA; cB = nB; ++ui;
        if constexpr (ALIGN_EPI) { if (wr == 1) PG8_BAR; }
    }
    PG8_WAIT_V(0);
    if constexpr (!ALIGN_EPI) { if (wr == 0) PG8_BAR; }
    PG8_BAR;
    if constexpr (Epi::AFTER_DRAIN) { E.fused(acc, cur, wr, wc, fr, fq, lds, wid, lane); S.done(cur); }
#undef PG8_SA
#undef PG8_SB
#undef PG8_STAGE
#undef PG8_LDA
#undef PG8_LDB
#undef PG8_MMA
#undef PG8_WAIT_V
#undef PG8_WAIT_L
#undef PG8_BAR
#undef PG8_SCHED
}
}

namespace att {
typedef unsigned short bf16_t;
typedef short bf16x8 __attribute__((ext_vector_type(8)));
typedef short s16x4 __attribute__((ext_vector_type(4)));
typedef short v4i16_t __attribute__((ext_vector_type(4)));
typedef float f32x16 __attribute__((ext_vector_type(16)));
typedef float f32x4 __attribute__((ext_vector_type(4)));
typedef unsigned u32x4 __attribute__((ext_vector_type(4)));
typedef unsigned u32x2 __attribute__((ext_vector_type(2)));
#define ATT_LAS __attribute__((address_space(3)))
__device__ __forceinline__ int crow(int r, int hi) { return (r & 3) + 8 * (r >> 2) + 4 * hi; }
typedef float f32x2_t __attribute__((ext_vector_type(2))); typedef __bf16 bf16x2_t __attribute__((ext_vector_type(2)));
__device__ __forceinline__ unsigned cvtpk(float lo, float hi) { f32x2_t v = {lo, hi}; bf16x2_t b = __builtin_convertvector(v, bf16x2_t); return __builtin_bit_cast(unsigned, b); }
__device__ __forceinline__ s16x4 vtr(const ATT_LAS unsigned char* p) { return __builtin_bit_cast(s16x4, __builtin_amdgcn_ds_read_tr16_b64_v4i16((ATT_LAS v4i16_t*)p)); }
constexpr float THR = 6.0f;
constexpr float NEG_BIG = -1.0e30f;

struct KvStream {
    const bf16_t *Kc, *Vc, *Kb, *Vb; int ncache, nown, kp;
};

template <int KW, int DV>
__device__ __forceinline__ float attn_core(ATT_LAS unsigned char* lds, ATT_LAS float* wsf, const bf16_t* Qw, int qpitch, int kslice, const KvStream& S,
                                           bool masked, int qpos, int kpos0, float m_init, float l_init, f32x16 (&o)[DV / 32]) {
    constexpr int KB = 64 * KW * 2, VB = 64 * DV * 2, TB = KB + VB, NKC = KW / 64, NVC = DV / 64;
    const int tid = pg8::opaque_tid(), lane = tid & 63, r32 = lane & 31, hi = lane >> 5;
    int ksoff[NKC], kdoff[NKC], vsoff[NVC], vdoff[NVC];
#pragma unroll
    for (int q = 0; q < NKC; ++q) { const int L = q * 512 + tid, cw = L >> 8, key = (L & 255) >> 2, c4 = L & 3; ksoff[q] = key * S.kp + cw * 32 + c4 * 8; kdoff[q] = cw * 4096 + key * 64 + ((c4 ^ ((key >> 2) & 3)) << 4); }
#pragma unroll
    for (int q = 0; q < NVC; ++q) { const int L = q * 512 + tid, cw = L >> 8, key = (L & 255) >> 2, c4 = L & 3; vsoff[q] = key * S.kp + cw * 32 + c4 * 8; vdoff[q] = KB + cw * 4096 + key * 64 + (c4 << 4); }
    int kaoff[4];
#pragma unroll
    for (int d0 = 0; d0 < 4; ++d0) kaoff[d0] = (kslice * 2 + (d0 >> 1)) * 4096 + r32 * 64 + (((((d0 & 1) << 1) | hi) ^ ((r32 >> 2) & 3)) << 4);
    const int vb0 = KB + ((lane >> 4) & 1) * 32 + (lane & 3) * 8 + (4 * hi + ((lane & 15) >> 2)) * 64;
    bf16x8 qr[4];
#pragma unroll
    for (int d0 = 0; d0 < 4; ++d0) qr[d0] = *(const bf16x8*)(Qw + (size_t)r32 * qpitch + d0 * 16 + hi * 8);
#pragma unroll
    for (int d = 0; d < DV / 32; ++d) o[d] = f32x16{};
    float mhat = m_init, l = l_init;
    const int NT = S.ncache + S.nown;
    u32x4 kreg[NKC], vreg[NVC];
    {   const bf16_t* ks = S.ncache > 0 ? S.Kc : S.Kb; const bf16_t* vs = S.ncache > 0 ? S.Vc : S.Vb;
#pragma unroll
        for (int q = 0; q < NKC; ++q) kreg[q] = *(const u32x4*)(ks + ksoff[q]);
#pragma unroll
        for (int q = 0; q < NVC; ++q) vreg[q] = *(const u32x4*)(vs + vsoff[q]); }
    for (int t = 0; t < NT; ++t) {
        ATT_LAS unsigned char* buf = lds + (t & 1) * TB;
#pragma unroll
        for (int q = 0; q < NKC; ++q) *(ATT_LAS u32x4*)(buf + kdoff[q]) = kreg[q];
#pragma unroll
        for (int q = 0; q < NVC; ++q) *(ATT_LAS u32x4*)(buf + vdoff[q]) = vreg[q];
        __syncthreads();
        if (t + 1 < NT) {
            const int tn = t + 1;
            const bf16_t* ks = tn < S.ncache ? S.Kc + (size_t)tn * 64 * S.kp : S.Kb + (size_t)(tn - S.ncache) * 64 * S.kp;
            const bf16_t* vs = tn < S.ncache ? S.Vc + (size_t)tn * 64 * S.kp : S.Vb + (size_t)(tn - S.ncache) * 64 * S.kp;
#pragma unroll
            for (int q = 0; q < NKC; ++q) kreg[q] = *(const u32x4*)(ks + ksoff[q]);
#pragma unroll
            for (int q = 0; q < NVC; ++q) vreg[q] = *(const u32x4*)(vs + vsoff[q]);
        }
        f32x16 p0 = f32x16{}, p1 = f32x16{};
#pragma unroll
        for (int d0 = 0; d0 < 4; ++d0) {
            const bf16x8 a0 = *(const ATT_LAS bf16x8*)(buf + kaoff[d0]);
            const bf16x8 a1 = *(const ATT_LAS bf16x8*)(buf + kaoff[d0] + 2048);
            p0 = __builtin_amdgcn_mfma_f32_32x32x16_bf16(a0, qr[d0], p0, 0, 0, 0);
            p1 = __builtin_amdgcn_mfma_f32_32x32x16_bf16(a1, qr[d0], p1, 0, 0, 0);
        }
        if (masked && t >= S.ncache) {
            const int kb = kpos0 + (t - S.ncache) * 64;
#pragma unroll
            for (int r = 0; r < 16; ++r) { const int k0 = kb + crow(r, hi); int dd = qpos - k0; if (dd < 0) dd = -dd; if (dd > 128) p0[r] = NEG_BIG; dd = qpos - (k0 + 32); if (dd < 0) dd = -dd; if (dd > 128) p1[r] = NEG_BIG; }
        }
        float rm = fmaxf(p0[0], p1[0]);
#pragma unroll
        for (int r = 1; r < 16; ++r) rm = fmaxf(rm, fmaxf(p0[r], p1[r]));
        { auto rr = __builtin_amdgcn_permlane32_swap(__float_as_uint(rm), __float_as_uint(rm), false, false); rm = fmaxf(__uint_as_float(rr[0]), __uint_as_float(rr[1])); }
        if (__any(rm > mhat + THR)) {
            const float mn = fmaxf(mhat, rm);
            const float f = __builtin_amdgcn_exp2f(mhat - mn);
            l *= f; mhat = mn;
            if (hi == 0) wsf[r32] = f;
#pragma unroll
            for (int r = 0; r < 16; ++r) { const float fr_ = wsf[crow(r, hi)];
#pragma unroll
                for (int d = 0; d < DV / 32; ++d) o[d][r] *= fr_; }
        }
        float ls = 0.f;
#pragma unroll
        for (int r = 0; r < 16; ++r) { p0[r] = __builtin_amdgcn_exp2f(p0[r] - mhat); p1[r] = __builtin_amdgcn_exp2f(p1[r] - mhat); ls += p0[r] + p1[r]; }
        l += ls;
        bf16x8 pa[4];
        { u32x4 w;
          w.x = cvtpk(p0[0], p0[1]); w.y = cvtpk(p0[2], p0[3]); w.z = cvtpk(p0[4], p0[5]); w.w = cvtpk(p0[6], p0[7]); pa[0] = __builtin_bit_cast(bf16x8, w);
          w.x = cvtpk(p0[8], p0[9]); w.y = cvtpk(p0[10], p0[11]); w.z = cvtpk(p0[12], p0[13]); w.w = cvtpk(p0[14], p0[15]); pa[1] = __builtin_bit_cast(bf16x8, w);
          w.x = cvtpk(p1[0], p1[1]); w.y = cvtpk(p1[2], p1[3]); w.z = cvtpk(p1[4], p1[5]); w.w = cvtpk(p1[6], p1[7]); pa[2] = __builtin_bit_cast(bf16x8, w);
          w.x = cvtpk(p1[8], p1[9]); w.y = cvtpk(p1[10], p1[11]); w.z = cvtpk(p1[12], p1[13]); w.w = cvtpk(p1[14], p1[15]); pa[3] = __builtin_bit_cast(bf16x8, w); }
#pragma unroll
        for (int d = 0; d < DV / 32; ++d) {
#pragma unroll
            for (int ks = 0; ks < 4; ++ks) {
                const s16x4 lo = vtr(buf + vb0 + d * 4096 + ks * 1024), hh = vtr(buf + vb0 + d * 4096 + ks * 1024 + 512);
                const bf16x8 vf = (bf16x8){lo[0], lo[1], lo[2], lo[3], hh[0], hh[1], hh[2], hh[3]};
                o[d] = __builtin_amdgcn_mfma_f32_32x32x16_bf16(pa[ks], vf, o[d], 0, 0, 0);
            }
        }
    }
    { auto rr = __builtin_amdgcn_permlane32_swap(__float_as_uint(l), __float_as_uint(l), false, false); l = __uint_as_float(rr[0]) + __uint_as_float(rr[1]); }
    return l;
}

__device__ __forceinline__ void row_recips(ATT_LAS float* wsf, float l, int r32, int hi, float (&rli)[16]) {
    if (hi == 0) wsf[32 + r32] = l;
#pragma unroll
    for (int r = 0; r < 16; ++r) rli[r] = 1.0f / wsf[32 + crow(r, hi)];
}

constexpr int ODD_KV = 2 * (64 + 64) * 64 * 2;
constexpr int ODD_WSF = ODD_KV, ODD_STG = ODD_WSF + 8 * 256;
__device__ __forceinline__ void odd_unit(ATT_LAS unsigned char* lds, const bf16_t* Q, const bf16_t* K, const bf16_t* V, const bf16_t* CK, const bf16_t* CV, bf16_t* O, const float* sink,
                                         bool sample, int b, int g, int qb) {
    const int tid = pg8::opaque_tid(), lane = tid & 63, r32 = lane & 31, hi = lane >> 5; const int wid = __builtin_amdgcn_readfirstlane(tid >> 6);
    const int head = 4 * g + (wid >> 1);
    const int rowbase = sample ? 4096 + b * 2048 : b * 256;
    const int q0 = qb * 64 + 32 * (wid & 1);
    KvStream S; S.kp = 256;
    int kpos0 = 0;
    if (sample) { const int ts = qb - 2 < 0 ? 0 : qb - 2, te = qb + 3 > 32 ? 32 : qb + 3; kpos0 = ts * 64;
        S.Kc = CK + (size_t)b * 512 * 256 + g * 64; S.Vc = CV + (size_t)b * 512 * 256 + g * 64; S.ncache = 8;
        S.Kb = K + (size_t)(rowbase + kpos0) * 256 + g * 64; S.Vb = V + (size_t)(rowbase + kpos0) * 256 + g * 64; S.nown = te - ts; }
    else { S.Kc = nullptr; S.Vc = nullptr; S.ncache = 0; S.Kb = K + (size_t)rowbase * 256 + g * 64; S.Vb = V + (size_t)rowbase * 256 + g * 64; S.nown = 4; }
    ATT_LAS float* wsf = (ATT_LAS float*)(lds + ODD_WSF) + wid * 64;
    f32x16 o[2];
    const float l = attn_core<64, 64>(lds, wsf, Q + (size_t)(rowbase + q0) * 1024 + head * 64, 1024, 0, S, sample, q0 + r32, kpos0, sink[head] * 1.4426950408889634f, hi == 0 ? 1.0f : 0.0f, o);
    float rli[16]; row_recips(wsf, l, r32, hi, rli);
    ATT_LAS bf16_t* stg = (ATT_LAS bf16_t*)(lds + ODD_STG) + wid * 2048;
#pragma unroll
    for (int r = 0; r < 16; ++r) { const int orow = crow(r, hi);
#pragma unroll
        for (int d = 0; d < 2; ++d) { const float v = o[d][r] * rli[r]; stg[orow * 64 + d * 32 + r32] = (bf16_t)(cvtpk(v, v) & 0xffffu); } }
    bf16_t* Ow = O + (size_t)(rowbase + q0) * 1024 + head * 64;
#pragma unroll
    for (int i = 0; i < 4; ++i) { const int row = i * 8 + (lane >> 3), ch = lane & 7; const u32x4 v = *(const ATT_LAS u32x4*)(stg + row * 64 + ch * 8); *(u32x4*)(Ow + (size_t)row * 1024 + ch * 8) = v; }
    __syncthreads();
}

constexpr int EVEN_KV = 2 * (128 + 128) * 64 * 2;
constexpr int EVEN_WSF = 72 * 1024;
constexpr int EVEN_SROW = 136;
__device__ __forceinline__ void even_unit(ATT_LAS unsigned char* lds, const bf16_t* Q, const bf16_t* K, const bf16_t* V, const bf16_t* CK, const bf16_t* CV, bf16_t* O, const float* subln, float lam, float post,
                                          bool sample, int b, int h, int qb) {
    const int tid = pg8::opaque_tid(), lane = tid & 63, r32 = lane & 31, hi = lane >> 5; const int wid = __builtin_amdgcn_readfirstlane(tid >> 6);
    const int mp = wid >> 2, wq = wid & 3;
    const int rowbase = sample ? 4096 + b * 2048 : b * 256;
    const int q0 = qb * 128 + 32 * wq;
    KvStream S; S.kp = 512;
    if (sample) { S.Kc = CK + (size_t)b * 512 * 512 + h * 128; S.Vc = CV + (size_t)b * 512 * 512 + h * 128; S.ncache = 8; S.nown = 32; }
    else { S.Kc = nullptr; S.Vc = nullptr; S.ncache = 0; S.nown = 4; }
    S.Kb = K + (size_t)rowbase * 512 + h * 128; S.Vb = V + (size_t)rowbase * 512 + h * 128;
    ATT_LAS float* wsf = (ATT_LAS float*)(lds + EVEN_WSF) + wid * 64;
    f32x16 o[4];
    const float l = attn_core<128, 128>(lds, wsf, Q + (size_t)(rowbase + q0) * 512 + h * 128 + mp * 64, 512, mp, S, false, 0, 0, -INFINITY, 0.0f, o);
    float rli[16]; row_recips(wsf, l, r32, hi, rli);
    ATT_LAS float* stage = (ATT_LAS float*)lds;
    __syncthreads();
    if (mp == 1) {
#pragma unroll
        for (int r = 0; r < 16; ++r) { const int row = 32 * wq + crow(r, hi);
#pragma unroll
            for (int d = 0; d < 4; ++d) stage[row * EVEN_SROW + d * 32 + r32] = o[d][r] * rli[r]; }
    }
    __syncthreads();
    if (mp == 0) {
#pragma unroll
        for (int r = 0; r < 16; ++r) { const int row = 32 * wq + crow(r, hi);
#pragma unroll
            for (int d = 0; d < 4; ++d) { ATT_LAS float* p = stage + row * EVEN_SROW + d * 32 + r32; *p = o[d][r] * rli[r] - lam * (*p); } }
        const int row = 32 * wq + (lane >> 1), half = lane & 1;
        const ATT_LAS float* rp = stage + row * EVEN_SROW + half * 4;
        float ss = 0.f;
#pragma unroll
        for (int i = 0; i < 16; ++i) { const f32x4 v = *(const ATT_LAS f32x4*)(rp + i * 8); ss += (v[0] * v[0] + v[1] * v[1]) + (v[2] * v[2] + v[3] * v[3]); }
        ss += __shfl_xor(ss, 1);
        const float rs = post / sqrtf(ss * (1.0f / 128.0f) + 1e-6f);
        bf16_t* Ow = O + (size_t)(rowbase + qb * 128 + row) * 1024 + h * 128 + half * 4;
#pragma unroll
        for (int i = 0; i < 16; ++i) { const f32x4 v = *(const ATT_LAS f32x4*)(rp + i * 8); const f32x4 gsub = *(const f32x4*)(subln + half * 4 + i * 8);
            u32x2 w; w.x = cvtpk(v[0] * rs * gsub[0], v[1] * rs * gsub[1]); w.y = cvtpk(v[2] * rs * gsub[2], v[3] * rs * gsub[3]); *(u32x2*)(Ow + i * 8) = w; }
    }
    __syncthreads();
}
#undef ATT_LAS
}

#define GAS __attribute__((address_space(1)))
#define LAS __attribute__((address_space(3)))
typedef unsigned short bf16;
typedef unsigned v4u __attribute__((ext_vector_type(4)));
typedef float f32x4 __attribute__((ext_vector_type(4)));
typedef short bf16x8 __attribute__((ext_vector_type(8)));
typedef GAS unsigned gu32;
typedef GAS unsigned long long gu64;
#define RLX_AGENT __ATOMIC_RELAXED, __HIP_MEMORY_SCOPE_AGENT
#define LDS_WAIT() asm volatile("s_waitcnt lgkmcnt(0)" ::: "memory")
#define VM_WAIT() asm volatile("s_waitcnt vmcnt(0)" ::: "memory")
__device__ __forceinline__ unsigned long long rt() { return __builtin_amdgcn_s_memrealtime(); }
__device__ __forceinline__ unsigned f2bf(float f) { unsigned u = __builtin_bit_cast(unsigned, f); return (u + 0x7fffu + ((u >> 16) & 1u)) >> 16; }
__device__ __forceinline__ unsigned pk2(float lo, float hi) { return f2bf(lo) | (f2bf(hi) << 16); }

#define XB_TMO      128
#define XB_XCNT(j)  (256  + 64 * (j))
#define XB_XSUB(j)  (1280 + 64 * (j))
#define XB_XGEN(j)  (2304 + 64 * (j))
#define XB_TOP      3328
#define XB_TOPGEN   3392
#define XCD_BAR_WORDS 3456
#define XB_SPIN_CAP (1u << 18)

__device__ __forceinline__ unsigned xb_ld(unsigned* p)              { return __hip_atomic_load(p, __ATOMIC_RELAXED, __HIP_MEMORY_SCOPE_AGENT); }
__device__ __forceinline__ unsigned xb_add(unsigned* p, unsigned v) { return __hip_atomic_fetch_add(p, v, __ATOMIC_RELAXED, __HIP_MEMORY_SCOPE_AGENT); }
__device__ __forceinline__ unsigned xb_xcc_id() { return (unsigned)__builtin_amdgcn_s_getreg((3 << 11) | 20) & 0xFu; }
#define XB_SPIN(cond, bar) do { unsigned _sp = 0; while (cond) { __builtin_amdgcn_s_sleep(1); \
    if ((++_sp & 255u) == 0u) { if (xb_ld(&(bar)[XB_TMO])) break; if (_sp > XB_SPIN_CAP) { atomicAdd(&(bar)[XB_TMO], 1u); break; } } } } while (0)

struct XcdBarrier {
    unsigned* bar; unsigned x;
    volatile LAS unsigned* st;
};

__device__ __forceinline__ XcdBarrier xcd_barrier_post(unsigned* bar, volatile LAS unsigned* st) {
    XcdBarrier b; b.bar = bar; b.x = xb_xcc_id(); b.st = st;
    if (threadIdx.x == 0) (void)xb_add(&bar[XB_XCNT(b.x)], 1u);
    return b;
}
__device__ __forceinline__ void xcd_barrier_complete(unsigned* bar, unsigned x, unsigned& nloc, unsigned& nx) {
    const unsigned G = gridDim.x * gridDim.y * gridDim.z;
    unsigned sum, cnt, mine, sp = 0u;
    for (;;) {
        sum = 0u; cnt = 0u; mine = 0u;
#pragma unroll
        for (unsigned j = 0; j < 16; ++j) { const unsigned c = xb_ld(&bar[XB_XCNT(j)]); sum += c; cnt += (c > 0u) ? 1u : 0u; mine = (j == x) ? c : mine; }
        if (sum == G) break;
        __builtin_amdgcn_s_sleep(1);
        if ((++sp & 255u) == 0u) { if (xb_ld(&bar[XB_TMO])) break; if (sp > XB_SPIN_CAP) { atomicAdd(&bar[XB_TMO], 1u); break; } }
    }
    nloc = mine > 0u ? mine : 1u; nx = cnt > 0u ? cnt : 1u;
}

__device__ __forceinline__ void xcd_barrier(const XcdBarrier& b) {
    asm volatile("s_waitcnt vmcnt(0)" ::: "memory");
    __syncthreads();
    if (threadIdx.x == 0) {
        unsigned* bar = b.bar;
        __builtin_amdgcn_s_waitcnt(0);
        unsigned nloc = b.st[0], nx = b.st[1];
        if (nloc == 0u) { xcd_barrier_complete(bar, b.x, nloc, nx); b.st[0] = nloc; b.st[1] = nx; }
        const unsigned old = xb_add(&bar[XB_XSUB(b.x)], 1u);
        const unsigned gen = old / nloc;
        if (old + 1u == (gen + 1u) * nloc) {
            __builtin_amdgcn_fence(__ATOMIC_RELEASE, "agent");
            asm volatile("s_waitcnt vmcnt(0)" ::: "memory");
            const unsigned og = xb_add(&bar[XB_TOP], 1u);
            const unsigned tg = og / nx;
            if (og + 1u == (tg + 1u) * nx) xb_add(&bar[XB_TOPGEN], 1u);
            else XB_SPIN(xb_ld(&bar[XB_TOPGEN]) == tg, bar);
            __builtin_amdgcn_fence(__ATOMIC_ACQUIRE, "agent");
            xb_add(&bar[XB_XGEN(b.x)], 1u);
            asm volatile("s_waitcnt vmcnt(0)" ::: "memory");
        } else {
            XB_SPIN(xb_ld(&bar[XB_XGEN(b.x)]) == gen, bar);
            __builtin_amdgcn_fence(__ATOMIC_ACQUIRE, "agent");
            asm volatile("s_waitcnt vmcnt(0)" ::: "memory");
        }
    }
    __syncthreads();
}

__device__ __forceinline__ float wave_sum(float v) {
#pragma unroll
    for (int o = 1; o < 64; o <<= 1) v += __shfl_xor(v, o);
    return v;
}

constexpr int NWAVES = 8;
constexpr int DM = 1024, DFF = 2816, NPROMPT = 4096, NSAMPLE = 16384, MT = NPROMPT + NSAMPLE;
constexpr int N_PHASES = 21;
#ifndef MK_PER_PHASE
#define MK_PER_PHASE 0
#endif

constexpr size_t MiB = 1u << 20;
constexpr size_t WS_CTL = 0, CTL_ZERO_BYTES = 1 * MiB;
constexpr size_t WS_MOD = 1 * MiB;
constexpr size_t WS_W13 = 2 * MiB;
constexpr size_t WS_W2 = 46 * MiB;
constexpr size_t WS_EWIN = 68 * MiB, WS_EWOUT = 74 * MiB, WS_OWIN = 76 * MiB, WS_OWOUT = 79 * MiB;
constexpr size_t WS_CEK = 81 * MiB, WS_CEV = 85 * MiB, WS_COK = 89 * MiB, WS_COV = 91 * MiB;
constexpr size_t WS_XN = 96 * MiB;
constexpr size_t WS_OB = 136 * MiB;
constexpr size_t WS_HB = 176 * MiB;
constexpr size_t WS_END = 286 * MiB;
constexpr size_t QKV_SLAB = (size_t)MT * 512 * 2;
constexpr size_t OUT_YP = 0, OUT_YS = 4194304, OUT_EK = 20971520, OUT_EV = 23068672, OUT_OK = 25165824, OUT_OV = 26214400, OUT_TOTAL = 27262976;
constexpr int CW_BAR = 4096;

constexpr int RING_BYTES = 131072;
constexpr int LDSCTL_OFF = RING_BYTES, MISC_OFF = LDSCTL_OFF + 320;
constexpr int LDS_BYTES = 147456;

struct Frame {
    LAS unsigned char* lds;
    int tid, lane, wave, vcu, G;
};

__device__ __forceinline__ void p0_transpose_item(const float* W, int K, int N, bf16* WT, int k0, int n0, int drow0, LAS float* scr, int lane) {
#pragma unroll 8
    for (int i = 0; i < 32; ++i) { const int kk = 2 * i + (lane >> 5); scr[kk * 33 + (lane & 31)] = W[(size_t)(k0 + kk) * N + n0 + (lane & 31)]; }
    LDS_WAIT(); asm volatile("" ::: "memory");
    const int c = lane & 7;
#pragma unroll
    for (int j = 0; j < 4; ++j) { const int n = (lane >> 3) + 8 * j; const LAS float* s = scr + (8 * c) * 33 + n;
        v4u o; o.x = pk2(s[0 * 33], s[1 * 33]); o.y = pk2(s[2 * 33], s[3 * 33]); o.z = pk2(s[4 * 33], s[5 * 33]); o.w = pk2(s[6 * 33], s[7 * 33]);
        *(GAS v4u*)(WT + (size_t)(drow0 + n) * K + k0 + 8 * c) = o; }
    LDS_WAIT(); asm volatile("" ::: "memory");
}
__device__ __forceinline__ int drow_swiglu(int n0) { const bool up = n0 >= DFF; const int c = up ? n0 - DFF : n0; return 256 * (c >> 7) + (up ? 128 : 0) + (c & 127); }
__device__ __forceinline__ int drow_heads(int n0) { const int pn = n0 >> 8, x = n0 & 255, wc = x >> 6, bj = (x & 63) >> 5; return 256 * pn + 128 * bj + 32 * wc; }
__device__ __forceinline__ int drow_even_in(int n0) {
    if (n0 < 1024) return drow_heads(n0);
    if (n0 < 2048) return n0;
    if (n0 < 2560) { const int c = n0 - 2048; return 2048 + 256 * (c >> 7) + (c & 127); }
    const int c = n0 - 2560; return 2048 + 256 * (c >> 7) + 128 + (c & 127);
}
__device__ __forceinline__ int drow_odd_in(int n0) { return n0 < 1280 ? drow_heads(n0) : n0; }

struct Ptrs {
    const float *x_prompt, *x_sample, *cek, *cev, *cok, *cov, *c, *c_ctx, *w_mod, *b_mod, *norm_g, *w13, *w2, *ewin, *ewout, *eqk, *elam, *esub, *econv, *owin, *owout, *oqk, *osink;
    float* out; unsigned char* ws;
};

__device__ __forceinline__ void cvt_cache(const Frame& F, const float* src, unsigned char* dst, size_t n8) {
    const size_t gt = (size_t)F.vcu * (NWAVES * 64) + F.tid, NGT = (size_t)F.G * NWAVES * 64;
    for (size_t i = gt; i < n8; i += NGT) { const f32x4 v0 = *(const f32x4*)(src + i * 8), v1 = *(const f32x4*)(src + i * 8 + 4);
        v4u o; o.x = pk2(v0[0], v0[1]); o.y = pk2(v0[2], v0[3]); o.z = pk2(v1[0], v1[1]); o.w = pk2(v1[2], v1[3]); *(v4u*)(dst + i * 16) = o; }
}
__device__ __forceinline__ void p0_prologue(const Frame& F0, const Ptrs& P) {
    Frame F = F0; F.tid = pg8::opaque_tid(); F.lane = F.tid & 63;
    {   LAS float* sil = (LAS float*)F.lds;
        LAS float* red = (LAS float*)(F.lds + 40960);
        bool have_sil = false;
        for (int item = blockIdx.x; item < 2 * 144; item += F.G) {
            if (!have_sil) {
                for (int i = F.tid; i < 9 * 1024; i += NWAVES * 64) { const int cnd = i >> 10, k = i & 1023; const float v = cnd < 8 ? P.c[cnd * 1024 + k] : P.c_ctx[k]; sil[i] = v / (1.0f + expf(-v)); }
                __syncthreads(); have_sil = true;
            }
            const int l = item / 144, cb = item % 144;
            const int lg = F.lane >> 4, l16 = F.lane & 15;
            const float* wp = P.w_mod + (size_t)l * 1024 * 9216 + cb * 64 + l16 * 4;
            f32x4 a[9];
#pragma unroll
            for (int cnd = 0; cnd < 9; ++cnd) a[cnd] = (f32x4){0.f, 0.f, 0.f, 0.f};
#pragma unroll 4
            for (int i = 0; i < 32; ++i) { const int k = F.wave * 4 + lg + 32 * i; const f32x4 wv = *(const f32x4*)(wp + (size_t)k * 9216);
#pragma unroll
                for (int cnd = 0; cnd < 9; ++cnd) a[cnd] += wv * sil[cnd * 1024 + k]; }
#pragma unroll
            for (int cnd = 0; cnd < 9; ++cnd)
#pragma unroll
                for (int e = 0; e < 4; ++e) { float v = a[cnd][e]; v += __shfl_xor(v, 16); v += __shfl_xor(v, 32); a[cnd][e] = v; }
            if (lg == 0) {
#pragma unroll
                for (int cnd = 0; cnd < 9; ++cnd) *(LAS f32x4*)(red + (F.wave * 9 + cnd) * 64 + l16 * 4) = a[cnd];
            }
            __syncthreads();
            for (int i = F.tid; i < 9 * 64; i += NWAVES * 64) { const int cnd = i >> 6, col = i & 63; float s = 0.f;
#pragma unroll
                for (int w = 0; w < 8; ++w) s += red[(w * 9 + cnd) * 64 + col];
                ((float*)(P.ws + WS_MOD))[(size_t)(l * 9 + cnd) * 9216 + cb * 64 + col] = s + P.b_mod[l * 9216 + cb * 64 + col]; }
            __syncthreads();
        }
        __syncthreads();
    }
    LAS float* scr = (LAS float*)(F.lds + F.wave * 16384);
    const int gw = F.vcu * NWAVES + F.wave, NGW = F.G * NWAVES;
    constexpr int I_W13 = 16 * 176, I_W2 = 44 * 32, I_EIN = 16 * 96, I_SQ = 16 * 32, I_OIN = 16 * 48;
    constexpr int NITEMS = 4 * I_W13 + 4 * I_W2 + I_EIN + I_SQ + I_OIN + I_SQ;
    for (int it = gw; it < NITEMS; it += NGW) {
        int r = it;
        if (r < 4 * I_W13) { const int mi = r / I_W13, q = r % I_W13, kb = q / 176, nb = q % 176;
            p0_transpose_item(P.w13 + (size_t)mi * 1024 * 5632, 1024, 5632, (bf16*)(P.ws + WS_W13) + (size_t)mi * 5632 * 1024, 64 * kb, 32 * nb, drow_swiglu(32 * nb), scr, F.lane); continue; }
        r -= 4 * I_W13;
        if (r < 4 * I_W2) { const int mi = r / I_W2, q = r % I_W2, kb = q / 32, nb = q % 32;
            p0_transpose_item(P.w2 + (size_t)mi * 2816 * 1024, 2816, 1024, (bf16*)(P.ws + WS_W2) + (size_t)mi * 1024 * 2816, 64 * kb, 32 * nb, 32 * nb, scr, F.lane); continue; }
        r -= 4 * I_W2;
        if (r < I_EIN) { const int kb = r / 96, nb = r % 96; p0_transpose_item(P.ewin, 1024, 3072, (bf16*)(P.ws + WS_EWIN), 64 * kb, 32 * nb, drow_even_in(32 * nb), scr, F.lane); continue; }
        r -= I_EIN;
        if (r < I_SQ) { const int kb = r / 32, nb = r % 32; p0_transpose_item(P.ewout, 1024, 1024, (bf16*)(P.ws + WS_EWOUT), 64 * kb, 32 * nb, 32 * nb, scr, F.lane); continue; }
        r -= I_SQ;
        if (r < I_OIN) { const int kb = r / 48, nb = r % 48; p0_transpose_item(P.owin, 1024, 1536, (bf16*)(P.ws + WS_OWIN), 64 * kb, 32 * nb, drow_odd_in(32 * nb), scr, F.lane); continue; }
        r -= I_OIN;
        { const int kb = r / 32, nb = r % 32; p0_transpose_item(P.owout, 1024, 1024, (bf16*)(P.ws + WS_OWOUT), 64 * kb, 32 * nb, 32 * nb, scr, F.lane); }
    }
    cvt_cache(F, P.cek, P.ws + WS_CEK, 2097152 / 8); cvt_cache(F, P.cev, P.ws + WS_CEV, 2097152 / 8);
    cvt_cache(F, P.cok, P.ws + WS_COK, 1048576 / 8); cvt_cache(F, P.cov, P.ws + WS_COV, 1048576 / 8);
}

__device__ __forceinline__ void norm_phase(const Frame& F0, const float* xP, const float* xS, const float* g, const float* mod  , int jshift, bf16* XN) {
    Frame F = F0; F.tid = pg8::opaque_tid(); F.lane = F.tid & 63;
    const int gw = F.vcu * NWAVES + F.wave, NGW = F.G * NWAVES;
    const int per = (MT + NGW - 1) / NGW;
    int r0 = gw * per, r1 = r0 + per; if (r1 > MT) r1 = MT;
    int cur_cond = -1; f32x4 gs[4], sh[4];
    for (int row = r0; row < r1; ++row) {
        const int cond = row < NPROMPT ? 8 : ((row - NPROMPT) >> 11);
        if (cond != cur_cond) { cur_cond = cond; const float* mp = mod + (size_t)cond * 9216;
#pragma unroll
            for (int j = 0; j < 4; ++j) { const int col = 4 * F.lane + 256 * j; const f32x4 gg = *(const f32x4*)(g + col), sc = *(const f32x4*)(mp + (jshift + 1) * 1024 + col); sh[j] = *(const f32x4*)(mp + jshift * 1024 + col); gs[j] = gg * (sc + 1.0f); } }
        const float* xr = row < NPROMPT ? xP + (size_t)row * DM : xS + (size_t)(row - NPROMPT) * DM;
        f32x4 v[4]; float s = 0.f;
#pragma unroll
        for (int j = 0; j < 4; ++j) { v[j] = *(const f32x4*)(xr + 4 * F.lane + 256 * j); s += (v[j][0] * v[j][0] + v[j][1] * v[j][1]) + (v[j][2] * v[j][2] + v[j][3] * v[j][3]); }
        const float rstd = 1.0f / sqrtf(wave_sum(s) * (1.0f / DM) + 1e-6f);
#pragma unroll
        for (int j = 0; j < 4; ++j) { const f32x4 y = v[j] * rstd * gs[j] + sh[j];
            *(unsigned long long*)(XN + (size_t)row * DM + 4 * F.lane + 256 * j) = (unsigned long long)pk2(y[0], y[1]) | ((unsigned long long)pk2(y[2], y[3]) << 32); }
    }
}

__device__ __forceinline__ float bf2f(unsigned short b) { return __builtin_bit_cast(float, (unsigned)b << 16); }
__device__ __forceinline__ void conv_phase(const Frame& F0, const bf16* U, const bf16* BG, const float* cw, bf16* OB) {
    Frame F = F0; F.tid = pg8::opaque_tid(); F.lane = F.tid & 63;
    const int gw = F.vcu * NWAVES + F.wave, NGW = F.G * NWAVES;
    const int c0 = 8 * F.lane;
    f32x4 w0[2], w1[2], w2[2];
#pragma unroll
    for (int h = 0; h < 2; ++h) { w0[h] = *(const f32x4*)(cw + c0 + 4 * h); w1[h] = *(const f32x4*)(cw + 512 + c0 + 4 * h); w2[h] = *(const f32x4*)(cw + 1024 + c0 + 4 * h); }
    for (int row = gw; row < MT; row += NGW) {
        const int t = row < NPROMPT ? (row & 255) : ((row - NPROMPT) & 2047), len = row < NPROMPT ? 256 : 2048;
        const v4u zero = (v4u){0u, 0u, 0u, 0u};
        const v4u uc = *(const v4u*)(U + (size_t)row * 512 + c0);
        const v4u up = t > 0 ? *(const v4u*)(U + (size_t)(row - 1) * 512 + c0) : zero;
        const v4u un = t < len - 1 ? *(const v4u*)(U + (size_t)(row + 1) * 512 + c0) : zero;
        const v4u bg = *(const v4u*)(BG + (size_t)row * 512 + c0);
        float y[8];
#pragma unroll
        for (int e = 0; e < 8; ++e) { const int wi = e >> 1, sft = (e & 1) * 16;
            const float a = bf2f((unsigned short)(up[wi] >> sft)), b = bf2f((unsigned short)(uc[wi] >> sft)), c = bf2f((unsigned short)(un[wi] >> sft)), gte = bf2f((unsigned short)(bg[wi] >> sft));
            y[e] = gte * (w0[e >> 2][e & 3] * a + w1[e >> 2][e & 3] * b + w2[e >> 2][e & 3] * c); }
        v4u o; o.x = pk2(y[0], y[1]); o.y = pk2(y[2], y[3]); o.z = pk2(y[4], y[5]); o.w = pk2(y[6], y[7]);
        *(v4u*)(OB + (size_t)row * DM + 512 + c0) = o;
    }
}

struct Args { const float* in[23]; float* out; unsigned char* ws; int ph_lo, ph_hi; };
__global__ void __launch_bounds__(NWAVES * 64, 2) mega_fwd(Args args) {
    extern __shared__ __attribute__((aligned(16))) unsigned char lds_raw[];
    Frame F;
    F.lds = (LAS unsigned char*)lds_raw;
    volatile LAS unsigned* MISC = (volatile LAS unsigned*)(F.lds + MISC_OFF);
    F.tid = threadIdx.x; F.lane = F.tid & 63; F.wave = __builtin_amdgcn_readfirstlane(F.tid >> 6);
    F.G = gridDim.x; { const int bx = blockIdx.x; F.vcu = (F.G % 8 == 0) ? (bx % 8) * (F.G / 8) + bx / 8 : bx; }
    typedef const __attribute__((address_space(4))) Args* KArgs;
    const KArgs KA0 = (KArgs)__builtin_amdgcn_kernarg_segment_ptr();
    unsigned char* ws = KA0->ws;
    for (int u = F.tid; u < (LDS_BYTES - LDSCTL_OFF) / 4; u += NWAVES * 64) ((LAS unsigned*)(F.lds + LDSCTL_OFF))[u] = 0u;
    __syncthreads();
    XcdBarrier bar; bar.bar = (unsigned*)(ws + WS_CTL) + CW_BAR; bar.x = 0; bar.st = nullptr;
    if (!MK_PER_PHASE) bar = xcd_barrier_post((unsigned*)(ws + WS_CTL) + CW_BAR, MISC + 8);

    const float* MODP = (const float*)(ws + WS_MOD);
    bf16* XN = (bf16*)(ws + WS_XN); bf16* OB = (bf16*)(ws + WS_OB); bf16* HB = (bf16*)(ws + WS_HB);
    float* xout = KA0->out;

    const int ph_lo = KA0->ph_lo, ph_hi = KA0->ph_hi;
    for (int ph = ph_lo; ph < ph_hi; ++ph) {
        KArgs ka = KA0; asm volatile("" : "+s"(ka));
        Ptrs P;
        P.x_prompt = ka->in[0]; P.x_sample = ka->in[1]; P.cek = ka->in[2]; P.cev = ka->in[3]; P.cok = ka->in[4]; P.cov = ka->in[5]; P.c = ka->in[6]; P.c_ctx = ka->in[7];
        P.w_mod = ka->in[8]; P.b_mod = ka->in[9]; P.norm_g = ka->in[10]; P.w13 = ka->in[11]; P.w2 = ka->in[12]; P.ewin = ka->in[13]; P.ewout = ka->in[14]; P.eqk = ka->in[15];
        P.elam = ka->in[16]; P.esub = ka->in[17]; P.econv = ka->in[18]; P.owin = ka->in[19]; P.owout = ka->in[20]; P.oqk = ka->in[21]; P.osink = ka->in[22];
        P.out = ka->out; P.ws = ka->ws;
        if (ph == 0) {
            p0_prologue(F, P);
        } else {
            const int l = (ph - 1) / 10, s = (ph - 1) % 10;
            const float* modl = MODP + (size_t)l * 9 * 9216;
            const bool first = (l == 0 && s < 3);
            const float* xP = first ? P.x_prompt : xout; const float* xS = first ? P.x_sample : xout + (size_t)NPROMPT * DM;
            if (s == 0 || s == 3 || s == 7) {
                const int sub = s == 0 ? 0 : (s == 3 ? 1 : 2);
                norm_phase(F, xP, xS, P.norm_g + (size_t)(l * 3 + sub) * DM, modl, 3 * sub, XN);
            } else if (s == 1 || s == 8) {
                const int fi = l * 2 + (s == 8 ? 1 : 0);
                pg8::Gemm g{XN, (const bf16*)(ws + WS_W13) + (size_t)fi * 5632 * 1024, MT, 2 * DFF, DM};
                pg8::StaticOrder S; S.init(MT, 2 * DFF, F.G, (int)blockIdx.x);
                pg8::EpiSwiGLU E{HB, DFF};
                pg8::gemm_phase<pg8::EpiSwiGLU, pg8::StaticOrder, true, true>(F.lds, g, S, E);
            } else if (s == 2 || s == 9 || s == 6) {
                pg8::Gemm g; const float* gate; float gs;
                if (s == 6) { g = pg8::Gemm{OB, (const bf16*)(ws + (l == 0 ? WS_EWOUT : WS_OWOUT)), MT, DM, DM}; gate = modl + 5 * 1024; gs = 1.0f; }
                else { const int fi = l * 2 + (s == 9 ? 1 : 0); g = pg8::Gemm{HB, (const bf16*)(ws + WS_W2) + (size_t)fi * 1024 * 2816, MT, DM, DFF}; gate = modl + (s == 2 ? 2 : 8) * 1024; gs = 0.5f; }
                pg8::StaticOrder S; S.init(MT, DM, F.G, (int)blockIdx.x);
                pg8::EpiResid E{xP, xS, xout, gate, gs};
                pg8::gemm_phase<pg8::EpiResid, pg8::StaticOrder, true, true>(F.lds, g, S, E);
            } else if (s == 4) {
                if (l == 0) {
                    pg8::Gemm g{XN, (const bf16*)(ws + WS_EWIN), MT, 3072, DM};
                    pg8::StaticOrder S; S.init(MT, 3072, F.G, (int)blockIdx.x);
                    unsigned char* qb = ws + WS_HB;
                    pg8::EpiQKVEven E{(bf16*)qb, (bf16*)(qb + QKV_SLAB), (bf16*)(qb + 2 * QKV_SLAB), (bf16*)(qb + 3 * QKV_SLAB), (bf16*)(qb + 4 * QKV_SLAB), P.out + OUT_EK, P.out + OUT_EV, P.eqk, ROPE_COS, ROPE_SIN};
                    pg8::gemm_phase<pg8::EpiQKVEven, pg8::StaticOrder, true, true>(F.lds, g, S, E);
                } else {
                    pg8::Gemm g{XN, (const bf16*)(ws + WS_OWIN), MT, 1536, DM};
                    pg8::StaticOrder S; S.init(MT, 1536, F.G, (int)blockIdx.x);
                    unsigned char* qb = ws + WS_HB;
                    pg8::EpiQKVOdd E{(bf16*)qb, (bf16*)(qb + 2 * QKV_SLAB), (bf16*)(qb + 2 * QKV_SLAB + QKV_SLAB / 2), P.out + OUT_OK, P.out + OUT_OV, P.oqk, ROPE_COS, ROPE_SIN};
                    pg8::gemm_phase<pg8::EpiQKVOdd, pg8::StaticOrder, true, true>(F.lds, g, S, E);
                }
            } else {
                unsigned char* qb = ws + WS_HB;
                if (l == 0) {
                    const bf16 *Q = (const bf16*)qb, *K = (const bf16*)(qb + QKV_SLAB), *V = (const bf16*)(qb + 2 * QKV_SLAB), *BG = (const bf16*)(qb + 3 * QKV_SLAB), *U = (const bf16*)(qb + 4 * QKV_SLAB);
                    const float a = wave_sum(P.elam[F.lane] * P.elam[64 + F.lane]), b2 = wave_sum(P.elam[128 + F.lane] * P.elam[192 + F.lane]);
                    const float lam_init = 0.8f - 0.6f * expf(-0.3f * (float)l);
                    const float lam = expf(a) - expf(b2) + lam_init;
                    for (int w = F.vcu; w < 256; w += F.G) for (int i = 0; i < 2; ++i) { const int su = w * 2 + i; const int bh = su >> 4; att::even_unit(F.lds, Q, K, V, (const bf16*)(ws + WS_CEK), (const bf16*)(ws + WS_CEV), OB, P.esub, lam, 1.0f - lam_init, true, bh >> 2, bh & 3, su & 15); }
                    for (int pu = F.vcu; pu < 128; pu += F.G) { const int bh = pu >> 1; att::even_unit(F.lds, Q, K, V, nullptr, nullptr, OB, P.esub, lam, 1.0f - lam_init, false, bh >> 2, bh & 3, pu & 1); }
                    conv_phase(F, U, BG, P.econv, OB);
                } else {
                    const bf16 *Q = (const bf16*)qb, *K = (const bf16*)(qb + 2 * QKV_SLAB), *V = (const bf16*)(qb + 2 * QKV_SLAB + QKV_SLAB / 2);
                    for (int w = F.vcu; w < 256; w += F.G) for (int su = w * 4; su < w * 4 + 4; ++su) { const int bg = su >> 5; att::odd_unit(F.lds, Q, K, V, (const bf16*)(ws + WS_COK), (const bf16*)(ws + WS_COV), OB, P.osink, true, bg >> 2, bg & 3, su & 31); }
                    for (int pu = F.vcu; pu < 256; pu += F.G) { const int bg = pu >> 2; att::odd_unit(F.lds, Q, K, V, nullptr, nullptr, OB, P.osink, false, bg >> 2, bg & 3, pu & 3); }
                }
            }
        }
        if (ph + 1 < ph_hi) xcd_barrier(bar);
    }
}

extern "C" void kernel_launch(void* const* d_in, const int* in_sizes, int n_in, void* d_out, int out_size, void* d_ws, size_t ws_size, hipStream_t stream) {
    static int grid = 0;
    if (grid == 0) {
        if (n_in != 23 || in_sizes[0] != NPROMPT * DM || in_sizes[1] != NSAMPLE * DM || (size_t)out_size != OUT_TOTAL || ws_size < WS_END) {
            fprintf(stderr, "kernel_launch: shape mismatch: n_in %d in0 %d in1 %d out %d ws %zu (need %zu); nothing launched\n", n_in, n_in > 0 ? in_sizes[0] : -1, n_in > 1 ? in_sizes[1] : -1, out_size, ws_size, (size_t)WS_END); grid = -1; return; }
        int dev = 0, cus = 0, per_cu = 0;
        if (hipGetDevice(&dev) != hipSuccess || hipDeviceGetAttribute(&cus, hipDeviceAttributeMultiprocessorCount, dev) != hipSuccess) { fprintf(stderr, "kernel_launch: device query failed\n"); grid = -1; return; }
        if (hipFuncSetAttribute((const void*)mega_fwd, hipFuncAttributeMaxDynamicSharedMemorySize, LDS_BYTES) != hipSuccess) { fprintf(stderr, "kernel_launch: hipFuncSetAttribute failed\n"); grid = -1; return; }
        if (hipOccupancyMaxActiveBlocksPerMultiprocessor(&per_cu, (const void*)mega_fwd, NWAVES * 64, LDS_BYTES) != hipSuccess || per_cu < 1) { fprintf(stderr, "kernel_launch: occupancy query says %d blocks per CU; nothing launched\n", per_cu); (void)hipGetLastError(); grid = -1; return; }
        grid = cus;
        if (grid % 8 != 0 || grid < 8) fprintf(stderr, "kernel_launch: note: %d CUs\n", grid);
    }
    if (grid < 0) return;
    if (hipMemsetAsync((char*)d_ws + WS_CTL, 0, CTL_ZERO_BYTES, stream) != hipSuccess) { fprintf(stderr, "kernel_launch: memset failed\n"); return; }
    Args a{};
    for (int i = 0; i < 23; ++i) a.in[i] = (const float*)d_in[i];
    a.out = (float*)d_out; a.ws = (unsigned char*)d_ws;
#if MK_PER_PHASE
    for (int ph = 0; ph < N_PHASES; ++ph) { a.ph_lo = ph; a.ph_hi = ph + 1; hipLaunchKernelGGL(mega_fwd, dim3(grid), dim3(NWAVES * 64), LDS_BYTES, stream, a); }
#else
    a.ph_lo = 0; a.ph_hi = N_PHASES;
    hipLaunchKernelGGL(mega_fwd, dim3(grid), dim3(NWAVES * 64), LDS_BYTES, stream, a);
#endif
    const hipError_t le = hipPeekAtLastError();
    if (le != hipSuccess) fprintf(stderr, "kernel_launch: launch failed: %s\n", hipGetErrorName(le));
}
```

```cpp
#include <hip/hip_runtime.h>
#include <cstdio>
#include <cstdint>
#include <cmath>

__device__ const float ROPE_COS[64 * 16] = {
  1.000000000e+00f, 1.000000000e+00f, 1.000000000e+00f, 1.000000000e+00f, 1.000000000e+00f, 1.000000000e+00f, 1.000000000e+00f, 1.000000000e+00f, 1.000000000e+00f, 1.000000000e+00f, 1.000000000e+00f, 1.000000000e+00f, 1.000000000e+00f, 1.000000000e+00f, 1.000000000e+00f, 1.000000000e+00f,
  5.403023059e-01f, 8.460091103e-01f, 9.504152803e-01f, 9.842302345e-01f, 9.950041653e-01f, 9.984192778e-01f, 9.995000417e-01f, 9.998418903e-01f, 9.999500004e-01f, 9.999841887e-01f, 9.999950000e-01f, 9.999984189e-01f, 9.999995000e-01f, 9.999998419e-01f, 9.999999500e-01f, 9.999999842e-01f,
  -4.161468365e-01f, 4.314628294e-01f, 8.065784099e-01f, 9.374183089e-01f, 9.800665778e-01f, 9.936821085e-01f, 9.980006666e-01f, 9.993676111e-01f, 9.998000067e-01f, 9.999367551e-01f, 9.999800001e-01f, 9.999936755e-01f, 9.999980000e-01f, 9.999993675e-01f, 9.999998000e-01f, 9.999999368e-01f,
  -9.899924966e-01f, -1.159661415e-01f, 5.827536107e-01f, 8.610406494e-01f, 9.553364891e-01f, 9.858034685e-01f, 9.955033740e-01f, 9.985773125e-01f, 9.995500337e-01f, 9.998577009e-01f, 9.999550003e-01f, 9.999857698e-01f, 9.999955000e-01f, 9.999985770e-01f, 9.999995500e-01f, 9.999998577e-01f,
  -6.536436209e-01f, -6.276796538e-01f, 3.011374626e-01f, 7.575061717e-01f, 9.210609940e-01f, 9.748082656e-01f, 9.920106610e-01f, 9.974712444e-01f, 9.992001067e-01f, 9.997470285e-01f, 9.999200011e-01f, 9.999747019e-01f, 9.999920000e-01f, 9.999974702e-01f, 9.999992000e-01f, 9.999997470e-01f,
  2.836621855e-01f, -9.460792693e-01f, -1.034231891e-02f, 6.300803045e-01f, 8.775825619e-01f, 9.607312606e-01f, 9.875260200e-01f, 9.960497564e-01f, 9.987502604e-01f, 9.996047413e-01f, 9.998750026e-01f, 9.999604718e-01f, 9.999875000e-01f, 9.999960472e-01f, 9.999987500e-01f, 9.999996047e-01f,
  9.601702867e-01f, -9.731037080e-01f, -3.207964584e-01f, 4.827820000e-01f, 8.253356149e-01f, 9.436169571e-01f, 9.820539352e-01f, 9.943132982e-01f, 9.982005399e-01f, 9.994308440e-01f, 9.998200054e-01f, 9.999430795e-01f, 9.999820001e-01f, 9.999943079e-01f, 9.999982000e-01f, 9.999994308e-01f,
  7.539022543e-01f, -7.004299352e-01f, -5.994373930e-01f, 3.202569776e-01f, 7.648421873e-01f, 9.235194611e-01f, 9.755998784e-01f, 9.922624187e-01f, 9.975510003e-01f, 9.992253420e-01f, 9.997550100e-01f, 9.999225252e-01f, 9.999755001e-01f, 9.999922524e-01f, 9.999975500e-01f, 9.999992252e-01f,
  -1.455000338e-01f, -2.120365045e-01f, -8.186324573e-01f, 1.476312003e-01f, 6.967067093e-01f, 9.005023096e-01f, 9.681703030e-01f, 9.898977666e-01f, 9.968017063e-01f, 9.989882418e-01f, 9.996800171e-01f, 9.998988088e-01f, 9.999680002e-01f, 9.999898807e-01f, 9.999968000e-01f, 9.999989881e-01f,
  -9.111302619e-01f, 3.416603061e-01f, -9.566441996e-01f, -2.965079584e-02f, 6.216099683e-01f, 8.746382701e-01f, 9.597726380e-01f, 9.872200896e-01f, 9.959527330e-01f, 9.987195509e-01f, 9.995950273e-01f, 9.998719305e-01f, 9.999595003e-01f, 9.999871928e-01f, 9.999959500e-01f, 9.999987193e-01f,
  -8.390715291e-01f, 7.901319677e-01f, -9.997860729e-01f, -2.059976198e-01f, 5.403023059e-01f, 8.460091103e-01f, 9.504152803e-01f, 9.842302345e-01f, 9.950041653e-01f, 9.984192778e-01f, 9.995000417e-01f, 9.998418903e-01f, 9.999500004e-01f, 9.999841887e-01f, 9.999950000e-01f, 9.999984189e-01f,
  4.425697988e-03f, 9.952573799e-01f, -9.437797217e-01f, -3.758473754e-01f, 4.535961214e-01f, 8.147053397e-01f, 9.401075865e-01f, 9.809291466e-01f, 9.939560980e-01f, 9.980874320e-01f, 9.993950610e-01f, 9.998086883e-01f, 9.999395006e-01f, 9.999808683e-01f, 9.999939500e-01f, 9.999980868e-01f,
  8.438539587e-01f, 8.938616532e-01f, -7.941792645e-01f, -5.338430810e-01f, 3.623577545e-01f, 7.808259235e-01f, 9.288598634e-01f, 9.773178698e-01f, 9.928086359e-01f, 9.977240240e-01f, 9.992800864e-01f, 9.997723246e-01f, 9.999280009e-01f, 9.999772317e-01f, 9.999928000e-01f, 9.999977232e-01f,
  9.074467815e-01f, 5.171728240e-01f, -5.658204948e-01f, -6.750016262e-01f, 2.674988286e-01f, 7.444779696e-01f, 9.166833580e-01f, 9.733975461e-01f, 9.915618937e-01f, 9.973290652e-01f, 9.991551190e-01f, 9.997327994e-01f, 9.999155012e-01f, 9.999732789e-01f, 9.999915500e-01f, 9.999973279e-01f,
  1.367372182e-01f, -1.879581181e-02f, -2.813496238e-01f, -7.948709366e-01f, 1.699671429e-01f, 7.057763899e-01f, 9.035902455e-01f, 9.691694153e-01f, 9.902159962e-01f, 9.969025682e-01f, 9.990201601e-01f, 9.996901128e-01f, 9.999020016e-01f, 9.999690098e-01f, 9.999902000e-01f, 9.999969010e-01f,
  -7.596879129e-01f, -5.489756801e-01f, 3.102253171e-02f, -8.896703905e-01f, 7.073720167e-02f, 6.648435374e-01f, 8.895936181e-01f, 9.646348142e-01f, 9.887710779e-01f, 9.964445465e-01f, 9.988752109e-01f, 9.996442649e-01f, 9.998875021e-01f, 9.999644246e-01f, 9.999887500e-01f, 9.999964424e-01f,
  -9.576594803e-01f, -9.100810415e-01f, 3.403182001e-01f, -9.564100574e-01f, -2.919952230e-02f, 6.218088190e-01f, 8.747074712e-01f, 9.597951768e-01f, 9.872272834e-01f, 9.959550145e-01f, 9.987202730e-01f, 9.995952558e-01f, 9.998720027e-01f, 9.999595231e-01f, 9.999872000e-01f, 9.999959523e-01f,
  -2.751633381e-01f, -9.908980244e-01f, 6.158647034e-01f, -9.929849996e-01f, -1.288444943e-01f, 5.768082866e-01f, 8.589466897e-01f, 9.546520336e-01f, 9.855847669e-01f, 9.954339878e-01f, 9.985553480e-01f, 9.995430857e-01f, 9.998555035e-01f, 9.999543054e-01f, 9.999855500e-01f, 9.999954305e-01f,
  6.603167082e-01f, -7.665364704e-01f, 8.303362493e-01f, -9.982416606e-01f, -2.272020947e-01f, 5.299842069e-01f, 8.423270331e-01f, 9.492070108e-01f, 9.838436928e-01f, 9.948814827e-01f, 9.983804374e-01f, 9.994877548e-01f, 9.998380044e-01f, 9.999487715e-01f, 9.999838000e-01f, 9.999948771e-01f,
  9.887046182e-01f, -3.060956503e-01f, 9.624638147e-01f, -9.720142477e-01f, -3.232895669e-01f, 4.814846115e-01f, 8.248651197e-01f, 9.434618303e-01f, 9.820042351e-01f, 9.942975168e-01f, 9.981955429e-01f, 9.994292632e-01f, 9.998195054e-01f, 9.999429214e-01f, 9.999819501e-01f, 9.999942921e-01f,
  4.080820618e-01f, 2.486170528e-01f, 9.991443830e-01f, -9.151299613e-01f, -4.161468365e-01f, 4.314628294e-01f, 8.065784099e-01f, 9.374183089e-01f, 9.800665778e-01f, 9.936821085e-01f, 9.980006666e-01f, 9.993676111e-01f, 9.998000067e-01f, 9.999367551e-01f, 9.999800001e-01f, 9.999936755e-01f,
  -5.477292602e-01f, 7.267602337e-01f, 9.367403630e-01f, -8.293829050e-01f, -5.048461046e-01f, 3.800770014e-01f, 7.874851889e-01f, 9.310783576e-01f, 9.780309147e-01f, 9.930352774e-01f, 9.977958102e-01f, 9.993027988e-01f, 9.997795081e-01f, 9.999302726e-01f, 9.999779501e-01f, 9.999930272e-01f,
  -9.999608264e-01f, 9.810745045e-01f, 7.814403262e-01f, -7.174775009e-01f, -5.885011173e-01f, 3.274895812e-01f, 7.676045483e-01f, 9.244439812e-01f, 9.758974493e-01f, 9.923570438e-01f, 9.975809759e-01f, 9.992348264e-01f, 9.997580098e-01f, 9.999234739e-01f, 9.999758001e-01f, 9.999923473e-01f,
  -5.328330203e-01f, 9.332357037e-01f, 5.486452902e-01f, -5.829431928e-01f, -6.662760213e-01f, 2.738668208e-01f, 7.469563671e-01f, 9.175172776e-01f, 9.736663950e-01f, 9.916474291e-01f, 9.973561658e-01f, 9.991636942e-01f, 9.997355117e-01f, 9.999163589e-01f, 9.999735501e-01f, 9.999916358e-01f,
  4.241790073e-01f, 5.979773102e-01f, 2.614414084e-01f, -4.300231298e-01f, -7.373937155e-01f, 2.193782457e-01f, 7.255612918e-01f, 9.103004373e-01f, 9.713379749e-01f, 9.909064559e-01f, 9.971213821e-01f, 9.990894023e-01f, 9.997120138e-01f, 9.999089278e-01f, 9.999712001e-01f, 9.999908927e-01f,
  9.912028119e-01f, 7.855280068e-02f, -5.168947139e-02f, -2.635403389e-01f, -8.011436155e-01f, 1.641961185e-01f, 7.034407157e-01f, 9.027957423e-01f, 9.689124217e-01f, 9.901341476e-01f, 9.968766273e-01f, 9.990119510e-01f, 9.996875163e-01f, 9.999011805e-01f, 9.999687502e-01f, 9.999901179e-01f,
  6.469193223e-01f, -4.650645402e-01f, -3.596943353e-01f, -8.874560929e-02f, -8.568887534e-01f, 1.084948944e-01f, 6.806167575e-01f, 8.950055657e-01f, 9.663899781e-01f, 9.893305286e-01f, 9.966219036e-01f, 9.989313405e-01f, 9.996620190e-01f, 9.998931169e-01f, 9.999662002e-01f, 9.999893115e-01f,
  -2.921388087e-01f, -8.654504764e-01f, -6.320285135e-01f, 8.884811520e-02f, -9.040721420e-01f, 5.245066969e-02f, 6.571122393e-01f, 8.869323709e-01f, 9.637708964e-01f, 9.884956243e-01f, 9.963572138e-01f, 9.988475712e-01f, 9.996355221e-01f, 9.998847372e-01f, 9.999635502e-01f, 9.999884735e-01f,
  -9.626058663e-01f, -9.992934349e-01f, -8.416847784e-01f, 2.636396118e-01f, -9.422223407e-01f, -3.759374883e-03f, 6.329506635e-01f, 8.785787110e-01f, 9.610554383e-01f, 9.876294611e-01f, 9.960825604e-01f, 9.987606432e-01f, 9.996080256e-01f, 9.998760413e-01f, 9.999608003e-01f, 9.999876039e-01f,
  -7.480575297e-01f, -8.253722231e-01f, -9.678716355e-01f, 4.301160387e-01f, -9.709581651e-01f, -5.995753440e-02f, 6.081561899e-01f, 8.699472273e-01f, 9.582438755e-01f, 9.867320664e-01f, 9.957979462e-01f, 9.986705569e-01f, 9.995795295e-01f, 9.998670292e-01f, 9.999579503e-01f, 9.999867027e-01f,
  1.542514499e-01f, -3.972514054e-01f, -9.980752051e-01f, 5.830268074e-01f, -9.899924966e-01f, -1.159661415e-01f, 5.827536107e-01f, 8.610406494e-01f, 9.553364891e-01f, 9.858034685e-01f, 9.955033740e-01f, 9.985773125e-01f, 9.995500337e-01f, 9.998577009e-01f, 9.999550003e-01f, 9.999857698e-01f,
  9.147423578e-01f, 1.532156071e-01f, -9.293002159e-01f, 7.175491840e-01f, -9.991351503e-01f, -1.716081281e-01f, 5.567683265e-01f, 8.518617938e-01f, 9.523335699e-01f, 9.848436969e-01f, 9.951988468e-01f, 9.984809103e-01f, 9.995195385e-01f, 9.998480564e-01f, 9.999519504e-01f, 9.999848053e-01f,
  8.342233605e-01f, 6.564950042e-01f, -7.683670453e-01f, 8.294403958e-01f, -9.982947758e-01f, -2.267075851e-01f, 5.302263203e-01f, 8.424135629e-01f, 9.492354181e-01f, 9.838527819e-01f, 9.948843676e-01f, 9.983813507e-01f, 9.994880437e-01f, 9.998380958e-01f, 9.999488004e-01f, 9.999838092e-01f,
  -1.327674722e-02f, 9.575859018e-01f, -5.312353455e-01f, 9.151714465e-01f, -9.874797699e-01f, -2.810903188e-01f, 5.031541321e-01f, 8.326989444e-01f, 9.460423435e-01f, 9.828307548e-01f, 9.945599395e-01f, 9.982786339e-01f, 9.994555494e-01f, 9.998278189e-01f, 9.999455505e-01f, 9.999827814e-01f,
  -8.485702748e-01f, 9.637577894e-01f, -2.414213342e-01f, 9.720384190e-01f, -9.667981926e-01f, -3.345844009e-01f, 4.755788316e-01f, 8.227210104e-01f, 9.427546655e-01f, 9.817776480e-01f, 9.942255659e-01f, 9.981727603e-01f, 9.994220557e-01f, 9.998172259e-01f, 9.999422006e-01f, 9.999817221e-01f,
  -9.036922051e-01f, 6.731098380e-01f, 7.233429552e-02f, 9.982477555e-01f, -9.364566873e-01f, -3.870207132e-01f, 4.475279919e-01f, 8.124829160e-01f, 9.393727128e-01f, 9.806934947e-01f, 9.938812501e-01f, 9.980637301e-01f, 9.993875625e-01f, 9.998063167e-01f, 9.999387506e-01f, 9.999806311e-01f,
  -1.279636896e-01f, 1.751563210e-01f, 3.789165737e-01f, 9.929728260e-01f, -8.967584163e-01f, -4.382334809e-01f, 4.190296615e-01f, 8.019878987e-01f, 9.358968237e-01f, 9.795783292e-01f, 9.935269954e-01f, 9.979515438e-01f, 9.993520700e-01f, 9.997950914e-01f, 9.999352007e-01f, 9.999795085e-01f,
  7.654140519e-01f, -3.767421515e-01f, 6.479219076e-01f, 9.563799991e-01f, -8.481000317e-01f, -4.880607978e-01f, 3.901123364e-01f, 7.912392773e-01f, 9.323273456e-01f, 9.784321869e-01f, 9.931628054e-01f, 9.978362017e-01f, 9.993155781e-01f, 9.997835499e-01f, 9.999315508e-01f, 9.999783543e-01f,
  9.550736440e-01f, -8.126109057e-01f, 8.526731891e-01f, 8.896233956e-01f, -7.909677119e-01f, -5.363451377e-01f, 3.608049314e-01f, 7.802404506e-01f, 9.286646356e-01f, 9.772551038e-01f, 9.927886839e-01f, 9.977177042e-01f, 9.992780869e-01f, 9.997716922e-01f, 9.999278009e-01f, 9.999771684e-01f,
  2.666429324e-01f, -9.982103072e-01f, 9.728653484e-01f, 7.948084874e-01f, -7.259323042e-01f, -5.829338522e-01f, 3.311367516e-01f, 7.689948967e-01f, 9.249090599e-01f, 9.760471174e-01f, 9.924046345e-01f, 9.975960516e-01f, 9.992395964e-01f, 9.997595184e-01f, 9.999239510e-01f, 9.999759510e-01f,
  -6.669380617e-01f, -8.763791221e-01f, 9.965789963e-01f, 6.749256921e-01f, -6.536436209e-01f, -6.276796538e-01f, 3.011374626e-01f, 7.575061717e-01f, 9.210609940e-01f, 9.748082656e-01f, 9.920106610e-01f, 9.974712444e-01f, 9.992001067e-01f, 9.997470285e-01f, 9.999200011e-01f, 9.999747019e-01f,
  -9.873392775e-01f, -4.846391354e-01f, 9.214624639e-01f, 5.337560571e-01f, -5.748239465e-01f, -6.704410810e-01f, 2.708370612e-01f, 7.457779085e-01f, 9.171208228e-01f, 9.735385879e-01f, 9.916067674e-01f, 9.973432828e-01f, 9.991596177e-01f, 9.997342223e-01f, 9.999159512e-01f, 9.999734212e-01f,
  -3.999853150e-01f, 5.636087450e-02f, 7.549650153e-01f, 3.757520063e-01f, -4.902608213e-01f, -7.110829460e-01f, 2.402658454e-01f, 7.338138159e-01f, 9.130889403e-01f, 9.722381242e-01f, 9.911929578e-01f, 9.972121674e-01f, 9.991181296e-01f, 9.997211001e-01f, 9.999118013e-01f, 9.999721088e-01f,
  5.551133015e-01f, 5.800027620e-01f, 5.135981094e-01f, 2.058969135e-01f, -4.007991721e-01f, -7.494767618e-01f, 2.094543837e-01f, 7.216176770e-01f, 9.089657497e-01f, 9.709069157e-01f, 9.907692362e-01f, 9.970778985e-01f, 9.990756424e-01f, 9.997076617e-01f, 9.999075514e-01f, 9.999707649e-01f,
  9.998433086e-01f, 9.250143668e-01f, 2.212979668e-01f, 2.954792850e-02f, -3.073328700e-01f, -7.855011484e-01f, 1.784334851e-01f, 7.091933487e-01f, 9.047516632e-01f, 9.695450046e-01f, 9.903356070e-01f, 9.969404766e-01f, 9.990321562e-01f, 9.996939071e-01f, 9.999032016e-01f, 9.999693893e-01f,
  5.253219888e-01f, 9.851384009e-01f, -9.294817111e-02f, -1.477329843e-01f, -2.107957994e-01f, -8.190422169e-01f, 1.472341679e-01f, 6.965447596e-01f, 9.004471024e-01f, 9.681524338e-01f, 9.898920744e-01f, 9.967999021e-01f, 9.989876708e-01f, 9.996798365e-01f, 9.998987517e-01f, 9.999679821e-01f,
  -4.321779449e-01f, 7.418577573e-01f, -3.979766910e-01f, -3.203544680e-01f, -1.121525269e-01f, -8.499939289e-01f, 1.158876288e-01f, 6.836759095e-01f, 8.960524975e-01f, 9.667292474e-01f, 9.894386429e-01f, 9.966561754e-01f, 9.989421865e-01f, 9.996654497e-01f, 9.998942019e-01f, 9.999665433e-01f,
  -9.923354692e-01f, 2.700984415e-01f, -6.635380855e-01f, -4.828721220e-01f, -1.238866346e-02f, -8.782584324e-01f, 8.442521171e-02f, 6.705908678e-01f, 8.915682882e-01f, 9.652754904e-01f, 9.889753170e-01f, 9.965092971e-01f, 9.988957033e-01f, 9.996507468e-01f, 9.998895520e-01f, 9.999650728e-01f,
  -6.401443395e-01f, -2.848462729e-01f, -8.632967800e-01f, -6.301602158e-01f, 8.749898344e-02f, -9.037463706e-01f, 5.287837645e-02f, 6.572937723e-01f, 8.869949228e-01f, 9.637912089e-01f, 9.885021014e-01f, 9.963592674e-01f, 9.988482212e-01f, 9.996357277e-01f, 9.998848022e-01f, 9.999635708e-01f,
  3.005925437e-01f, -7.520635254e-01f, -9.774428167e-01f, -7.575733518e-01f, 1.865123694e-01f, -9.263771649e-01f, 2.127866722e-02f, 6.437888276e-01f, 8.823328586e-01f, 9.622764496e-01f, 9.880190008e-01f, 9.962060871e-01f, 9.987997402e-01f, 9.996203926e-01f, 9.998799524e-01f, 9.999620371e-01f,
  9.649660285e-01f, -9.876589150e-01f, -9.946563971e-01f, -8.610929796e-01f, 2.836621855e-01f, -9.460792693e-01f, -1.034231891e-02f, 6.300803045e-01f, 8.775825619e-01f, 9.607312606e-01f, 9.875260200e-01f, 9.960497564e-01f, 9.987502604e-01f, 9.996047413e-01f, 9.998750026e-01f, 9.999604718e-01f,
  7.421541968e-01f, -9.190733545e-01f, -9.132304601e-01f, -9.374541386e-01f, 3.779777427e-01f, -9.627903967e-01f, -4.195296357e-02f, 6.161725377e-01f, 8.727445076e-01f, 9.591556907e-01f, 9.870231639e-01f, 9.958902760e-01f, 9.986997819e-01f, 9.995887740e-01f, 9.998699528e-01f, 9.999588749e-01f,
  -1.629907808e-01f, -5.674299469e-01f, -7.412399703e-01f, -9.842484337e-01f, 4.685166713e-01f, -9.764577158e-01f, -7.352165877e-02f, 6.020699252e-01f, 8.678191797e-01f, 9.575497897e-01f, 9.865104376e-01f, 9.957276462e-01f, 9.986483046e-01f, 9.995724905e-01f, 9.998648030e-01f, 9.999572463e-01f,
  -9.182827862e-01f, -4.102845452e-02f, -4.957411282e-01f, -9.999999947e-01f, 5.543743362e-01f, -9.870380181e-01f, -1.050168384e-01f, 5.877769265e-01f, 8.628070705e-01f, 9.559136084e-01f, 9.859878462e-01f, 9.955618678e-01f, 9.985958287e-01f, 9.995558910e-01f, 9.998595533e-01f, 9.999555861e-01f,
  -8.293098329e-01f, 4.980090543e-01f, -2.010799162e-01f, -9.842120249e-01f, 6.346928759e-01f, -9.944978545e-01f, -1.364070100e-01f, 5.732980613e-01f, 8.577086814e-01f, 9.542471985e-01f, 9.854553950e-01f, 9.953929410e-01f, 9.985423543e-01f, 9.995389753e-01f, 9.998542035e-01f, 9.999538943e-01f,
  2.212675626e-02f, 8.836688484e-01f, 1.135222784e-01f, -9.373824693e-01f, 7.086697743e-01f, -9.988136413e-01f, -1.676607860e-01f, 5.586379081e-01f, 8.525245221e-01f, 9.525506128e-01f, 9.849130892e-01f, 9.952208666e-01f, 9.984878812e-01f, 9.995217436e-01f, 9.998487538e-01f, 9.999521709e-01f,
  8.532201077e-01f, 9.971747381e-01f, 4.168665323e-01f, -8.609883102e-01f, 7.755658785e-01f, -9.999717342e-01f, -1.987469151e-01f, 5.438011027e-01f, 8.472551110e-01f, 9.508239048e-01f, 9.843609343e-01f, 9.950456450e-01f, 9.984324097e-01f, 9.995041958e-01f, 9.998432041e-01f, 9.999504159e-01f,
  8.998668270e-01f, 8.035689776e-01f, 6.788703658e-01f, -7.574389836e-01f, 8.347127848e-01f, -9.979684721e-01f, -2.296343139e-01f, 5.287923369e-01f, 8.419009752e-01f, 9.490671292e-01f, 9.837989357e-01f, 9.948672768e-01f, 9.983759398e-01f, 9.994863320e-01f, 9.998375544e-01f, 9.999486292e-01f,
  1.191801354e-01f, 3.624786135e-01f, 8.735510056e-01f, -6.300003866e-01f, 8.855195169e-01f, -9.928101881e-01f, -2.602920974e-01f, 5.136163566e-01f, 8.364626499e-01f, 9.472803416e-01f, 9.832270992e-01f, 9.946857625e-01f, 9.983184715e-01f, 9.994681520e-01f, 9.998318047e-01f, 9.999468110e-01f,
  -7.710802230e-01f, -1.902485591e-01f, 9.816020819e-01f, -4.826918728e-01f, 9.274784307e-01f, -9.845131900e-01f, -2.906896106e-01f, 4.982779609e-01f, 8.309406791e-01f, 9.454635984e-01f, 9.826454305e-01f, 9.945011028e-01f, 9.982600048e-01f, 9.994496561e-01f, 9.998259550e-01f, 9.999449611e-01f,
  -9.524129804e-01f, -6.843826418e-01f, 9.923082299e-01f, -3.201594838e-01f, 9.601702867e-01f, -9.731037080e-01f, -3.207964584e-01f, 4.827820000e-01f, 8.253356149e-01f, 9.436169571e-01f, 9.820539352e-01f, 9.943132982e-01f, 9.982005399e-01f, 9.994308440e-01f, 9.998200054e-01f, 9.999430795e-01f,
  -2.581016359e-01f, -9.677393408e-01f, 9.046077269e-01f, -1.475294147e-01f, 9.832684384e-01f, -9.586178129e-01f, -3.505825365e-01f, 4.671333740e-01f, 8.196480178e-01f, 9.417404761e-01f, 9.814526195e-01f, 9.941223493e-01f, 9.981400768e-01f, 9.994117159e-01f, 9.998139558e-01f, 9.999411664e-01f,
  6.735071623e-01f, -9.530499555e-01f, 7.271977827e-01f, 2.975366287e-02f, 9.965420970e-01f, -9.411013007e-01f, -3.800180612e-01f, 4.513370314e-01f, 8.138784567e-01f, 9.398342148e-01f, 9.808414892e-01f, 9.939282566e-01f, 9.980786156e-01f, 9.993922718e-01f, 9.998078062e-01f, 9.999392216e-01f,
  9.858965816e-01f, -6.448385490e-01f, 4.776720420e-01f, 2.060983239e-01f, 9.998586364e-01f, -9.206095492e-01f, -4.090735996e-01f, 4.353979673e-01f, 8.080275083e-01f, 9.378982333e-01f, 9.802205506e-01f, 9.937310210e-01f, 9.980161563e-01f, 9.993725116e-01f, 9.998015566e-01f, 9.999372453e-01f,
};
__device__ const float ROPE_SIN[64 * 16] = {
  0.000000000e+00f, 0.000000000e+00f, 0.000000000e+00f, 0.000000000e+00f, 0.000000000e+00f, 0.000000000e+00f, 0.000000000e+00f, 0.000000000e+00f, 0.000000000e+00f, 0.000000000e+00f, 0.000000000e+00f, 0.000000000e+00f, 0.000000000e+00f, 0.000000000e+00f, 0.000000000e+00f, 0.000000000e+00f,
  8.414709848e-01f, 5.331684399e-01f, 3.109835929e-01f, 1.768921862e-01f, 9.983341665e-02f, 5.620449921e-02f, 3.161750640e-02f, 1.778185688e-02f, 9.999833334e-03f, 5.623383614e-03f, 3.162272390e-03f, 1.778278473e-03f, 9.999998333e-04f, 5.623412956e-04f, 3.162277607e-04f, 1.778279401e-04f,
  9.092974268e-01f, 9.021307150e-01f, 5.911271172e-01f, 3.482052759e-01f, 1.986693308e-01f, 1.122313110e-01f, 6.320339793e-02f, 3.555809079e-02f, 1.999866669e-02f, 1.124658940e-02f, 6.324513157e-03f, 3.556551322e-03f, 1.999998667e-03f, 1.124682413e-03f, 6.324554899e-04f, 3.556558745e-04f,
  1.411200081e-01f, 9.932531671e-01f, 8.126488966e-01f, 5.085361344e-01f, 2.955202067e-01f, 1.679033098e-01f, 9.472609133e-02f, 5.332308054e-02f, 2.999550020e-02f, 1.686943954e-02f, 9.486690679e-03f, 5.334812925e-03f, 2.999995500e-03f, 1.687023175e-03f, 9.486831557e-04f, 5.334837977e-04f,
  -7.568024953e-01f, 7.784717415e-01f, 9.535807405e-01f, 6.528280017e-01f, 3.894183423e-01f, 2.230444916e-01f, 1.261540665e-01f, 7.107120850e-02f, 3.998933419e-02f, 2.249175622e-02f, 1.264877333e-02f, 7.113057657e-03f, 3.999989333e-03f, 2.249363404e-03f, 1.264910727e-03f, 7.113117040e-04f,
  -9.589242747e-01f, 3.239352036e-01f, 9.999465168e-01f, 7.765299800e-01f, 4.794255386e-01f, 2.774805306e-01f, 1.574558982e-01f, 8.879686236e-02f, 4.997916927e-02f, 2.811336166e-02f, 1.581072950e-02f, 8.891279896e-03f, 4.999979167e-03f, 2.811702921e-03f, 1.581138171e-03f, 8.891395879e-04f,
  -2.794154982e-01f, -2.303674747e-01f, 9.471481575e-01f, 8.757405669e-01f, 5.646424734e-01f, 3.310393303e-01f, 1.886002871e-01f, 1.064944369e-01f, 5.996400648e-02f, 3.373407807e-02f, 1.897252756e-02f, 1.066947402e-02f, 5.999964000e-03f, 3.374041549e-03f, 1.897365458e-03f, 1.066967444e-03f,
  6.569865987e-01f, -7.137211682e-01f, 8.004216463e-01f, 9.473307069e-01f, 6.442176872e-01f, 3.835515676e-01f, 2.195560914e-01f, 1.241583359e-01f, 6.994284734e-02f, 3.935372772e-02f, 2.213413590e-02f, 1.244763440e-02f, 6.999942833e-03f, 3.936379111e-03f, 2.213592554e-03f, 1.244795266e-03f,
  9.893582466e-01f, -9.772617463e-01f, 5.743177691e-01f, 9.890424807e-01f, 7.173560909e-01f, 4.348512280e-01f, 2.502923579e-01f, 1.417829736e-01f, 7.991469397e-02f, 4.497213290e-02f, 2.529552289e-02f, 1.422575542e-02f, 7.999914667e-03f, 4.498715427e-03f, 2.529819430e-03f, 1.422623048e-03f,
  4.121184852e-01f, -9.398235128e-01f, 2.912591207e-01f, 9.995603185e-01f, 7.833269096e-01f, 4.847761303e-01f, 2.807783529e-01f, 1.593627767e-01f, 8.987854920e-02f, 5.058911594e-02f, 2.845665693e-02f, 1.600383145e-02f, 8.999878500e-03f, 5.061050321e-03f, 2.846046052e-03f, 1.600450786e-03f,
  -5.440211109e-01f, -6.129367615e-01f, -2.068353153e-02f, 9.785524925e-01f, 8.414709848e-01f, 5.331684399e-01f, 3.109835929e-01f, 1.768921862e-01f, 9.983341665e-02f, 5.620449921e-02f, 3.161750640e-02f, 1.778185688e-02f, 9.999833334e-03f, 5.623383614e-03f, 3.162272390e-03f, 1.778278473e-03f,
  -9.999902066e-01f, -9.727665569e-02f, -3.305750095e-01f, 9.266815798e-01f, 8.912073601e-01f, 5.798751671e-01f, 3.408778753e-01f, 1.943656590e-01f, 1.097783008e-01f, 6.181810515e-02f, 3.477803970e-02f, 1.955982607e-02f, 1.099977817e-02f, 6.185715129e-03f, 3.478498411e-03f, 1.956106104e-03f,
  -5.365729180e-01f, 4.483428876e-01f, -6.076835491e-01f, 8.455835647e-01f, 9.320390860e-01f, 6.247486512e-01f, 3.704313082e-01f, 2.117776696e-01f, 1.197122073e-01f, 6.742975624e-02f, 3.793822522e-02f, 2.133773341e-02f, 1.199971200e-02f, 6.748044688e-03f, 3.794724085e-03f, 2.133933673e-03f,
  4.201670368e-01f, 8.558809906e-01f, -8.245284517e-01f, 7.378162404e-01f, 9.635581854e-01f, 6.676470271e-01f, 3.996143406e-01f, 2.291227120e-01f, 1.296341426e-01f, 7.303927501e-02f, 4.109803135e-02f, 2.311557328e-02f, 1.299963384e-02f, 7.310372113e-03f, 4.110949379e-03f, 2.311761174e-03f,
  9.906073557e-01f, 9.998233431e-01f, -9.596053299e-01f, 6.067785379e-01f, 9.854497300e-01f, 7.084346741e-01f, 4.283977921e-01f, 2.463953013e-01f, 1.395431146e-01f, 7.864648408e-02f, 4.425742651e-02f, 2.489334005e-02f, 1.399954267e-02f, 7.872697226e-03f, 4.427174262e-03f, 2.489588602e-03f,
  6.502878402e-01f, 8.358383233e-01f, -9.995186854e-01f, 4.566033249e-01f, 9.974949866e-01f, 7.469826442e-01f, 4.567528814e-01f, 2.635899757e-01f, 1.494381325e-01f, 8.425120614e-02f, 4.741637909e-02f, 2.667102809e-02f, 1.499943751e-02f, 8.435019850e-03f, 4.743398702e-03f, 2.667415952e-03f,
  -2.879033167e-01f, 4.144303293e-01f, -9.403103332e-01f, 2.920270571e-01f, 9.995736030e-01f, 7.831690702e-01f, 4.846512559e-01f, 2.807012978e-01f, 1.593182066e-01f, 8.985326395e-02f, 5.057485751e-02f, 2.844863180e-02f, 1.599931734e-02f, 8.997339806e-03f, 5.059622668e-03f, 2.845243217e-03f,
  -9.613974919e-01f, -1.346146549e-01f, -7.878519322e-01f, 1.182403929e-01f, 9.916648105e-01f, 8.168795508e-01f, 5.120650195e-01f, 2.977238566e-01f, 1.691823491e-01f, 9.545248036e-02f, 5.373283018e-02f, 3.022614554e-02f, 1.699918118e-02f, 9.559656917e-03f, 5.375846129e-03f, 3.023070392e-03f,
  -7.509872468e-01f, -6.422007782e-01f, -5.572626967e-01f, -5.927551787e-02f, 9.738476309e-01f, 8.480075120e-01f, 5.389667608e-01f, 3.146522694e-01f, 1.790295734e-01f, 1.010486783e-01f, 5.689026552e-02f, 3.200356370e-02f, 1.799902802e-02f, 1.012197101e-02f, 5.692069051e-03f, 3.200897472e-03f,
  1.498772097e-01f, -9.520007631e-01f, -2.714100320e-01f, -2.349219066e-01f, 9.463000877e-01f, 8.764545447e-01f, 5.653295802e-01f, 3.314811830e-01f, 1.888588950e-01f, 1.066416808e-01f, 6.004713196e-02f, 3.378088066e-02f, 1.899885685e-02f, 1.068428189e-02f, 6.008291404e-03f, 3.378724451e-03f,
  9.129452507e-01f, -9.686018589e-01f, 4.135821352e-02f, -4.031589686e-01f, 9.092974268e-01f, 9.021307150e-01f, 5.911271172e-01f, 3.482052759e-01f, 1.986693308e-01f, 1.122313110e-01f, 6.320339793e-02f, 3.555809079e-02f, 1.999866669e-02f, 1.124658940e-02f, 6.324513157e-03f, 3.556551322e-03f,
  8.366556385e-01f, -6.868912307e-01f, 3.500249882e-01f, -5.586805857e-01f, 8.632093666e-01f, 9.249548492e-01f, 6.163335763e-01f, 3.648192595e-01f, 2.084598998e-01f, 1.178173922e-01f, 6.635903187e-02f, 3.733518848e-02f, 2.099845653e-02f, 1.180889335e-02f, 6.640734277e-03f, 3.734378081e-03f,
  -8.851309290e-03f, -1.936306189e-01f, 6.239799809e-01f, -6.965816792e-01f, 8.084964038e-01f, 9.448547900e-01f, 6.409237532e-01f, 3.813178801e-01f, 2.182296231e-01f, 1.233997476e-01f, 6.951400222e-02f, 3.911216810e-02f, 2.199822538e-02f, 1.237119357e-02f, 6.956954733e-03f, 3.912204722e-03f,
  -8.462204042e-01f, 3.592646954e-01f, 8.360552287e-01f, -8.125129131e-01f, 7.457052122e-01f, 9.617676250e-01f, 6.648730598e-01f, 3.976959206e-01f, 2.279775235e-01f, 1.289782009e-01f, 7.266827742e-02f, 4.088902404e-02f, 2.299797222e-02f, 1.293348988e-02f, 7.273174493e-03f, 4.090031240e-03f,
  -9.055783620e-01f, 8.015130295e-01f, 9.652193481e-01f, -9.028178708e-01f, 6.754631806e-01f, 9.756398851e-01f, 6.881575487e-01f, 4.139482019e-01f, 2.377026264e-01f, 1.345525755e-01f, 7.582182595e-02f, 4.266575068e-02f, 2.399769607e-02f, 1.349578209e-02f, 7.589393526e-03f, 4.267857628e-03f,
  -1.323517501e-01f, 9.969099546e-01f, 9.986632058e-01f, -9.646483762e-01f, 5.984721441e-01f, 9.864277139e-01f, 7.107539373e-01f, 4.300695848e-01f, 2.474039593e-01f, 1.401226951e-01f, 7.897461625e-02f, 4.444234239e-02f, 2.499739591e-02f, 1.405807004e-02f, 7.905611800e-03f, 4.445683881e-03f,
  7.625584505e-01f, 8.852767779e-01f, 9.330701931e-01f, -9.960543242e-01f, 5.155013718e-01f, 9.940970063e-01f, 7.326396313e-01f, 4.460549713e-01f, 2.570805519e-01f, 1.456883837e-01f, 8.212661682e-02f, 4.621879357e-02f, 2.599707077e-02f, 1.462035354e-02f, 8.221829283e-03f, 4.623509993e-03f,
  9.563759284e-01f, 5.009944839e-01f, 7.749451323e-01f, -9.960451859e-01f, 4.273798802e-01f, 9.986235163e-01f, 7.537927467e-01f, 4.618993065e-01f, 2.667314367e-01f, 1.512494653e-01f, 8.527779611e-02f, 4.799509859e-02f, 2.699671962e-02f, 1.518263242e-02f, 8.538045944e-03f, 4.801335960e-03f,
  2.709057883e-01f, -3.758498280e-02f, 5.399691971e-01f, -9.646212496e-01f, 3.349881502e-01f, 9.999929335e-01f, 7.741921322e-01f, 4.775975802e-01f, 2.763556486e-01f, 1.568057639e-01f, 8.842812263e-02f, 4.977125184e-02f, 2.799634148e-02f, 1.574490650e-02f, 8.854261752e-03f, 4.979161774e-03f,
  -6.636338842e-01f, -5.645889596e-01f, 2.514448194e-01f, -9.027736113e-01f, 2.392493292e-01f, 9.982009287e-01f, 7.938173900e-01f, 4.931448283e-01f, 2.859522251e-01f, 1.623571039e-01f, 9.157756487e-02f, 5.154724769e-02f, 2.899593534e-02f, 1.630717560e-02f, 9.170476674e-03f, 5.156987431e-03f,
  -9.880316241e-01f, -9.177098239e-01f, -6.201520023e-02f, -8.124529167e-01f, 1.411200081e-01f, 9.932531671e-01f, 8.126488966e-01f, 5.085361344e-01f, 2.955202067e-01f, 1.679033098e-01f, 9.472609133e-02f, 5.332308054e-02f, 2.999550020e-02f, 1.686943954e-02f, 9.486690679e-03f, 5.334812925e-03f,
  -4.040376453e-01f, -9.881927837e-01f, -3.693252072e-01f, -6.965078381e-01f, 4.158066243e-02f, 9.851652909e-01f, 8.306678221e-01f, 5.237666315e-01f, 3.050586364e-01f, 1.734442061e-01f, 9.787367054e-02f, 5.509874477e-02f, 3.099503507e-02f, 1.743169815e-02f, 9.802903735e-03f, 5.512638250e-03f,
  5.514266812e-01f, -7.543303715e-01f, -6.400094403e-01f, -5.585952289e-01f, -5.837414343e-02f, 9.739628693e-01f, 8.478561489e-01f, 5.388315034e-01f, 3.145665606e-01f, 1.789796176e-01f, 1.010202710e-01f, 5.687423476e-02f, 3.199453895e-02f, 1.799395124e-02f, 1.011911581e-02f, 5.690463401e-03f,
  9.999118601e-01f, -2.881479492e-01f, -8.472242960e-01f, -4.030647882e-01f, -1.577456941e-01f, 9.596813183e-01f, 8.641966902e-01f, 5.537259863e-01f, 3.240430284e-01f, 1.845093693e-01f, 1.041658613e-01f, 5.864954490e-02f, 3.299401083e-02f, 1.855619865e-02f, 1.043532687e-02f, 5.868288372e-03f,
  5.290826861e-01f, 2.667787912e-01f, -9.704203931e-01f, -2.348218730e-01f, -2.555411020e-01f, 9.423657881e-01f, 8.796731069e-01f, 5.684453703e-01f, 3.334870921e-01f, 1.900332863e-01f, 1.073104099e-01f, 6.042466957e-02f, 3.399344971e-02f, 1.911844019e-02f, 1.075153690e-02f, 6.046113157e-03f,
  -4.281826695e-01f, 7.395425248e-01f, -9.973804438e-01f, -5.917278607e-02f, -3.507832277e-01f, 9.220710209e-01f, 8.942699237e-01f, 5.829850008e-01f, 3.428978075e-01f, 1.955511940e-01f, 1.104538854e-01f, 6.219960316e-02f, 3.499285460e-02f, 1.968067568e-02f, 1.106774584e-02f, 6.223937751e-03f,
  -9.917788534e-01f, 9.845406356e-01f, -9.254308349e-01f, 1.183425828e-01f, -4.425204433e-01f, 8.988611774e-01f, 9.079725452e-01f, 5.973402802e-01f, 3.522742333e-01f, 2.010629178e-01f, 1.135962563e-01f, 6.397434006e-02f, 3.599222450e-02f, 2.024290495e-02f, 1.138395368e-02f, 6.401762149e-03f,
  -6.435381334e-01f, 9.263181696e-01f, -7.617067688e-01f, 2.921254821e-01f, -5.298361409e-01f, 8.728096342e-01f, 9.207672697e-01f, 6.115066689e-01f, 3.616154320e-01f, 2.065682834e-01f, 1.167374914e-01f, 6.574887465e-02f, 3.699155841e-02f, 2.080512781e-02f, 1.170016038e-02f, 6.579586343e-03f,
  2.963685787e-01f, 5.828065854e-01f, -5.224446694e-01f, 4.566948806e-01f, -6.118578909e-01f, 8.439987519e-01f, 9.326413038e-01f, 6.254796874e-01f, 3.709204694e-01f, 2.120671168e-01f, 1.198775590e-01f, 6.752320133e-02f, 3.799085533e-02f, 2.136734410e-02f, 1.201636591e-02f, 6.757410330e-03f,
  9.637953863e-01f, 5.980119189e-02f, -2.313720250e-01f, 6.068603368e-01f, -6.877661592e-01f, 8.125196145e-01f, 9.435827742e-01f, 6.392549170e-01f, 3.801884151e-01f, 2.175592441e-01f, 1.230164278e-01f, 6.929731449e-02f, 3.899011425e-02f, 2.192955363e-02f, 1.233257024e-02f, 6.935234103e-03f,
  7.451131605e-01f, -4.816218791e-01f, 8.264565347e-02f, 7.378857026e-01f, -7.568024953e-01f, 7.784717415e-01f, 9.535807405e-01f, 6.528280017e-01f, 3.894183423e-01f, 2.230444916e-01f, 1.261540665e-01f, 7.107120850e-02f, 3.998933419e-02f, 2.249175622e-02f, 1.264877333e-02f, 7.113057657e-03f,
  -1.586226688e-01f, -8.747141867e-01f, 3.884674088e-01f, 8.456384993e-01f, -8.182771111e-01f, 7.419627733e-01f, 9.626252055e-01f, 6.661946496e-01f, 3.986093280e-01f, 2.285226858e-01f, 1.292904437e-01f, 7.284487777e-02f, 4.098851413e-02f, 2.305395171e-02f, 1.296497516e-02f, 7.290880986e-03f,
  -9.165215479e-01f, -9.984104626e-01f, 6.557650689e-01f, 9.267202543e-01f, -8.715757724e-01f, 7.031081310e-01f, 9.707071255e-01f, 6.793506338e-01f, 4.077604531e-01f, 2.339936535e-01f, 1.324255279e-01f, 7.461831668e-02f, 4.198765309e-02f, 2.361613990e-02f, 1.328117570e-02f, 7.468704084e-03f,
  -8.317747426e-01f, -8.146145076e-01f, 8.580308748e-01f, 9.785736871e-01f, -9.161659367e-01f, 6.620306515e-01f, 9.778184193e-01f, 6.922917941e-01f, 4.168708024e-01f, 2.394572216e-01f, 1.355592879e-01f, 7.639151963e-02f, 4.298675006e-02f, 2.417832062e-02f, 1.359737490e-02f, 7.646526947e-03f,
  1.770192511e-02f, -3.799321270e-01f, 9.752062397e-01f, 9.995633646e-01f, -9.516020739e-01f, 6.188601989e-01f, 9.839519762e-01f, 7.050140383e-01f, 4.259394651e-01f, 2.449132175e-01f, 1.386916923e-01f, 7.816448100e-02f, 4.398580404e-02f, 2.474049370e-02f, 1.391357275e-02f, 7.824349567e-03f,
  8.509035245e-01f, 1.717624261e-01f, 9.956709484e-01f, 9.890272824e-01f, -9.775301177e-01f, 5.737332542e-01f, 9.891016630e-01f, 7.175133434e-01f, 4.349655341e-01f, 2.503614686e-01f, 1.418227098e-01f, 7.993719520e-02f, 4.498481404e-02f, 2.530265896e-02f, 1.422976920e-02f, 8.002171940e-03f,
  9.017883476e-01f, 6.705572816e-01f, 9.173955273e-01f, 9.472977435e-01f, -9.936910036e-01f, 5.267924836e-01f, 9.932623307e-01f, 7.297857568e-01f, 4.439481070e-01f, 2.558018026e-01f, 1.449523091e-01f, 8.170965662e-02f, 4.598377905e-02f, 2.586481621e-02f, 1.454596424e-02f, 8.179994060e-03f,
  1.235731227e-01f, 9.628327123e-01f, 7.481425059e-01f, 8.756908780e-01f, -9.999232576e-01f, 4.781862879e-01f, 9.964298187e-01f, 7.418273977e-01f, 4.528862854e-01f, 2.612340474e-01f, 1.480804588e-01f, 8.348185965e-02f, 4.698269808e-02f, 2.642696529e-02f, 1.486215781e-02f, 8.357815921e-03f,
  -7.682546613e-01f, 9.585732110e-01f, 5.046966116e-01f, 7.764651328e-01f, -9.961646088e-01f, 4.280683329e-01f, 9.986009600e-01f, 7.536344584e-01f, 4.617791755e-01f, 2.666580314e-01f, 1.512071278e-01f, 8.525379868e-02f, 4.798157012e-02f, 2.698910600e-02f, 1.517834990e-02f, 8.535637518e-03f,
  -9.537526528e-01f, 6.590906264e-01f, 2.112002371e-01f, 6.527500415e-01f, -9.824526126e-01f, 3.765970636e-01f, 9.997735835e-01f, 7.652032053e-01f, 4.706258882e-01f, 2.720735828e-01f, 1.543322846e-01f, 8.702546812e-02f, 4.898039419e-02f, 2.755123819e-02f, 1.549454048e-02f, 8.713458845e-03f,
  -2.623748537e-01f, 1.566201379e-01f, -1.032407464e-01f, 5.084475199e-01f, -9.589242747e-01f, 3.239352036e-01f, 9.999465168e-01f, 7.765299800e-01f, 4.794255386e-01f, 2.774805306e-01f, 1.574558982e-01f, 8.879686236e-02f, 4.997916927e-02f, 2.811336166e-02f, 1.581072950e-02f, 8.891279896e-03f,
  6.702291758e-01f, -3.940864994e-01f, -4.074434030e-01f, 3.481088020e-01f, -9.258146823e-01f, 2.702492405e-01f, 9.991195869e-01f, 7.876112009e-01f, 4.881772469e-01f, 2.828787037e-01f, 1.605779372e-01f, 9.056797580e-02f, 5.097789438e-02f, 2.867547624e-02f, 1.612691694e-02f, 9.069100666e-03f,
  9.866275920e-01f, -8.234216753e-01f, -6.712401257e-01f, 1.767908958e-01f, -8.834546557e-01f, 2.157088994e-01f, 9.972936206e-01f, 7.984433638e-01f, 4.968801378e-01f, 2.882679314e-01f, 1.636983704e-01f, 9.233880284e-02f, 5.197656850e-02f, 2.923758175e-02f, 1.644310277e-02f, 9.246921150e-03f,
  3.959251502e-01f, -9.991579785e-01f, -8.684703414e-01f, -1.029124367e-04f, -8.322674422e-01f, 1.604866066e-01f, 9.944704438e-01f, 8.090230434e-01f, 5.055333412e-01f, 2.936480433e-01f, 1.668171666e-01f, 9.410933788e-02f, 5.297519065e-02f, 2.979967802e-02f, 1.675928696e-02f, 9.424741341e-03f,
  -5.587890489e-01f, -8.671718295e-01f, -9.795748401e-01f, -1.769934748e-01f, -7.727644876e-01f, 1.047569444e-01f, 9.906528795e-01f, 8.193468942e-01f, 5.141359917e-01f, 2.990188692e-01f, 1.699342947e-01f, 9.587957531e-02f, 5.397375983e-02f, 3.036176486e-02f, 1.707546947e-02f, 9.602561234e-03f,
  -9.997551734e-01f, -4.681125574e-01f, -9.935354510e-01f, -3.483017460e-01f, -7.055403256e-01f, 4.869609889e-02f, 9.858447448e-01f, 8.294116515e-01f, 5.226872289e-01f, 3.043802394e-01f, 1.730497234e-01f, 9.764950955e-02f, 5.497227503e-02f, 3.092384210e-02f, 1.739165027e-02f, 9.780380823e-03f,
  -5.215510021e-01f, 7.511685313e-02f, -9.089677080e-01f, -5.086247435e-01f, -6.312666379e-01f, -7.518696635e-03f, 9.800508475e-01f, 8.392141328e-01f, 5.311861979e-01f, 3.097319842e-01f, 1.761634216e-01f, 9.941913500e-02f, 5.597073526e-02f, 3.148590956e-02f, 1.770782933e-02f, 9.958200103e-03f,
  4.361647552e-01f, 5.952116415e-01f, -7.342581470e-01f, -6.529059551e-01f, -5.506855426e-01f, -6.370972221e-02f, 9.732769811e-01f, 8.487512383e-01f, 5.396320487e-01f, 3.150739345e-01f, 1.792753582e-01f, 1.011884461e-01f, 5.696913951e-02f, 3.204796707e-02f, 1.802400663e-02f, 1.013601907e-02f,
  9.928726481e-01f, 9.319920894e-01f, -4.867326171e-01f, -7.765948190e-01f, -4.646021794e-01f, -1.196993330e-01f, 9.655299188e-01f, 8.580199521e-01f, 5.480239368e-01f, 3.204059213e-01f, 1.823855020e-01f, 1.029574371e-01f, 5.796748680e-02f, 3.261001444e-02f, 1.834018212e-02f, 1.031383771e-02f,
  6.367380071e-01f, 9.817359552e-01f, -1.909380864e-01f, -8.757902465e-01f, -3.738766648e-01f, -1.753105211e-01f, 9.568174070e-01f, 8.670173434e-01f, 5.563610229e-01f, 3.257277760e-01f, 1.854938220e-01f, 1.047261026e-01f, 5.896577612e-02f, 3.317205150e-02f, 1.865635577e-02f, 1.049165603e-02f,
  -3.048106211e-01f, 7.291230346e-01f, 1.237916674e-01f, -9.473636604e-01f, -2.794154982e-01f, -2.303674747e-01f, 9.471481575e-01f, 8.757405669e-01f, 5.646424734e-01f, 3.310393303e-01f, 1.886002871e-01f, 1.064944369e-01f, 5.996400648e-02f, 3.373407807e-02f, 1.897252756e-02f, 1.066947402e-02f,
  -9.661177700e-01f, 2.519535043e-01f, 4.262450708e-01f, -9.890576686e-01f, -1.821625043e-01f, -2.846961343e-01f, 9.365318388e-01f, 8.841868642e-01f, 5.728674601e-01f, 3.363404163e-01f, 1.917048661e-01f, 1.082624345e-01f, 6.096217687e-02f, 3.429609397e-02f, 1.928869745e-02f, 1.084729167e-02f,
  -7.391806966e-01f, -3.028131145e-01f, 6.864279895e-01f, -9.995572618e-01f, -8.308940282e-02f, -3.381247429e-01f, 9.249790663e-01f, 8.923535645e-01f, 5.810351605e-01f, 3.416308663e-01f, 1.948075281e-01f, 1.100300897e-01f, 6.196028630e-02f, 3.485809903e-02f, 1.960486542e-02f, 1.102510897e-02f,
  1.673557003e-01f, -7.643188115e-01f, 8.785382293e-01f, -9.785312876e-01f, 1.681390048e-02f, -3.904843889e-01f, 9.125013918e-01f, 9.002380852e-01f, 5.891447579e-01f, 3.469105129e-01f, 1.979082420e-01f, 1.117973969e-01f, 6.295833377e-02f, 3.542009306e-02f, 1.992103142e-02f, 1.120292593e-02f,
};

namespace pg8 {
#define PG8_LAS __attribute__((address_space(3)))
typedef unsigned short bf16_t;
typedef short bf16x8 __attribute__((ext_vector_type(8)));
typedef float f32x4 __attribute__((ext_vector_type(4)));
typedef unsigned u32x4 __attribute__((ext_vector_type(4)));
constexpr int BM = 256, BK = 64, HALF = 128, HTB = HALF * BK * 2  , STAGE_BYTES = 8 * HTB, NXCD = 8, WGM = 8;

__host__ __device__ __forceinline__ int lds_byte(int r, int c) { const int st = (r >> 4) * 2 + (c >> 5), rr = r & 15, cc = c & 31, ob = rr * 64 + cc * 2; return st * 1024 + (ob ^ (((ob >> 9) & 1) << 5)); }
__host__ __device__ __forceinline__ void stage_rc(int b, int& R, int& C) { const int st = b / 1024, sb = b % 1024, swz = sb ^ (((sb >> 9) & 1) << 5); R = (st >> 1) * 16 + swz / 64; C = (st & 1) * 32 + (swz % 64) / 2; }
__host__ __device__ __forceinline__ int perm32(int rho) { const int n = rho >> 4, i = rho & 15; return 8 * (i >> 2) + 4 * n + (i & 3); }

struct Unit { int pm, pn; };
struct Gemm { const bf16_t* A; const bf16_t* Bt; int M, N, K; };

struct StaticOrder {
    int nM, nN, nwg, G, c;
    __host__ __device__ void init(int M, int N, int G_, int c_) { nM = M / BM; nN = N / BM; nwg = nM * nN; G = G_; c = c_; }
    __host__ __device__ bool next(int i, Unit& u) const {
        const long L = (long)i * G + c; if (L >= nwg) return false;
        int wgid = (int)L; { const int q = nwg / NXCD, r = nwg % NXCD, xcd = wgid % NXCD, off = wgid / NXCD; wgid = (xcd < r ? xcd * (q + 1) : r * (q + 1) + (xcd - r) * q) + off; }
        const int nig = WGM * nN, gid = wgid / nig, fm = gid * WGM, gsz = (nM - fm) < WGM ? (nM - fm) : WGM;
        u.pm = fm + ((wgid % nig) % gsz); u.pn = (wgid % nig) / gsz; return true;
    }
    __device__ __forceinline__ void a_ready(const Unit&) const {}
    __device__ __forceinline__ void done(const Unit&) const {}
};

__device__ __forceinline__ unsigned cvt_pk_bf16(float lo, float hi) { unsigned r; asm volatile("v_cvt_pk_bf16_f32 %0, %1, %2" : "=v"(r) : "v"(lo), "v"(hi)); return r; }
typedef float f32x2 __attribute__((ext_vector_type(2)));

__device__ __forceinline__ int opaque_tid() { int t = threadIdx.x; asm volatile("" : "+v"(t)); return t; }
#define EPI_FENCE() asm volatile("" ::: "memory")
constexpr int MOD_STRIDE = 9 * 1024;
__device__ __forceinline__ int cond_of_panel(int pm) { return pm < 16 ? 8 : ((pm - 16) >> 3); }
__device__ __forceinline__ f32x2 silu_mul_pk(f32x2 g, f32x2 u) {
    const f32x2 t = g * (-1.4426950408889634f);
    f32x2 e; e.x = __builtin_amdgcn_exp2f(t.x); e.y = __builtin_amdgcn_exp2f(t.y);
    const f32x2 d = e + 1.0f;
    f32x2 r; r.x = __builtin_amdgcn_rcpf(d.x); r.y = __builtin_amdgcn_rcpf(d.y);
    return (g * u) * r;
}
__device__ __forceinline__ float fast_silu(float g) { return g * __builtin_amdgcn_rcpf(1.0f + __builtin_amdgcn_exp2f(-1.4426950408889634f * g)); }

struct EpiSwiGLU {
    static constexpr bool PERM = true, AFTER_DRAIN = false;
    bf16_t* H; int ldh;
    __device__ __forceinline__ void operator()(const f32x4 (&acc)[2][2][4][2], const Unit& u, int wr, int wc, int fr, int fq) const {
        const int row0 = u.pm * BM + wr * 64 + fr, col0 = u.pn * HALF + wc * 32 + 8 * fq;
#pragma unroll
        for (int ai = 0; ai < 2; ++ai)
#pragma unroll
            for (int m = 0; m < 4; ++m) {
                bf16_t* rowp = H + (size_t)(row0 + ai * HALF + m * 16) * ldh + col0;
                const f32x4 g0 = acc[ai][0][m][0], g1 = acc[ai][0][m][1], u0 = acc[ai][1][m][0], u1 = acc[ai][1][m][1];
                const f32x2 h0 = silu_mul_pk((f32x2){g0[0], g0[1]}, (f32x2){u0[0], u0[1]}), h1 = silu_mul_pk((f32x2){g0[2], g0[3]}, (f32x2){u0[2], u0[3]});
                const f32x2 h2 = silu_mul_pk((f32x2){g1[0], g1[1]}, (f32x2){u1[0], u1[1]}), h3 = silu_mul_pk((f32x2){g1[2], g1[3]}, (f32x2){u1[2], u1[3]});
                u32x4 w;
                w.x = cvt_pk_bf16(h0.x, h0.y); w.y = cvt_pk_bf16(h1.x, h1.y); w.z = cvt_pk_bf16(h2.x, h2.y); w.w = cvt_pk_bf16(h3.x, h3.y);
                *(u32x4*)rowp = w;
            }
    }
};

__device__ __forceinline__ float bflo(unsigned w) { return __builtin_bit_cast(float, w << 16); }
__device__ __forceinline__ float bfhi(unsigned w) { return __builtin_bit_cast(float, w & 0xffff0000u); }
struct EpiResid {
    static constexpr bool PERM = true, AFTER_DRAIN = false;
    const float* xinP; const float* xinS; float* out; const float* gate; int half_gate;
    int defer; bf16_t* dout;
    int npend; const bf16_t* pd0; const bf16_t* pd1;
    __device__ __forceinline__ void operator()(const f32x4 (&acc)[2][2][4][2], const Unit& u, int wr, int wc, int fr, int fq) const {
        const float gs = half_gate ? 0.5f : 1.0f;
        const int cl = u.pn * BM + wc * 32 + 8 * fq;
        const float* gp = gate + (size_t)cond_of_panel(u.pm) * MOD_STRIDE + cl;
        f32x4 gv[2][2];
#pragma unroll
        for (int bj = 0; bj < 2; ++bj)
#pragma unroll
            for (int n = 0; n < 2; ++n) gv[bj][n] = *(const f32x4*)(gp + bj * HALF + 4 * n) * gs;
        const size_t r0 = (size_t)(u.pm * BM + wr * 64 + fr) * 1024 + cl;
        if (defer) {
#pragma unroll
            for (int ai = 0; ai < 2; ++ai)
#pragma unroll
                for (int m = 0; m < 4; ++m)
#pragma unroll
                    for (int bj = 0; bj < 2; ++bj) { const f32x4 v0 = gv[bj][0] * acc[ai][bj][m][0], v1 = gv[bj][1] * acc[ai][bj][m][1];
                        u32x4 w; w.x = cvt_pk_bf16(v0[0], v0[1]); w.y = cvt_pk_bf16(v0[2], v0[3]); w.z = cvt_pk_bf16(v1[0], v1[1]); w.w = cvt_pk_bf16(v1[2], v1[3]);
                        *(u32x4*)(dout + r0 + (size_t)(ai * HALF + m * 16) * 1024 + bj * HALF) = w; }
        } else {
            const float* xb = (u.pm < 16) ? xinP + r0 : xinS + (r0 - (size_t)4096 * 1024);
#pragma unroll
            for (int ai = 0; ai < 2; ++ai)
#pragma unroll
                for (int mp = 0; mp < 2; ++mp) {
                    EPI_FENCE();
                    f32x4 xv[2][2][2]; u32x4 p0[2][2], p1[2][2];
#pragma unroll
                    for (int mm = 0; mm < 2; ++mm)
#pragma unroll
                        for (int bj = 0; bj < 2; ++bj) { const size_t o = (size_t)(ai * HALF + (2 * mp + mm) * 16) * 1024 + bj * HALF;
                            xv[mm][bj][0] = __builtin_nontemporal_load((const f32x4*)(xb + o)); xv[mm][bj][1] = __builtin_nontemporal_load((const f32x4*)(xb + o + 4));
                            if (npend > 0) p0[mm][bj] = __builtin_nontemporal_load((const u32x4*)(pd0 + r0 + o));
                            if (npend > 1) p1[mm][bj] = __builtin_nontemporal_load((const u32x4*)(pd1 + r0 + o)); }
                    EPI_FENCE();
#pragma unroll
                    for (int mm = 0; mm < 2; ++mm)
#pragma unroll
                        for (int bj = 0; bj < 2; ++bj) { const int m = 2 * mp + mm; const size_t o = (size_t)(ai * HALF + m * 16) * 1024 + bj * HALF;
                            f32x4 a = xv[mm][bj][0] + gv[bj][0] * acc[ai][bj][m][0], b = xv[mm][bj][1] + gv[bj][1] * acc[ai][bj][m][1];
                            if (npend > 0) { const u32x4 w = p0[mm][bj]; a += (f32x4){bflo(w.x), bfhi(w.x), bflo(w.y), bfhi(w.y)}; b += (f32x4){bflo(w.z), bfhi(w.z), bflo(w.w), bfhi(w.w)}; }
                            if (npend > 1) { const u32x4 w = p1[mm][bj]; a += (f32x4){bflo(w.x), bfhi(w.x), bflo(w.y), bfhi(w.y)}; b += (f32x4){bflo(w.z), bfhi(w.z), bflo(w.w), bfhi(w.w)}; }
                            *(f32x4*)(out + r0 + o) = a; *(f32x4*)(out + r0 + o + 4) = b; }
                }
        }
    }
};

typedef unsigned u32x2 __attribute__((ext_vector_type(2)));
__device__ __forceinline__ void store_bf16x4(bf16_t* p, f32x4 v) { u32x2 w; w.x = cvt_pk_bf16(v[0], v[1]); w.y = cvt_pk_bf16(v[2], v[3]); *(u32x2*)p = w; }

__device__ __forceinline__ void plain_tile(const f32x4 (&acc)[2][2][4][2], int pm, int wr, int wc, int fr, int fq, bf16_t* dst, int dpitch, int dcol0, float* fdst, int fpitch, int fcol0) {
    const int row0 = pm * BM + wr * 64 + fr, c0 = wc * 32 + 4 * fq;
#pragma unroll
    for (int ai = 0; ai < 2; ++ai)
#pragma unroll
        for (int m = 0; m < 4; ++m) {
            EPI_FENCE();
            int row = row0 + ai * HALF + m * 16; asm volatile("" : "+v"(row));
#pragma unroll
            for (int bj = 0; bj < 2; ++bj)
#pragma unroll
                for (int n = 0; n < 2; ++n) {
                    const int c = c0 + bj * HALF + n * 16;
                    store_bf16x4(dst + (size_t)row * dpitch + dcol0 + c, acc[ai][bj][m][n]);
                    if (fdst) *(f32x4*)(fdst + (size_t)row * fpitch + fcol0 + c) = acc[ai][bj][m][n];
                }
        }
}
__device__ __forceinline__ void prod_tile(const f32x4 (&acc)[2][2][4][2], int pm, int wr, int wc, int fr, int fq, bf16_t* dst, int dpitch, int dcol0) {
    const int row0 = pm * BM + wr * 64 + fr, c0 = wc * 32 + 4 * fq;
#pragma unroll
    for (int ai = 0; ai < 2; ++ai)
#pragma unroll
        for (int m = 0; m < 4; ++m) {
            const int row = row0 + ai * HALF + m * 16;
#pragma unroll
            for (int n = 0; n < 2; ++n) store_bf16x4(dst + (size_t)row * dpitch + dcol0 + c0 + n * 16, acc[ai][0][m][n] * acc[ai][1][m][n]);
        }
}
__device__ __forceinline__ void head_tile(const f32x4 (&acc)[2][2][4][2], int pm, int wr, int wc, int fr, int fq, const float* gq, bool rope, float outscale,
                                          bf16_t* dst, int dpitch, int dcol, float* fdst, int fpitch, int fcol, const float* rcos, const float* rsin) {
    f32x4 gv[2][2];
#pragma unroll
    for (int bj = 0; bj < 2; ++bj)
#pragma unroll
        for (int n = 0; n < 2; ++n) gv[bj][n] = *(const f32x4*)(gq + 32 * bj + 16 * n + 4 * fq);
    f32x4 cr[2], sr[2];
    const int rbase = pm * BM + wr * 64;
    if (rope) {
#pragma unroll
        for (int ai = 0; ai < 2; ++ai) { const int p = (((rbase + ai * HALF) - 4096) & 2047) >> 6; cr[ai] = *(const f32x4*)(rcos + p * 16 + 4 * fq); sr[ai] = *(const f32x4*)(rsin + p * 16 + 4 * fq); }
    }
#pragma unroll
    for (int m = 0; m < 4; ++m) {
        EPI_FENCE();
        f32x4 cc, sc;
        if (rope) { const int p = 16 * m + fr; cc = *(const f32x4*)(rcos + p * 16 + 4 * fq); sc = *(const f32x4*)(rsin + p * 16 + 4 * fq); }
#pragma unroll
        for (int ai = 0; ai < 2; ++ai) {
            int row = rbase + ai * HALF + m * 16 + fr; asm volatile("" : "+v"(row));
            f32x4 v[2][2]; float ss = 0.f;
#pragma unroll
            for (int bj = 0; bj < 2; ++bj)
#pragma unroll
                for (int n = 0; n < 2; ++n) { v[bj][n] = acc[ai][bj][m][n]; const f32x4 q = v[bj][n] * v[bj][n]; ss += (q[0] + q[1]) + (q[2] + q[3]); }
            ss += __shfl_xor(ss, 16); ss += __shfl_xor(ss, 32);
            const float r = 1.0f / sqrtf(ss * (1.0f / 64.0f) + 1e-6f);
#pragma unroll
            for (int bj = 0; bj < 2; ++bj)
#pragma unroll
                for (int n = 0; n < 2; ++n) v[bj][n] = v[bj][n] * r * gv[bj][n];
            if (fdst) {
#pragma unroll
                for (int bj = 0; bj < 2; ++bj)
#pragma unroll
                    for (int n = 0; n < 2; ++n) *(f32x4*)(fdst + (size_t)row * fpitch + fcol + 32 * bj + 16 * n + 4 * fq) = v[bj][n];
            }
            if (rope) {
                { const f32x4 a = v[0][0], b = v[0][1]; v[0][0] = a * cr[ai] - b * sr[ai]; v[0][1] = b * cr[ai] + a * sr[ai]; }
                { const f32x4 a = v[1][0], b = v[1][1]; v[1][0] = a * cc - b * sc; v[1][1] = b * cc + a * sc; }
            }
#pragma unroll
            for (int bj = 0; bj < 2; ++bj)
#pragma unroll
                for (int n = 0; n < 2; ++n) store_bf16x4(dst + (size_t)row * dpitch + dcol + 32 * bj + 16 * n + 4 * fq, v[bj][n] * outscale);
        }
    }
}
constexpr float QSCALE = 0.125f * 1.4426950408889634f;

constexpr int HBP = 2816;
struct EpiQKVEven {
    static constexpr bool PERM = false, AFTER_DRAIN = false;
    bf16_t* HB;
    float *newk, *newv;
    const float* qkg;
    const float *rcos, *rsin;
    __device__ __forceinline__ void operator()(const f32x4 (&acc)[2][2][4][2], const Unit& u, int wr, int wc, int fr, int fq) const {
        const int pn = u.pn; const bool sample = u.pm >= 16;
        if (pn < 2)      head_tile(acc, u.pm, wr, wc, fr, fq, qkg, sample, QSCALE, HB, HBP, 64 * (4 * pn + wc), nullptr, 0, 0, rcos, rsin);
        else if (pn < 4) head_tile(acc, u.pm, wr, wc, fr, fq, qkg + 64, sample, 1.0f, HB, HBP, 512 + 64 * (4 * (pn - 2) + wc), sample ? nullptr : newk, 512, 64 * (4 * (pn - 2) + wc), rcos, rsin);
        else if (pn < 6) plain_tile(acc, u.pm, wr, wc, fr, fq, HB, HBP, 1024 + 256 * (pn - 4), sample ? nullptr : newv, 512, 256 * (pn - 4));
        else if (pn < 8) plain_tile(acc, u.pm, wr, wc, fr, fq, HB, HBP, 1536 + 256 * (pn - 6), nullptr, 0, 0);
        else             prod_tile(acc, u.pm, wr, wc, fr, fq, HB, HBP, 2048 + 128 * (pn - 8));
    }
};
struct EpiQKVOdd {
    static constexpr bool PERM = false, AFTER_DRAIN = false;
    bf16_t* HB;
    float *newk, *newv;
    const float* qkg; const float *rcos, *rsin;
    __device__ __forceinline__ void operator()(const f32x4 (&acc)[2][2][4][2], const Unit& u, int wr, int wc, int fr, int fq) const {
        const int pn = u.pn; const bool sample = u.pm >= 16;
        if (pn < 4)       head_tile(acc, u.pm, wr, wc, fr, fq, qkg, sample, QSCALE, HB, HBP, 64 * (4 * pn + wc), nullptr, 0, 0, rcos, rsin);
        else if (pn == 4) head_tile(acc, u.pm, wr, wc, fr, fq, qkg + 64, sample, 1.0f, HB, HBP, 1024 + 64 * wc, sample ? nullptr : newk, 256, 64 * wc, rcos, rsin);
        else              plain_tile(acc, u.pm, wr, wc, fr, fq, HB, HBP, 1280, sample ? nullptr : newv, 256, 0);
    }
};

struct GroupOrder {
    int nM, nN, nwg, G, c, pm0, nbig, skip;
    __device__ void init(int pm0_, int nM_, int N, int G_, int c_, int nbig_, int skip_) { pm0 = pm0_; nM = nM_; nN = N / BM; nwg = nM * nN; G = G_; c = c_; nbig = nbig_; skip = skip_; }
    __device__ bool next(int i, Unit& u) const {
        long L;
        if (c < nbig) L = (long)skip * (G - nbig) + (long)i * G + c;
        else if (i < skip) L = (long)i * (G - nbig) + (c - nbig);
        else L = (long)skip * (G - nbig) + (long)(i - skip) * G + c;
        if (L >= nwg) return false;
        int wgid = (int)L; { const int q = nwg / NXCD, r = nwg % NXCD, xcd = wgid % NXCD, off = wgid / NXCD; wgid = (xcd < r ? xcd * (q + 1) : r * (q + 1) + (xcd - r) * q) + off; }
        const int nig = WGM * nN, gid = wgid / nig, fm = gid * WGM, gsz = (nM - fm) < WGM ? (nM - fm) : WGM;
        u.pm = pm0 + fm + ((wgid % nig) % gsz); u.pn = (wgid % nig) / gsz; return true;
    }
    __device__ __forceinline__ void a_ready(const Unit&) const {}
    __device__ __forceinline__ void done(const Unit&) const {}
};

template <class Epi, class Sched, bool ALIGN_EPI = false, bool SP2 = false>
__device__ __forceinline__ void gemm_phase(PG8_LAS unsigned char* lds, const Gemm g, const Sched& S, const Epi& E) {
    const int tid = opaque_tid(), wid = __builtin_amdgcn_readfirstlane(tid >> 6), lane = tid & 63, wr = wid >> 2, wc = wid & 3, fr = lane & 15, fq = lane >> 4;
    const int K = g.K, nt = K / BK;
    unsigned voffA[2], voffB[2];
#pragma unroll
    for (int i = 0; i < 2; ++i) { int R, C; stage_rc(tid * 16 + i * 8192, R, C); const int Rb = Epi::PERM ? ((R & ~31) + perm32(R & 31)) : R;
        voffA[i] = (unsigned)(R * K + C) * 2u; voffB[i] = (unsigned)(Rb * K + C) * 2u; }
    const size_t kstep = (size_t)(BK * 2);
    const size_t hstep = (size_t)HALF * K * 2;
    const size_t tstep = 2 * hstep;
    const unsigned ldsw = (unsigned)wid * 1024u;
    const int aoff = lds_byte(wr * 64 + fr, fq * 8), boff = lds_byte(wc * 32 + fr, fq * 8);
#define PG8_SA(b, h) (((b) * 2 + (h)) * HTB)
#define PG8_SB(b, h) ((4 + (b) * 2 + (h)) * HTB)
#define PG8_STAGE(bufoff, gbase, voff) do { _Pragma("unroll") for (int _i = 0; _i < 2; ++_i) \
        __builtin_amdgcn_global_load_lds((const unsigned*)((const char*)(gbase) + (voff)[_i]), (PG8_LAS unsigned*)(lds + (bufoff) + ldsw + _i * 8192), 16, 0, 0); } while (0)
#define PG8_LDA(dst, b, h) do { _Pragma("unroll") for (int m = 0; m < 4; ++m) _Pragma("unroll") for (int k = 0; k < 2; ++k) dst[m][k] = *(const PG8_LAS bf16x8*)(lds + PG8_SA(b, h) + aoff + m * 2048 + k * 1024); } while (0)
#define PG8_LDB(dst, b, h) do { _Pragma("unroll") for (int n = 0; n < 2; ++n) _Pragma("unroll") for (int k = 0; k < 2; ++k) dst[n][k] = *(const PG8_LAS bf16x8*)(lds + PG8_SB(b, h) + boff + n * 2048 + k * 1024); } while (0)
#define PG8_MMA(ai, bj, At, Bt) do { __builtin_amdgcn_s_setprio(1); _Pragma("unroll") for (int m = 0; m < 4; ++m) _Pragma("unroll") for (int n = 0; n < 2; ++n) _Pragma("unroll") for (int k = 0; k < 2; ++k) \
        acc[ai][bj][m][n] = __builtin_amdgcn_mfma_f32_16x16x32_bf16(Bt[n][k], At[m][k], acc[ai][bj][m][n], 0, 0, 0); __builtin_amdgcn_s_setprio(0); } while (0)
#define PG8_WAIT_V(n) asm volatile("s_waitcnt vmcnt(" #n ")" ::: "memory")
#define PG8_WAIT_L(n) asm volatile("s_waitcnt lgkmcnt(" #n ")" ::: "memory")
#define PG8_BAR __builtin_amdgcn_s_barrier()
#define PG8_SCHED __builtin_amdgcn_sched_barrier(0)
    Unit cur, nxt; int ui = 0;
    if (!S.next(0, cur)) return;
    f32x4 acc[2][2][4][2];
#pragma unroll
    for (int a = 0; a < 2; ++a)
#pragma unroll
        for (int b = 0; b < 2; ++b)
#pragma unroll
            for (int m = 0; m < 4; ++m)
#pragma unroll
                for (int n = 0; n < 2; ++n) acc[a][b][m][n] = (f32x4){0.f, 0.f, 0.f, 0.f};
    bf16x8 At[4][2], B0[2][2], B1[2][2];
    const char* cA = (const char*)g.A + (size_t)cur.pm * tstep; const char* cB = (const char*)g.Bt + (size_t)cur.pn * tstep;
    S.a_ready(cur);
    if constexpr (SP2) {
        PG8_STAGE(PG8_SB(0, 0), cB, voffB); PG8_STAGE(PG8_SB(0, 1), cB + hstep, voffB); PG8_STAGE(PG8_SA(0, 0), cA, voffA); PG8_STAGE(PG8_SA(0, 1), cA + hstep, voffA);
        if (wr == 1) PG8_BAR;
        PG8_WAIT_V(2); PG8_BAR;
        PG8_STAGE(PG8_SB(1, 0), cB + kstep, voffB); PG8_STAGE(PG8_SA(1, 0), cA + kstep, voffA); PG8_STAGE(PG8_SB(1, 1), cB + hstep + kstep, voffB);
        PG8_WAIT_V(6); PG8_BAR;
    } else {
        PG8_STAGE(PG8_SB(0, 0), cB, voffB); PG8_STAGE(PG8_SA(0, 0), cA, voffA); PG8_STAGE(PG8_SB(0, 1), cB + hstep, voffB); PG8_STAGE(PG8_SA(0, 1), cA + hstep, voffA);
        if (wr == 1) PG8_BAR;
        PG8_WAIT_V(4); PG8_BAR;
        PG8_STAGE(PG8_SB(1, 0), cB + kstep, voffB); PG8_STAGE(PG8_SA(1, 0), cA + kstep, voffA); PG8_STAGE(PG8_SB(1, 1), cB + hstep + kstep, voffB);
        PG8_WAIT_V(6); PG8_BAR;
    }
    for (;;) {
        const bool has_next = S.next(ui + 1, nxt);
        const char* nA = has_next ? (const char*)g.A + (size_t)nxt.pm * tstep : cA; const char* nB = has_next ? (const char*)g.Bt + (size_t)nxt.pn * tstep : cB;
        for (int t = 0; t < nt; t += 2) {
            const bool last = (t == nt - 2);
            const char* a1 = cA + (size_t)(t + 1) * kstep;
            const char* a2 = last ? nA : cA + (size_t)(t + 2) * kstep; const char* b2 = last ? nB : cB + (size_t)(t + 2) * kstep;
            const char* a3 = a2 + kstep; const char* b3 = b2 + kstep;
            if (last && has_next) S.a_ready(nxt);
            if constexpr (SP2) {
            PG8_LDB(B0, 0, 0); PG8_LDB(B1, 0, 1); PG8_SCHED; PG8_LDA(At, 0, 0); PG8_STAGE(PG8_SA(1, 1), a1 + hstep, voffA);
            PG8_WAIT_V(8); PG8_WAIT_L(0); PG8_BAR; PG8_MMA(0, 0, At, B0); PG8_MMA(0, 1, At, B1); PG8_BAR; PG8_SCHED;
            PG8_LDA(At, 0, 1); PG8_STAGE(PG8_SB(0, 0), b2, voffB); PG8_STAGE(PG8_SB(0, 1), b2 + hstep, voffB); PG8_STAGE(PG8_SA(0, 0), a2, voffA);
            PG8_WAIT_V(8); PG8_WAIT_L(0); PG8_BAR; PG8_MMA(1, 0, At, B0); PG8_MMA(1, 1, At, B1); PG8_BAR; PG8_SCHED;
            PG8_LDB(B0, 1, 0); PG8_LDB(B1, 1, 1); PG8_SCHED; PG8_LDA(At, 1, 0); PG8_STAGE(PG8_SA(0, 1), a2 + hstep, voffA);
            PG8_WAIT_V(8); PG8_WAIT_L(0); PG8_BAR; PG8_MMA(0, 0, At, B0); PG8_MMA(0, 1, At, B1); PG8_BAR; PG8_SCHED;
            PG8_LDA(At, 1, 1); PG8_STAGE(PG8_SB(1, 0), b3, voffB); PG8_STAGE(PG8_SB(1, 1), b3 + hstep, voffB); PG8_STAGE(PG8_SA(1, 0), a3, voffA);
            PG8_WAIT_V(8); PG8_WAIT_L(0); PG8_BAR; PG8_MMA(1, 0, At, B0); PG8_MMA(1, 1, At, B1); PG8_BAR; PG8_SCHED;
            } else {
            PG8_LDB(B0, 0, 0); PG8_SCHED; PG8_LDA(At, 0, 0); PG8_STAGE(PG8_SA(1, 1), a1 + hstep, voffA);
            PG8_WAIT_L(8); PG8_BAR; PG8_WAIT_L(0); PG8_MMA(0, 0, At, B0); PG8_BAR; PG8_SCHED;
            PG8_LDB(B1, 0, 1); PG8_STAGE(PG8_SB(0, 0), b2, voffB);
            PG8_BAR; PG8_WAIT_L(0); PG8_MMA(0, 1, At, B1); PG8_BAR;
            PG8_LDA(At, 0, 1); PG8_STAGE(PG8_SA(0, 0), a2, voffA);
            PG8_BAR; PG8_WAIT_L(0); PG8_MMA(1, 0, At, B0); PG8_BAR; PG8_SCHED;
            PG8_STAGE(PG8_SB(0, 1), b2 + hstep, voffB);
            PG8_WAIT_V(6); PG8_BAR; PG8_MMA(1, 1, At, B1); PG8_BAR;
            PG8_LDB(B0, 1, 0); PG8_SCHED; PG8_LDA(At, 1, 0); PG8_STAGE(PG8_SA(0, 1), a2 + hstep, voffA);
            PG8_WAIT_L(8); PG8_BAR; PG8_WAIT_L(0); PG8_MMA(0, 0, At, B0); PG8_BAR; PG8_SCHED;
            PG8_LDB(B1, 1, 1); PG8_STAGE(PG8_SB(1, 0), b3, voffB);
            PG8_BAR; PG8_WAIT_L(0); PG8_MMA(0, 1, At, B1); PG8_BAR;
            PG8_LDA(At, 1, 1); PG8_STAGE(PG8_SA(1, 0), a3, voffA);
            PG8_BAR; PG8_WAIT_L(0); PG8_MMA(1, 0, At, B0); PG8_BAR; PG8_SCHED;
            PG8_STAGE(PG8_SB(1, 1), b3 + hstep, voffB);
            PG8_WAIT_V(6); PG8_BAR; PG8_MMA(1, 1, At, B1); PG8_BAR;
            }
        }
        if constexpr (ALIGN_EPI) { if (wr == 0) PG8_BAR; }
        if constexpr (!Epi::AFTER_DRAIN) { E(acc, cur, wr, wc, fr, fq); S.done(cur); }
        if (!has_next) break;
#pragma unroll
        for (int a = 0; a < 2; ++a)
#pragma unroll
            for (int b = 0; b < 2; ++b)
#pragma unroll
                for (int m = 0; m < 4; ++m)
#pragma unroll
                    for (int n = 0; n < 2; ++n) acc[a][b][m][n] = (f32x4){0.f, 0.f, 0.f, 0.f};
        cur = nxt; cA = nA; cB = nB; ++ui;
        if constexpr (ALIGN_EPI) { if (wr == 1) PG8_BAR; }
    }
    PG8_WAIT_V(0);
    if constexpr (!ALIGN_EPI) { if (wr == 0) PG8_BAR; }
    PG8_BAR;
    if constexpr (Epi::AFTER_DRAIN) { E.fused(acc, cur, wr, wc, fr, fq, lds, wid, lane); S.done(cur); }
#undef PG8_SA
#undef PG8_SB
#undef PG8_STAGE
#undef PG8_LDA
#undef PG8_LDB
#undef PG8_MMA
#undef PG8_WAIT_V
#undef PG8_WAIT_L
#undef PG8_BAR
#undef PG8_SCHED
}
}

namespace att {
typedef unsigned short bf16_t;
typedef short bf16x8 __attribute__((ext_vector_type(8)));
typedef short s16x4 __attribute__((ext_vector_type(4)));
typedef short v4i16_t __attribute__((ext_vector_type(4)));
typedef float f32x16 __attribute__((ext_vector_type(16)));
typedef float f32x4 __attribute__((ext_vector_type(4)));
typedef unsigned u32x4 __attribute__((ext_vector_type(4)));
typedef unsigned u32x2 __attribute__((ext_vector_type(2)));
#define ATT_LAS __attribute__((address_space(3)))
__device__ __forceinline__ int crow(int r, int hi) { return (r & 3) + 8 * (r >> 2) + 4 * hi; }
typedef float f32x2_t __attribute__((ext_vector_type(2))); typedef __bf16 bf16x2_t __attribute__((ext_vector_type(2)));
__device__ __forceinline__ unsigned cvtpk(float lo, float hi) { f32x2_t v = {lo, hi}; bf16x2_t b = __builtin_convertvector(v, bf16x2_t); return __builtin_bit_cast(unsigned, b); }
__device__ __forceinline__ s16x4 vtr(const ATT_LAS unsigned char* p) { return __builtin_bit_cast(s16x4, __builtin_amdgcn_ds_read_tr16_b64_v4i16((ATT_LAS v4i16_t*)p)); }
__device__ __forceinline__ float max3f(float a, float b, float c) { float r; asm("v_max3_f32 %0, %1, %2, %3" : "=v"(r) : "v"(a), "v"(b), "v"(c)); return r; }
constexpr float THR = 6.0f;
constexpr float NEG_BIG = -1.0e30f;

struct KvStream {
    const bf16_t *Kc, *Vc, *Kb, *Vb; int ncache, nown, kp, kpc;
};

template <int KW, int DV>
__device__ __forceinline__ float attn_core(ATT_LAS unsigned char* lds, ATT_LAS float* wsf, const bf16_t* Qw, int qpitch, int kslice, const KvStream& S,
                                           bool masked, int qpos, int kpos0, float m_init, float l_init, f32x16 (&o)[DV / 32]) {
    constexpr int KB = 64 * KW * 2, VB = 64 * DV * 2, TB = KB + VB, NKC = KW / 64, NVC = DV / 64;
    const int tid = pg8::opaque_tid(), lane = tid & 63, r32 = lane & 31, hi = lane >> 5;
    static_assert(KW == DV, "K and V tiles share one staging map");
    int skey[NKC], scol[NKC], kdoff[NKC], vdoff[NVC];
#pragma unroll
    for (int q = 0; q < NKC; ++q) { const int L = q * 512 + tid, cw = L >> 8, key = (L & 255) >> 2, c4 = L & 3; skey[q] = key; scol[q] = cw * 32 + c4 * 8; kdoff[q] = cw * 4096 + key * 64 + ((c4 ^ ((key >> 2) & 3)) << 4); vdoff[q] = KB + cw * 4096 + key * 64 + (c4 << 4); }
    int kaoff[4];
#pragma unroll
    for (int d0 = 0; d0 < 4; ++d0) kaoff[d0] = (kslice * 2 + (d0 >> 1)) * 4096 + r32 * 64 + (((((d0 & 1) << 1) | hi) ^ ((r32 >> 2) & 3)) << 4);
    const int vb0 = KB + ((lane >> 4) & 1) * 32 + (lane & 3) * 8 + (4 * hi + ((lane & 15) >> 2)) * 64;
    bf16x8 qr[4];
#pragma unroll
    for (int d0 = 0; d0 < 4; ++d0) qr[d0] = *(const bf16x8*)(Qw + (size_t)r32 * qpitch + d0 * 16 + hi * 8);
#pragma unroll
    for (int d = 0; d < DV / 32; ++d) o[d] = f32x16{};
    float mhat = m_init, l = l_init;
    const int NT = S.ncache + S.nown;
    u32x4 kreg[NKC], vreg[NVC];
    const int half = __builtin_amdgcn_readfirstlane(tid >> 8);
#define ATT_LOAD(tn) do { const bool cch_ = (tn) < S.ncache; const int pt_ = cch_ ? S.kpc : S.kp; \
        const bf16_t* ks_ = cch_ ? S.Kc + (size_t)(tn) * 64 * pt_ : S.Kb + (size_t)((tn) - S.ncache) * 64 * pt_; \
        const bf16_t* vs_ = cch_ ? S.Vc + (size_t)(tn) * 64 * pt_ : S.Vb + (size_t)((tn) - S.ncache) * 64 * pt_; \
        _Pragma("unroll") for (int q = 0; q < NKC; ++q) { kreg[q] = *(const u32x4*)(ks_ + skey[q] * pt_ + scol[q]); vreg[q] = *(const u32x4*)(vs_ + skey[q] * pt_ + scol[q]); } } while (0)
#define ATT_WRITE(tn) do { ATT_LAS unsigned char* wb_ = lds + ((tn) & 1) * TB; \
        _Pragma("unroll") for (int q = 0; q < NKC; ++q) *(ATT_LAS u32x4*)(wb_ + kdoff[q]) = kreg[q]; \
        _Pragma("unroll") for (int q = 0; q < NVC; ++q) *(ATT_LAS u32x4*)(wb_ + vdoff[q]) = vreg[q]; } while (0)
#define ATT_STAGE(t) do { if ((t) + 1 < NT) { ATT_WRITE((t) + 1); if ((t) + 2 < NT) ATT_LOAD((t) + 2); } } while (0)
    ATT_LOAD(0);
    ATT_WRITE(0);
    if (NT > 1) ATT_LOAD(1);
    __syncthreads();
    if (half == 1) __syncthreads();
    for (int t = 0; t < NT; ++t) {
        ATT_LAS unsigned char* buf = lds + (t & 1) * TB;
        if (half == 1) ATT_STAGE(t);
        f32x16 p0 = f32x16{}, p1 = f32x16{};
        {   bf16x8 kf[8];
#pragma unroll
            for (int d0 = 0; d0 < 4; ++d0) { kf[2 * d0] = *(const ATT_LAS bf16x8*)(buf + kaoff[d0]); kf[2 * d0 + 1] = *(const ATT_LAS bf16x8*)(buf + kaoff[d0] + 2048); }
            __builtin_amdgcn_sched_barrier(0);
#pragma unroll
            for (int d0 = 0; d0 < 4; ++d0) {
                p0 = __builtin_amdgcn_mfma_f32_32x32x16_bf16(kf[2 * d0], qr[d0], p0, 0, 0, 0);
                p1 = __builtin_amdgcn_mfma_f32_32x32x16_bf16(kf[2 * d0 + 1], qr[d0], p1, 0, 0, 0);
            }
        }
        asm volatile("s_nop 15\n\ts_nop 7" : "+v"(p0), "+v"(p1));
        if (masked && t >= S.ncache) {
            const int kb = kpos0 + (t - S.ncache) * 64, qlo = qpos - r32;
            if (kb + 63 - qlo > 128 || qlo + 31 - kb > 128) {
#pragma unroll
                for (int r = 0; r < 16; ++r) { const int k0 = kb + crow(r, hi); int dd = qpos - k0; if (dd < 0) dd = -dd; if (dd > 128) p0[r] = NEG_BIG; dd = qpos - (k0 + 32); if (dd < 0) dd = -dd; if (dd > 128) p1[r] = NEG_BIG; }
            }
        }
        float rm;
        {   float ma = max3f(p0[0], p0[1], p1[0]), mb = max3f(p0[2], p0[3], p1[1]); ma = max3f(ma, p1[2], p1[3]);
#pragma unroll
            for (int r = 4; r < 16; r += 4) { ma = max3f(ma, p0[r], p0[r + 1]); mb = max3f(mb, p0[r + 2], p0[r + 3]); ma = max3f(ma, p1[r], p1[r + 1]); mb = max3f(mb, p1[r + 2], p1[r + 3]); }
            rm = max3f(ma, mb, mb);
            auto rr = __builtin_amdgcn_permlane32_swap(__float_as_uint(rm), __float_as_uint(rm), false, false); rm = max3f(__uint_as_float(rr[0]), __uint_as_float(rr[1]), __uint_as_float(rr[1])); }
        if (__any(rm > mhat + THR)) {
            const float mn = fmaxf(mhat, rm);
            const float f = __builtin_amdgcn_exp2f(mhat - mn);
            l *= f; mhat = mn;
            if (hi == 0) wsf[r32] = f;
#pragma unroll
            for (int r = 0; r < 16; ++r) { const float fr_ = wsf[crow(r, hi)];
#pragma unroll
                for (int d = 0; d < DV / 32; ++d) o[d][r] *= fr_; }
        }
        float ls = 0.f;
#pragma unroll
        for (int r = 0; r < 16; ++r) { p0[r] = __builtin_amdgcn_exp2f(p0[r] - mhat); p1[r] = __builtin_amdgcn_exp2f(p1[r] - mhat); ls += p0[r] + p1[r]; }
        l += ls;
        bf16x8 pa[4];
        { u32x4 w;
          w.x = cvtpk(p0[0], p0[1]); w.y = cvtpk(p0[2], p0[3]); w.z = cvtpk(p0[4], p0[5]); w.w = cvtpk(p0[6], p0[7]); pa[0] = __builtin_bit_cast(bf16x8, w);
          w.x = cvtpk(p0[8], p0[9]); w.y = cvtpk(p0[10], p0[11]); w.z = cvtpk(p0[12], p0[13]); w.w = cvtpk(p0[14], p0[15]); pa[1] = __builtin_bit_cast(bf16x8, w);
          w.x = cvtpk(p1[0], p1[1]); w.y = cvtpk(p1[2], p1[3]); w.z = cvtpk(p1[4], p1[5]); w.w = cvtpk(p1[6], p1[7]); pa[2] = __builtin_bit_cast(bf16x8, w);
          w.x = cvtpk(p1[8], p1[9]); w.y = cvtpk(p1[10], p1[11]); w.z = cvtpk(p1[12], p1[13]); w.w = cvtpk(p1[14], p1[15]); pa[3] = __builtin_bit_cast(bf16x8, w); }
        __syncthreads();
        if (half == 0) ATT_STAGE(t);
#pragma unroll
        for (int g = 0; g < DV / 64; ++g) {
            s16x4 lo[8], hh[8];
#pragma unroll
            for (int i = 0; i < 8; ++i) { const int d = 2 * g + (i >> 2), ks = i & 3; lo[i] = vtr(buf + vb0 + d * 4096 + ks * 1024); hh[i] = vtr(buf + vb0 + d * 4096 + ks * 1024 + 512); }
            __builtin_amdgcn_sched_barrier(0);
#pragma unroll
            for (int i = 0; i < 8; ++i) { const int d = 2 * g + (i >> 2), ks = i & 3;
                const bf16x8 vf = (bf16x8){lo[i][0], lo[i][1], lo[i][2], lo[i][3], hh[i][0], hh[i][1], hh[i][2], hh[i][3]};
                o[d] = __builtin_amdgcn_mfma_f32_32x32x16_bf16(pa[ks], vf, o[d], 0, 0, 0); }
        }
        __syncthreads();
    }
    if (half == 0) __syncthreads();
#undef ATT_LOAD
#undef ATT_WRITE
#undef ATT_STAGE
    { auto rr = __builtin_amdgcn_permlane32_swap(__float_as_uint(l), __float_as_uint(l), false, false); l = __uint_as_float(rr[0]) + __uint_as_float(rr[1]); }
    return l;
}

__device__ __forceinline__ void row_recips(ATT_LAS float* wsf, float l, int r32, int hi, float (&rli)[16]) {
    if (hi == 0) wsf[32 + r32] = l;
#pragma unroll
    for (int r = 0; r < 16; ++r) rli[r] = 1.0f / wsf[32 + crow(r, hi)];
}

constexpr int ODD_KV = 2 * (64 + 64) * 64 * 2;
constexpr int ODD_WSF = ODD_KV, ODD_STG = ODD_WSF + 8 * 256;
__device__ __forceinline__ void odd_unit(ATT_LAS unsigned char* lds, const bf16_t* HB, const bf16_t* CK, const bf16_t* CV, bf16_t* O, const float* sink,
                                         bool sample, int b, int g, int qb) {
    const int tid = pg8::opaque_tid(), lane = tid & 63, r32 = lane & 31, hi = lane >> 5; const int wid = __builtin_amdgcn_readfirstlane(tid >> 6);
    const int head = 4 * g + (wid >> 1);
    const int rowbase = sample ? 4096 + b * 2048 : b * 256;
    const int q0 = qb * 64 + 32 * (wid & 1);
    KvStream S; S.kp = 2816; S.kpc = 256;
    int kpos0 = 0;
    if (sample) { const int ts = qb - 2 < 0 ? 0 : qb - 2, te = qb + 3 > 32 ? 32 : qb + 3; kpos0 = ts * 64;
        S.Kc = CK + (size_t)b * 512 * 256 + g * 64; S.Vc = CV + (size_t)b * 512 * 256 + g * 64; S.ncache = 8;
        S.Kb = HB + (size_t)(rowbase + kpos0) * 2816 + 1024 + g * 64; S.Vb = HB + (size_t)(rowbase + kpos0) * 2816 + 1280 + g * 64; S.nown = te - ts; }
    else { S.Kc = nullptr; S.Vc = nullptr; S.ncache = 0; S.Kb = HB + (size_t)rowbase * 2816 + 1024 + g * 64; S.Vb = HB + (size_t)rowbase * 2816 + 1280 + g * 64; S.nown = 4; }
    ATT_LAS float* wsf = (ATT_LAS float*)(lds + ODD_WSF) + wid * 64;
    f32x16 o[2];
    const float l = attn_core<64, 64>(lds, wsf, HB + (size_t)(rowbase + q0) * 2816 + head * 64, 2816, 0, S, sample, q0 + r32, kpos0, sink[head] * 1.4426950408889634f, hi == 0 ? 1.0f : 0.0f, o);
    float rli[16]; row_recips(wsf, l, r32, hi, rli);
    ATT_LAS bf16_t* stg = (ATT_LAS bf16_t*)(lds + ODD_STG) + wid * 2048;
#pragma unroll
    for (int r = 0; r < 16; ++r) { const int orow = crow(r, hi);
#pragma unroll
        for (int d = 0; d < 2; ++d) { const float v = o[d][r] * rli[r]; stg[orow * 64 + d * 32 + r32] = (bf16_t)(cvtpk(v, v) & 0xffffu); } }
    bf16_t* Ow = O + (size_t)(rowbase + q0) * 1024 + head * 64;
#pragma unroll
    for (int i = 0; i < 4; ++i) { const int row = i * 8 + (lane >> 3), ch = lane & 7; const u32x4 v = *(const ATT_LAS u32x4*)(stg + row * 64 + ch * 8); *(u32x4*)(Ow + (size_t)row * 1024 + ch * 8) = v; }
    __syncthreads();
}

constexpr int EVEN_KV = 2 * (128 + 128) * 64 * 2;
constexpr int EVEN_WSF = 72 * 1024;
constexpr int EVEN_SROW = 136;
__device__ __forceinline__ void even_unit(ATT_LAS unsigned char* lds, const bf16_t* HB, const bf16_t* CK, const bf16_t* CV, bf16_t* O, const float* subln, float lam, float post,
                                          bool sample, int b, int h, int qb) {
    const int tid = pg8::opaque_tid(), lane = tid & 63, r32 = lane & 31, hi = lane >> 5; const int wid = __builtin_amdgcn_readfirstlane(tid >> 6);
    const int mp = wid >> 2, wq = wid & 3;
    const int rowbase = sample ? 4096 + b * 2048 : b * 256;
    const int q0 = qb * 128 + 32 * wq;
    KvStream S; S.kp = 2816; S.kpc = 512;
    if (sample) { S.Kc = CK + (size_t)b * 512 * 512 + h * 128; S.Vc = CV + (size_t)b * 512 * 512 + h * 128; S.ncache = 8; S.nown = 32; }
    else { S.Kc = nullptr; S.Vc = nullptr; S.ncache = 0; S.nown = 4; }
    S.Kb = HB + (size_t)rowbase * 2816 + 512 + h * 128; S.Vb = HB + (size_t)rowbase * 2816 + 1024 + h * 128;
    ATT_LAS float* wsf = (ATT_LAS float*)(lds + EVEN_WSF) + wid * 64;
    f32x16 o[4];
    const float l = attn_core<128, 128>(lds, wsf, HB + (size_t)(rowbase + q0) * 2816 + h * 128 + mp * 64, 2816, mp, S, false, 0, 0, -INFINITY, 0.0f, o);
    float rli[16]; row_recips(wsf, l, r32, hi, rli);
    ATT_LAS float* stage = (ATT_LAS float*)lds;
    __syncthreads();
    if (mp == 1) {
#pragma unroll
        for (int r = 0; r < 16; ++r) { const int row = 32 * wq + crow(r, hi);
#pragma unroll
            for (int d = 0; d < 4; ++d) stage[row * EVEN_SROW + d * 32 + r32] = o[d][r] * rli[r]; }
    }
    __syncthreads();
    if (mp == 0) {
#pragma unroll
        for (int r = 0; r < 16; ++r) { const int row = 32 * wq + crow(r, hi);
#pragma unroll
            for (int d = 0; d < 4; ++d) { ATT_LAS float* p = stage + row * EVEN_SROW + d * 32 + r32; *p = o[d][r] * rli[r] - lam * (*p); } }
        const int row = 32 * wq + (lane >> 1), half = lane & 1;
        const ATT_LAS float* rp = stage + row * EVEN_SROW + half * 4;
        float ss = 0.f;
#pragma unroll
        for (int i = 0; i < 16; ++i) { const f32x4 v = *(const ATT_LAS f32x4*)(rp + i * 8); ss += (v[0] * v[0] + v[1] * v[1]) + (v[2] * v[2] + v[3] * v[3]); }
        ss += __shfl_xor(ss, 1);
        const float rs = post / sqrtf(ss * (1.0f / 128.0f) + 1e-6f);
        bf16_t* Ow = O + (size_t)(rowbase + qb * 128 + row) * 1024 + h * 128 + half * 4;
#pragma unroll
        for (int i = 0; i < 16; ++i) { const f32x4 v = *(const ATT_LAS f32x4*)(rp + i * 8); const f32x4 gsub = *(const f32x4*)(subln + half * 4 + i * 8);
            u32x2 w; w.x = cvtpk(v[0] * rs * gsub[0], v[1] * rs * gsub[1]); w.y = cvtpk(v[2] * rs * gsub[2], v[3] * rs * gsub[3]); *(u32x2*)(Ow + i * 8) = w; }
    }
    __syncthreads();
}
#undef ATT_LAS
}

#define GAS __attribute__((address_space(1)))
#define LAS __attribute__((address_space(3)))
typedef unsigned short bf16;
typedef unsigned v4u __attribute__((ext_vector_type(4)));
typedef float f32x4 __attribute__((ext_vector_type(4)));
typedef short bf16x8 __attribute__((ext_vector_type(8)));
typedef GAS unsigned gu32;
typedef GAS unsigned long long gu64;
#define RLX_AGENT __ATOMIC_RELAXED, __HIP_MEMORY_SCOPE_AGENT
#define LDS_WAIT() asm volatile("s_waitcnt lgkmcnt(0)" ::: "memory")
#define VM_WAIT() asm volatile("s_waitcnt vmcnt(0)" ::: "memory")
__device__ __forceinline__ unsigned long long rt() { return __builtin_amdgcn_s_memrealtime(); }
__device__ __forceinline__ unsigned f2bf(float f) { unsigned u = __builtin_bit_cast(unsigned, f); return (u + 0x7fffu + ((u >> 16) & 1u)) >> 16; }
__device__ __forceinline__ unsigned pk2(float lo, float hi) { return f2bf(lo) | (f2bf(hi) << 16); }

#define XB_TMO      128
#define XB_XCNT(j)  (256  + 64 * (j))
#define XB_XSUB(j)  (1280 + 64 * (j))
#define XB_XGEN(j)  (2304 + 64 * (j))
#define XB_TOP      3328
#define XB_TOPGEN   3392
#define XCD_BAR_WORDS 3456
#define XB_SPIN_CAP (1u << 18)

__device__ __forceinline__ unsigned xb_ld(unsigned* p)              { return __hip_atomic_load(p, __ATOMIC_RELAXED, __HIP_MEMORY_SCOPE_AGENT); }
__device__ __forceinline__ unsigned xb_add(unsigned* p, unsigned v) { return __hip_atomic_fetch_add(p, v, __ATOMIC_RELAXED, __HIP_MEMORY_SCOPE_AGENT); }
__device__ __forceinline__ unsigned xb_xcc_id() { return (unsigned)__builtin_amdgcn_s_getreg((3 << 11) | 20) & 0xFu; }
#define XB_SPIN(cond, bar) do { unsigned _sp = 0; while (cond) { __builtin_amdgcn_s_sleep(1); \
    if ((++_sp & 255u) == 0u) { if (xb_ld(&(bar)[XB_TMO])) break; if (_sp > XB_SPIN_CAP) { atomicAdd(&(bar)[XB_TMO], 1u); break; } } } } while (0)

struct XcdBarrier {
    unsigned* bar; unsigned x;
    volatile LAS unsigned* st;
};

__device__ __forceinline__ XcdBarrier xcd_barrier_post(unsigned* bar, volatile LAS unsigned* st) {
    XcdBarrier b; b.bar = bar; b.x = xb_xcc_id(); b.st = st;
    if (threadIdx.x == 0) (void)xb_add(&bar[XB_XCNT(b.x)], 1u);
    return b;
}
__device__ __forceinline__ void xcd_barrier_complete(unsigned* bar, unsigned x, unsigned& nloc, unsigned& nx) {
    const unsigned G = gridDim.x * gridDim.y * gridDim.z;
    unsigned sum, cnt, mine, sp = 0u;
    for (;;) {
        sum = 0u; cnt = 0u; mine = 0u;
#pragma unroll
        for (unsigned j = 0; j < 16; ++j) { const unsigned c = xb_ld(&bar[XB_XCNT(j)]); sum += c; cnt += (c > 0u) ? 1u : 0u; mine = (j == x) ? c : mine; }
        if (sum == G) break;
        __builtin_amdgcn_s_sleep(1);
        if ((++sp & 255u) == 0u) { if (xb_ld(&bar[XB_TMO])) break; if (sp > XB_SPIN_CAP) { atomicAdd(&bar[XB_TMO], 1u); break; } }
    }
    nloc = mine > 0u ? mine : 1u; nx = cnt > 0u ? cnt : 1u;
}

__device__ __forceinline__ void xcd_barrier(const XcdBarrier& b) {
    asm volatile("s_waitcnt vmcnt(0)" ::: "memory");
    __syncthreads();
    if (threadIdx.x == 0) {
        unsigned* bar = b.bar;
        __builtin_amdgcn_s_waitcnt(0);
        unsigned nloc = b.st[0], nx = b.st[1];
        if (nloc == 0u) { xcd_barrier_complete(bar, b.x, nloc, nx); b.st[0] = nloc; b.st[1] = nx; }
        const unsigned old = xb_add(&bar[XB_XSUB(b.x)], 1u);
        const unsigned gen = old / nloc;
        if (old + 1u == (gen + 1u) * nloc) {
            __builtin_amdgcn_fence(__ATOMIC_RELEASE, "agent");
            asm volatile("s_waitcnt vmcnt(0)" ::: "memory");
            const unsigned og = xb_add(&bar[XB_TOP], 1u);
            const unsigned tg = og / nx;
            if (og + 1u == (tg + 1u) * nx) xb_add(&bar[XB_TOPGEN], 1u);
            else XB_SPIN(xb_ld(&bar[XB_TOPGEN]) == tg, bar);
            __builtin_amdgcn_fence(__ATOMIC_ACQUIRE, "agent");
            xb_add(&bar[XB_XGEN(b.x)], 1u);
            asm volatile("s_waitcnt vmcnt(0)" ::: "memory");
        } else {
            XB_SPIN(xb_ld(&bar[XB_XGEN(b.x)]) == gen, bar);
            __builtin_amdgcn_fence(__ATOMIC_ACQUIRE, "agent");
            asm volatile("s_waitcnt vmcnt(0)" ::: "memory");
        }
    }
    __syncthreads();
}

__device__ __forceinline__ float wave_sum(float v) {
#pragma unroll
    for (int o = 1; o < 64; o <<= 1) v += __shfl_xor(v, o);
    return v;
}

constexpr int NWAVES = 8;
constexpr int DM = 1024, DFF = 2816, NPROMPT = 4096, NSAMPLE = 16384, MT = NPROMPT + NSAMPLE;
constexpr int N_PHASES = 22;
#ifndef MK_PER_PHASE
#define MK_PER_PHASE 0
#endif

constexpr size_t MiB = 1u << 20;
constexpr size_t WS_CTL = 0, CTL_ZERO_BYTES = 64 * 1024;
constexpr size_t WS_MOD = 1 * MiB;
constexpr size_t WS_W13 = 2 * MiB;
constexpr size_t WS_W2 = 46 * MiB;
constexpr size_t WS_EWIN = 68 * MiB, WS_EWOUT = 74 * MiB, WS_OWIN = 76 * MiB, WS_OWOUT = 79 * MiB;
constexpr size_t WS_CEK = 81 * MiB, WS_CEV = 85 * MiB, WS_COK = 89 * MiB, WS_COV = 91 * MiB;
constexpr size_t WS_XN = 96 * MiB;
constexpr size_t WS_OB = WS_XN;
constexpr size_t WS_DA = 136 * MiB, WS_DB = 286 * MiB;
constexpr size_t WS_HB = 176 * MiB;
constexpr size_t WS_END = 326 * MiB;
constexpr size_t QKV_SLAB = (size_t)MT * 512 * 2;
constexpr size_t OUT_YP = 0, OUT_YS = 4194304, OUT_EK = 20971520, OUT_EV = 23068672, OUT_OK = 25165824, OUT_OV = 26214400, OUT_TOTAL = 27262976;
constexpr int CW_BAR = 4096;

constexpr int RING_BYTES = 131072;
constexpr int LDSCTL_OFF = 139264, MISC_OFF = LDSCTL_OFF + 320;
constexpr int LDS_BYTES = 147456;

struct Frame {
    LAS unsigned char* lds;
    int tid, lane, wave, vcu, G;
};

template <class DROW>
__device__ __forceinline__ void p0_transpose_wg(const float* W, int K, int N, bf16* WT, int k0, int n0, DROW drow, LAS float* scr, int wave, int lane) {
    {   f32x4 v[16];
#pragma unroll
        for (int i = 0; i < 8; ++i)
#pragma unroll
            for (int h = 0; h < 2; ++h) v[2 * i + h] = __builtin_nontemporal_load((const f32x4*)(W + (size_t)(k0 + wave + 8 * i) * N + n0 + h * 256 + lane * 4));
#pragma unroll
        for (int i = 0; i < 8; ++i)
#pragma unroll
            for (int h = 0; h < 2; ++h) { LAS float* d = scr + (wave + 8 * i) * 513 + h * 256 + lane * 4; d[0] = v[2 * i + h][0]; d[1] = v[2 * i + h][1]; d[2] = v[2 * i + h][2]; d[3] = v[2 * i + h][3]; }
    }
    __syncthreads();
    const int c = lane & 7;
#pragma unroll
    for (int j = 0; j < 8; ++j) { const int n = wave * 64 + (lane >> 3) + 8 * j; const LAS float* s = scr + (8 * c) * 513 + n;
        v4u o; o.x = pk2(s[0 * 513], s[1 * 513]); o.y = pk2(s[2 * 513], s[3 * 513]); o.z = pk2(s[4 * 513], s[5 * 513]); o.w = pk2(s[6 * 513], s[7 * 513]);
        const int dr = drow(n0 + (n & ~31)) + (n & 31);
        *(GAS v4u*)(WT + (size_t)dr * K + k0 + 8 * c) = o; }
    __syncthreads();
}
__device__ __forceinline__ int drow_swiglu(int n0) { const bool up = n0 >= DFF; const int c = up ? n0 - DFF : n0; return 256 * (c >> 7) + (up ? 128 : 0) + (c & 127); }
__device__ __forceinline__ int drow_heads(int n0) { const int pn = n0 >> 8, x = n0 & 255, wc = x >> 6, bj = (x & 63) >> 5; return 256 * pn + 128 * bj + 32 * wc; }
__device__ __forceinline__ int drow_even_in(int n0) {
    if (n0 < 1024) return drow_heads(n0);
    if (n0 < 2048) return n0;
    if (n0 < 2560) { const int c = n0 - 2048; return 2048 + 256 * (c >> 7) + (c & 127); }
    const int c = n0 - 2560; return 2048 + 256 * (c >> 7) + 128 + (c & 127);
}
__device__ __forceinline__ int drow_odd_in(int n0) { return n0 < 1280 ? drow_heads(n0) : n0; }

struct Ptrs {
    const float *x_prompt, *x_sample, *cek, *cev, *cok, *cov, *c, *c_ctx, *w_mod, *b_mod, *norm_g, *w13, *w2, *ewin, *ewout, *eqk, *elam, *esub, *econv, *owin, *owout, *oqk, *osink;
    float* out; unsigned char* ws;
};

__device__ __forceinline__ void cvt_cache(const Frame& F, const float* src, unsigned char* dst, size_t n8) {
    const size_t gt = (size_t)F.vcu * (NWAVES * 64) + F.tid, NGT = (size_t)F.G * NWAVES * 64;
    for (size_t i = gt; i < n8; i += NGT) { const f32x4 v0 = *(const f32x4*)(src + i * 8), v1 = *(const f32x4*)(src + i * 8 + 4);
        v4u o; o.x = pk2(v0[0], v0[1]); o.y = pk2(v0[2], v0[3]); o.z = pk2(v1[0], v1[1]); o.w = pk2(v1[2], v1[3]); *(v4u*)(dst + i * 16) = o; }
}
__device__ __forceinline__ void p0_prologue(const Frame& F0, const Ptrs& P) {
    Frame F = F0; F.tid = pg8::opaque_tid(); F.lane = F.tid & 63;
    {   LAS float* sil = (LAS float*)F.lds;
        LAS float* red = (LAS float*)(F.lds + 40960);
        for (int i = F.tid; i < 9 * 1024; i += NWAVES * 64) { const int cnd = i >> 10, k = i & 1023; const float v = cnd < 8 ? P.c[cnd * 1024 + k] : P.c_ctx[k]; sil[i] = v / (1.0f + expf(-v)); }
        __syncthreads();
        const int lg = F.lane / 18, l18 = F.lane % 18, rs = F.wave * 3 + lg;
        for (int item = blockIdx.x; item < 256; item += F.G) {
            const int l = item >> 7, c0 = (item & 127) * 72;
            const float* wp = P.w_mod + (size_t)l * 1024 * 9216 + c0 + l18 * 4;
            f32x4 a[9];
#pragma unroll
            for (int cnd = 0; cnd < 9; ++cnd) a[cnd] = (f32x4){0.f, 0.f, 0.f, 0.f};
            if (lg < 3) {
#pragma unroll 1
                for (int i0 = 0; i0 < 48; i0 += 8) {
                    f32x4 wv[8];
#pragma unroll
                    for (int u = 0; u < 8; ++u) { const int k = rs + 24 * (i0 + u); wv[u] = k < 1024 ? *(const f32x4*)(wp + (size_t)k * 9216) : (f32x4){0.f, 0.f, 0.f, 0.f}; }
#pragma unroll
                    for (int u = 0; u < 8; ++u) { const int k = rs + 24 * (i0 + u); const int kk = k < 1024 ? k : 0;
#pragma unroll
                        for (int cnd = 0; cnd < 9; ++cnd) a[cnd] += wv[u] * sil[cnd * 1024 + kk]; }
                }
#pragma unroll
                for (int cnd = 0; cnd < 9; ++cnd) *(LAS f32x4*)(red + (rs * 9 + cnd) * 72 + l18 * 4) = a[cnd];
            }
            __syncthreads();
            for (int i = F.tid; i < 9 * 72; i += NWAVES * 64) { const int cnd = i / 72, col = i % 72; float s = 0.f;
#pragma unroll
                for (int w = 0; w < 24; ++w) s += red[(w * 9 + cnd) * 72 + col];
                ((float*)(P.ws + WS_MOD))[(size_t)(l * 9 + cnd) * 9216 + c0 + col] = s + P.b_mod[l * 9216 + c0 + col]; }
            __syncthreads();
        }
        __syncthreads();
    }
    LAS float* scr = (LAS float*)F.lds;
    constexpr int I_W13 = 16 * 11, I_W2 = 44 * 2, I_EIN = 16 * 6, I_SQ = 16 * 2, I_OIN = 16 * 3;
    constexpr int NITEMS = 4 * I_W13 + 4 * I_W2 + I_EIN + I_SQ + I_OIN + I_SQ;
    auto d_id = [](int n) { return n; };
    auto d_sw = [](int n) { return drow_swiglu(n); };
    auto d_ei = [](int n) { return drow_even_in(n); };
    auto d_oi = [](int n) { return drow_odd_in(n); };
    for (int it = F.vcu; it < NITEMS; it += F.G) {
        int r = it;
        if (r < 4 * I_W13) { const int mi = r / I_W13, q = r % I_W13, kb = q / 11, nb = q % 11;
            p0_transpose_wg(P.w13 + (size_t)mi * 1024 * 5632, 1024, 5632, (bf16*)(P.ws + WS_W13) + (size_t)mi * 5632 * 1024, 64 * kb, 512 * nb, d_sw, scr, F.wave, F.lane); continue; }
        r -= 4 * I_W13;
        if (r < 4 * I_W2) { const int mi = r / I_W2, q = r % I_W2, kb = q / 2, nb = q % 2;
            p0_transpose_wg(P.w2 + (size_t)mi * 2816 * 1024, 2816, 1024, (bf16*)(P.ws + WS_W2) + (size_t)mi * 1024 * 2816, 64 * kb, 512 * nb, d_id, scr, F.wave, F.lane); continue; }
        r -= 4 * I_W2;
        if (r < I_EIN) { const int kb = r / 6, nb = r % 6; p0_transpose_wg(P.ewin, 1024, 3072, (bf16*)(P.ws + WS_EWIN), 64 * kb, 512 * nb, d_ei, scr, F.wave, F.lane); continue; }
        r -= I_EIN;
        if (r < I_SQ) { const int kb = r / 2, nb = r % 2; p0_transpose_wg(P.ewout, 1024, 1024, (bf16*)(P.ws + WS_EWOUT), 64 * kb, 512 * nb, d_id, scr, F.wave, F.lane); continue; }
        r -= I_SQ;
        if (r < I_OIN) { const int kb = r / 3, nb = r % 3; p0_transpose_wg(P.owin, 1024, 1536, (bf16*)(P.ws + WS_OWIN), 64 * kb, 512 * nb, d_oi, scr, F.wave, F.lane); continue; }
        r -= I_OIN;
        { const int kb = r / 2, nb = r % 2; p0_transpose_wg(P.owout, 1024, 1024, (bf16*)(P.ws + WS_OWOUT), 64 * kb, 512 * nb, d_id, scr, F.wave, F.lane); }
    }
    cvt_cache(F, P.cek, P.ws + WS_CEK, 2097152 / 8); cvt_cache(F, P.cev, P.ws + WS_CEV, 2097152 / 8);
    cvt_cache(F, P.cok, P.ws + WS_COK, 1048576 / 8); cvt_cache(F, P.cov, P.ws + WS_COV, 1048576 / 8);
}

__device__ __forceinline__ void norm_rows(const Frame& F0, const float* xP, const float* xS, const float* g, const float* mod  , int jshift, bf16* XN, int row0, int row1, int pidx, int pcount, int npend, const bf16* pd0, const bf16* pd1) {
    Frame F = F0; F.tid = pg8::opaque_tid(); F.lane = F.tid & 63;
    if (pidx < 0) return;
    const int gw = pidx * NWAVES + F.wave, NGW = pcount * NWAVES;
    const int per = (row1 - row0 + NGW - 1) / NGW;
    int r0 = row0 + gw * per, r1 = r0 + per; if (r1 > row1) r1 = row1;
    int cur_cond = -1; f32x4 gs[4], sh[4];
    f32x4 nv[4]; unsigned long long nd0[4], nd1[4];
#define NORM_LOAD(rw) do { const float* xr_ = (rw) < NPROMPT ? xP + (size_t)(rw) * DM : xS + (size_t)((rw) - NPROMPT) * DM; \
        _Pragma("unroll") for (int j = 0; j < 4; ++j) { nv[j] = *(const f32x4*)(xr_ + 4 * F.lane + 256 * j); \
            if (npend > 0) nd0[j] = *(const unsigned long long*)(pd0 + (size_t)(rw) * DM + 4 * F.lane + 256 * j); \
            if (npend > 1) nd1[j] = *(const unsigned long long*)(pd1 + (size_t)(rw) * DM + 4 * F.lane + 256 * j); } } while (0)
    if (r0 < r1) NORM_LOAD(r0);
    for (int row = r0; row < r1; ++row) {
        const int cond = row < NPROMPT ? 8 : ((row - NPROMPT) >> 11);
        if (cond != cur_cond) { cur_cond = cond; const float* mp = mod + (size_t)cond * 9216;
#pragma unroll
            for (int j = 0; j < 4; ++j) { const int col = 4 * F.lane + 256 * j; const f32x4 gg = *(const f32x4*)(g + col), sc = *(const f32x4*)(mp + (jshift + 1) * 1024 + col); sh[j] = *(const f32x4*)(mp + jshift * 1024 + col); gs[j] = gg * (sc + 1.0f); } }
        f32x4 v[4]; float s = 0.f;
#pragma unroll
        for (int j = 0; j < 4; ++j) { v[j] = nv[j];
            if (npend > 0) { const unsigned lo = (unsigned)nd0[j], hi = (unsigned)(nd0[j] >> 32);
                v[j] += (f32x4){__builtin_bit_cast(float, lo << 16), __builtin_bit_cast(float, lo & 0xffff0000u), __builtin_bit_cast(float, hi << 16), __builtin_bit_cast(float, hi & 0xffff0000u)}; }
            if (npend > 1) { const unsigned lo = (unsigned)nd1[j], hi = (unsigned)(nd1[j] >> 32);
                v[j] += (f32x4){__builtin_bit_cast(float, lo << 16), __builtin_bit_cast(float, lo & 0xffff0000u), __builtin_bit_cast(float, hi << 16), __builtin_bit_cast(float, hi & 0xffff0000u)}; }
            s += (v[j][0] * v[j][0] + v[j][1] * v[j][1]) + (v[j][2] * v[j][2] + v[j][3] * v[j][3]); }
        if (row + 1 < r1) NORM_LOAD(row + 1);
        const float rstd = 1.0f / sqrtf(wave_sum(s) * (1.0f / DM) + 1e-6f);
#pragma unroll
        for (int j = 0; j < 4; ++j) { const f32x4 y = v[j] * rstd * gs[j] + sh[j];
            *(unsigned long long*)(XN + (size_t)row * DM + 4 * F.lane + 256 * j) = (unsigned long long)pk2(y[0], y[1]) | ((unsigned long long)pk2(y[2], y[3]) << 32); }
    }
#undef NORM_LOAD
}

__device__ __forceinline__ float bf2f(unsigned short b) { return __builtin_bit_cast(float, (unsigned)b << 16); }
__device__ __forceinline__ void conv_rows(const Frame& F0, const bf16* HB, const float* cw, bf16* OB, int row0, int row1, int pidx, int pcount) {
    Frame F = F0; F.tid = pg8::opaque_tid(); F.lane = F.tid & 63;
    if (pidx < 0) return;
    const int gw = pidx * NWAVES + F.wave, NGW = pcount * NWAVES;
    const int c0 = 8 * F.lane;
    f32x4 w0[2], w1[2], w2[2];
#pragma unroll
    for (int h = 0; h < 2; ++h) { w0[h] = *(const f32x4*)(cw + c0 + 4 * h); w1[h] = *(const f32x4*)(cw + 512 + c0 + 4 * h); w2[h] = *(const f32x4*)(cw + 1024 + c0 + 4 * h); }
    for (int row = row0 + gw; row < row1; row += NGW) {
        const int t = row < NPROMPT ? (row & 255) : ((row - NPROMPT) & 2047), len = row < NPROMPT ? 256 : 2048;
        const v4u zero = (v4u){0u, 0u, 0u, 0u};
        const bf16* up_ = HB + (size_t)row * 2816 + 2048 + c0;
        const v4u uc = *(const v4u*)up_;
        const v4u up = t > 0 ? *(const v4u*)(up_ - 2816) : zero;
        const v4u un = t < len - 1 ? *(const v4u*)(up_ + 2816) : zero;
        const v4u bg = *(const v4u*)(HB + (size_t)row * 2816 + 1536 + c0);
        float y[8];
#pragma unroll
        for (int e = 0; e < 8; ++e) { const int wi = e >> 1, sft = (e & 1) * 16;
            const float a = bf2f((unsigned short)(up[wi] >> sft)), b = bf2f((unsigned short)(uc[wi] >> sft)), c = bf2f((unsigned short)(un[wi] >> sft)), gte = bf2f((unsigned short)(bg[wi] >> sft));
            y[e] = gte * (w0[e >> 2][e & 3] * a + w1[e >> 2][e & 3] * b + w2[e >> 2][e & 3] * c); }
        v4u o; o.x = pk2(y[0], y[1]); o.y = pk2(y[2], y[3]); o.z = pk2(y[4], y[5]); o.w = pk2(y[6], y[7]);
        *(v4u*)(OB + (size_t)row * DM + 512 + c0) = o;
    }
}

struct Args { const float* in[23]; float* out; unsigned char* ws; int ph_lo, ph_hi; };
__global__ void __launch_bounds__(NWAVES * 64, 2) mega_fwd(Args args) {
    extern __shared__ __attribute__((aligned(16))) unsigned char lds_raw[];
    Frame F;
    F.lds = (LAS unsigned char*)lds_raw;
    volatile LAS unsigned* MISC = (volatile LAS unsigned*)(F.lds + MISC_OFF);
    F.tid = threadIdx.x; F.lane = F.tid & 63; F.wave = __builtin_amdgcn_readfirstlane(F.tid >> 6);
    F.G = gridDim.x; { const int bx = blockIdx.x; F.vcu = (F.G % 8 == 0) ? (bx % 8) * (F.G / 8) + bx / 8 : bx; }
    typedef const __attribute__((address_space(4))) Args* KArgs;
    const KArgs KA0 = (KArgs)__builtin_amdgcn_kernarg_segment_ptr();
    unsigned char* ws = KA0->ws;
    for (int u = F.tid; u < (LDS_BYTES - LDSCTL_OFF) / 4; u += NWAVES * 64) ((LAS unsigned*)(F.lds + LDSCTL_OFF))[u] = 0u;
    __syncthreads();
    XcdBarrier bar; bar.bar = (unsigned*)(ws + WS_CTL) + CW_BAR; bar.x = 0; bar.st = nullptr;
    if (!MK_PER_PHASE) bar = xcd_barrier_post((unsigned*)(ws + WS_CTL) + CW_BAR, MISC + 8);

    const float* MODP = (const float*)(ws + WS_MOD);
    bf16* XN = (bf16*)(ws + WS_XN); bf16* OB = (bf16*)(ws + WS_OB); bf16* HB = (bf16*)(ws + WS_HB);
    float* xout = KA0->out;

    const int ph_lo = KA0->ph_lo, ph_hi = KA0->ph_hi;
    for (int ph = ph_lo; ph < ph_hi; ++ph) {
      if (ph == 0) {
        KArgs ka = KA0; asm volatile("" : "+s"(ka));
        Ptrs P;
        P.x_prompt = ka->in[0]; P.x_sample = ka->in[1]; P.cek = ka->in[2]; P.cev = ka->in[3]; P.cok = ka->in[4]; P.cov = ka->in[5]; P.c = ka->in[6]; P.c_ctx = ka->in[7];
        P.w_mod = ka->in[8]; P.b_mod = ka->in[9]; P.norm_g = ka->in[10]; P.w13 = ka->in[11]; P.w2 = ka->in[12]; P.ewin = ka->in[13]; P.ewout = ka->in[14]; P.eqk = ka->in[15];
        P.elam = ka->in[16]; P.esub = ka->in[17]; P.econv = ka->in[18]; P.owin = ka->in[19]; P.owout = ka->in[20]; P.oqk = ka->in[21]; P.osink = ka->in[22];
        P.out = ka->out; P.ws = ka->ws;
        p0_prologue(F, P);
      } else {
        const int opS = ph - 2, opP = ph - 1;
        const bool validS = opS >= 0 && opS < 20, validP = opP >= 0 && opP < 20;
        const int kS = validS ? opS % 10 : -1, kP = validP ? opP % 10 : -1;
        const bool pfirst = !(kS == 2 || kS == 6 || kS == 9);
        for (int slot = 0; slot < 2; ++slot) {
            const bool isP = (slot == 0) == pfirst;
            if (isP ? !validP : !validS) continue;
            KArgs ka = KA0; asm volatile("" : "+s"(ka));
            Ptrs P;
            P.x_prompt = ka->in[0]; P.x_sample = ka->in[1]; P.cek = ka->in[2]; P.cev = ka->in[3]; P.cok = ka->in[4]; P.cov = ka->in[5]; P.c = ka->in[6]; P.c_ctx = ka->in[7];
            P.w_mod = ka->in[8]; P.b_mod = ka->in[9]; P.norm_g = ka->in[10]; P.w13 = ka->in[11]; P.w2 = ka->in[12]; P.ewin = ka->in[13]; P.ewout = ka->in[14]; P.eqk = ka->in[15];
            P.elam = ka->in[16]; P.esub = ka->in[17]; P.econv = ka->in[18]; P.owin = ka->in[19]; P.owout = ka->in[20]; P.oqk = ka->in[21]; P.osink = ka->in[22];
            P.out = ka->out; P.ws = ka->ws;
            const int op = isP ? opP : opS, l = op / 10, s = op % 10, ko = isP ? kS : kP;
            const int pm0 = isP ? 0 : 16, nM = isP ? 16 : 64, row0 = isP ? 0 : NPROMPT, row1 = isP ? NPROMPT : MT;
            const float* modl = MODP + (size_t)l * 9 * 9216;
            const bool fromin = op <= 6;
            const float* xP = fromin ? P.x_prompt : xout; const float* xS = fromin ? P.x_sample : xout + (size_t)NPROMPT * DM;
            const bf16* DA = (const bf16*)(ws + WS_DA); const bf16* DB = (const bf16*)(ws + WS_DB);
            int npend = 0; const bf16 *pd0 = DA, *pd1 = DA;
            if (s <= 6) { if (l >= 1) { pd0 = DB; npend = 1; } if (s >= 3) { if (npend) pd1 = DA; else pd0 = DA; ++npend; } }
            if (s == 0 || s == 3 || s == 7) {
                const int sub = s == 0 ? 0 : (s == 3 ? 1 : 2);
                int pidx = F.vcu, pcount = F.G;
                if (!isP && F.G == 256 && (ko == 1 || ko == 8)) { pidx = (int)blockIdx.x - 96; pcount = 160; }
                int ra = row0, rb = row1;
                if (!isP && F.G == 256 && ko == 4) {
                    const int bx = (int)blockIdx.x;
                    if (l == 0) { if (bx < 192) { ra = row0 + bx * 40; rb = ra + 40; } else { ra = row0 + 7680 + (bx - 192) * 136; rb = ra + 136; } pidx = 0; pcount = 1; }
                    else { pidx = bx - 96; pcount = 160; }
                }
                norm_rows(F, xP, xS, P.norm_g + (size_t)(l * 3 + sub) * DM, modl, 3 * sub, XN, ra, rb, pidx, pcount, npend, pd0, pd1);
            } else if (s == 1 || s == 8) {
                const int fi = l * 2 + (s == 8 ? 1 : 0);
                pg8::Gemm g{XN, (const bf16*)(ws + WS_W13) + (size_t)fi * 5632 * 1024, MT, 2 * DFF, DM};
                const bool bigother = !isP && (ko == 2 || ko == 9) && F.G == 256;
                pg8::GroupOrder S; S.init(pm0, nM, 2 * DFF, F.G, (int)blockIdx.x, bigother ? 64 : 0, bigother ? 2 : 0);
                pg8::EpiSwiGLU E{HB, DFF};
                pg8::gemm_phase<pg8::EpiSwiGLU, pg8::GroupOrder, true, true>(F.lds, g, S, E);
            } else if (s == 2 || s == 9 || s == 6) {
                pg8::Gemm g; const float* gate; int hg, defer; bf16* dout = (bf16*)(ws + WS_DA);
                if (s == 6) { g = pg8::Gemm{OB, (const bf16*)(ws + (l == 0 ? WS_EWOUT : WS_OWOUT)), MT, DM, DM}; gate = modl + 5 * 1024; hg = 0; defer = 0; }
                else { const int fi = l * 2 + (s == 9 ? 1 : 0); g = pg8::Gemm{HB, (const bf16*)(ws + WS_W2) + (size_t)fi * 1024 * 2816, MT, DM, DFF}; gate = modl + (s == 2 ? 2 : 8) * 1024; hg = 1;
                       defer = (s == 2 || l == 0) ? 1 : 0; if (s == 9) dout = (bf16*)(ws + WS_DB); }
                pg8::GroupOrder S; S.init(pm0, nM, DM, F.G, (int)blockIdx.x, 0, 0);
                pg8::EpiResid E{xP, xS, xout, gate, hg, defer, dout, defer ? 0 : npend, pd0, pd1};
                pg8::gemm_phase<pg8::EpiResid, pg8::GroupOrder, true, true>(F.lds, g, S, E);
            } else if (s == 4) {
                if (l == 0) {
                    pg8::Gemm g{XN, (const bf16*)(ws + WS_EWIN), MT, 3072, DM};
                    pg8::GroupOrder S; S.init(pm0, nM, 3072, F.G, (int)blockIdx.x, 0, 0);
                    pg8::EpiQKVEven E{HB, P.out + OUT_EK, P.out + OUT_EV, P.eqk, ROPE_COS, ROPE_SIN};
                    pg8::gemm_phase<pg8::EpiQKVEven, pg8::GroupOrder, true, true>(F.lds, g, S, E);
                } else {
                    pg8::Gemm g{XN, (const bf16*)(ws + WS_OWIN), MT, 1536, DM};
                    pg8::GroupOrder S; S.init(pm0, nM, 1536, F.G, (int)blockIdx.x, 0, 0);
                    pg8::EpiQKVOdd E{HB, P.out + OUT_OK, P.out + OUT_OV, P.oqk, ROPE_COS, ROPE_SIN};
                    pg8::gemm_phase<pg8::EpiQKVOdd, pg8::GroupOrder, true, true>(F.lds, g, S, E);
                }
            } else {
                if (l == 0) {
                    const float a = wave_sum(P.elam[F.lane] * P.elam[64 + F.lane]), b2 = wave_sum(P.elam[128 + F.lane] * P.elam[192 + F.lane]);
                    const float lam_init = 0.8f - 0.6f * expf(-0.3f * (float)l);
                    const float lam = expf(a) - expf(b2) + lam_init;
                    const int nunits = isP ? 128 : 512;
                    if (isP) { for (int pu = F.vcu; pu < nunits; pu += F.G) { const int bh = pu >> 1; att::even_unit(F.lds, HB, nullptr, nullptr, OB, P.esub, lam, 1.0f - lam_init, false, bh >> 2, bh & 3, pu & 1); } }
                    else { for (int w = F.vcu; w < 256; w += F.G) for (int i = 0; i < 2; ++i) { const int su = w * 2 + i; const int bh = su >> 4; att::even_unit(F.lds, HB, (const bf16*)(ws + WS_CEK), (const bf16*)(ws + WS_CEV), OB, P.esub, lam, 1.0f - lam_init, true, bh >> 2, bh & 3, su & 15); } }
                    {   int pidx = F.vcu, pcount = F.G;
                        if (F.G == 256) { if (isP) { pidx = F.vcu - 128; pcount = 128; } else { pidx = (int)blockIdx.x - 64; pcount = 192; } }
                        conv_rows(F, HB, P.econv, OB, row0, row1, pidx, pcount); }
                } else {
                    if (isP) { for (int pu = F.vcu; pu < 256; pu += F.G) { const int bg = pu >> 2; att::odd_unit(F.lds, HB, nullptr, nullptr, OB, P.osink, false, bg >> 2, bg & 3, pu & 3); } }
                    else { for (int w = F.vcu; w < 256; w += F.G) for (int su = w * 4; su < w * 4 + 4; ++su) { const int bg = su >> 5; att::odd_unit(F.lds, HB, (const bf16*)(ws + WS_COK), (const bf16*)(ws + WS_COV), OB, P.osink, true, bg >> 2, bg & 3, su & 31); } }
                }
            }
        }
      }
        if (ph + 1 < ph_hi) xcd_barrier(bar);
    }
}

extern "C" void kernel_launch(void* const* d_in, const int* in_sizes, int n_in, void* d_out, int out_size, void* d_ws, size_t ws_size, hipStream_t stream) {
    static int grid = 0;
    if (grid == 0) {
        if (n_in != 23 || in_sizes[0] != NPROMPT * DM || in_sizes[1] != NSAMPLE * DM || (size_t)out_size != OUT_TOTAL || ws_size < WS_END) {
            fprintf(stderr, "kernel_launch: shape mismatch: n_in %d in0 %d in1 %d out %d ws %zu (need %zu); nothing launched\n", n_in, n_in > 0 ? in_sizes[0] : -1, n_in > 1 ? in_sizes[1] : -1, out_size, ws_size, (size_t)WS_END); grid = -1; return; }
        int dev = 0, cus = 0, per_cu = 0;
        if (hipGetDevice(&dev) != hipSuccess || hipDeviceGetAttribute(&cus, hipDeviceAttributeMultiprocessorCount, dev) != hipSuccess) { fprintf(stderr, "kernel_launch: device query failed\n"); grid = -1; return; }
        if (hipFuncSetAttribute((const void*)mega_fwd, hipFuncAttributeMaxDynamicSharedMemorySize, LDS_BYTES) != hipSuccess) { fprintf(stderr, "kernel_launch: hipFuncSetAttribute failed\n"); grid = -1; return; }
        if (hipOccupancyMaxActiveBlocksPerMultiprocessor(&per_cu, (const void*)mega_fwd, NWAVES * 64, LDS_BYTES) != hipSuccess || per_cu < 1) { fprintf(stderr, "kernel_launch: occupancy query says %d blocks per CU; nothing launched\n", per_cu); (void)hipGetLastError(); grid = -1; return; }
        grid = cus;
        if (grid % 8 != 0 || grid < 8) fprintf(stderr, "kernel_launch: note: %d CUs\n", grid);
    }
    if (grid < 0) return;
    if (hipMemsetAsync((char*)d_ws + WS_CTL, 0, CTL_ZERO_BYTES, stream) != hipSuccess) { fprintf(stderr, "kernel_launch: memset failed\n"); return; }
    Args a{};
    for (int i = 0; i < 23; ++i) a.in[i] = (const float*)d_in[i];
    a.out = (float*)d_out; a.ws = (unsigned char*)d_ws;
#if MK_PER_PHASE
    for (int ph = 0; ph < N_PHASES; ++ph) { a.ph_lo = ph; a.ph_hi = ph + 1; hipLaunchKernelGGL(mega_fwd, dim3(grid), dim3(NWAVES * 64), LDS_BYTES, stream, a); }
#else
    a.ph_lo = 0; a.ph_hi = N_PHASES;
    hipLaunchKernelGGL(mega_fwd, dim3(grid), dim3(NWAVES * 64), LDS_BYTES, stream, a);
#endif
    const hipError_t le = hipPeekAtLastError();
    if (le != hipSuccess) fprintf(stderr, "kernel_launch: launch failed: %s\n", hipGetErrorName(le));
}
```

```cpp
#include <hip/hip_runtime.h>
#include <cstdio>
#include <cstdint>
#include <cmath>

__device__ const float ROPE_COS[64 * 16] = {
  1.000000000e+00f, 1.000000000e+00f, 1.000000000e+00f, 1.000000000e+00f, 1.000000000e+00f, 1.000000000e+00f, 1.000000000e+00f, 1.000000000e+00f, 1.000000000e+00f, 1.000000000e+00f, 1.000000000e+00f, 1.000000000e+00f, 1.000000000e+00f, 1.000000000e+00f, 1.000000000e+00f, 1.000000000e+00f,
  5.403023059e-01f, 8.460091103e-01f, 9.504152803e-01f, 9.842302345e-01f, 9.950041653e-01f, 9.984192778e-01f, 9.995000417e-01f, 9.998418903e-01f, 9.999500004e-01f, 9.999841887e-01f, 9.999950000e-01f, 9.999984189e-01f, 9.999995000e-01f, 9.999998419e-01f, 9.999999500e-01f, 9.999999842e-01f,
  -4.161468365e-01f, 4.314628294e-01f, 8.065784099e-01f, 9.374183089e-01f, 9.800665778e-01f, 9.936821085e-01f, 9.980006666e-01f, 9.993676111e-01f, 9.998000067e-01f, 9.999367551e-01f, 9.999800001e-01f, 9.999936755e-01f, 9.999980000e-01f, 9.999993675e-01f, 9.999998000e-01f, 9.999999368e-01f,
  -9.899924966e-01f, -1.159661415e-01f, 5.827536107e-01f, 8.610406494e-01f, 9.553364891e-01f, 9.858034685e-01f, 9.955033740e-01f, 9.985773125e-01f, 9.995500337e-01f, 9.998577009e-01f, 9.999550003e-01f, 9.999857698e-01f, 9.999955000e-01f, 9.999985770e-01f, 9.999995500e-01f, 9.999998577e-01f,
  -6.536436209e-01f, -6.276796538e-01f, 3.011374626e-01f, 7.575061717e-01f, 9.210609940e-01f, 9.748082656e-01f, 9.920106610e-01f, 9.974712444e-01f, 9.992001067e-01f, 9.997470285e-01f, 9.999200011e-01f, 9.999747019e-01f, 9.999920000e-01f, 9.999974702e-01f, 9.999992000e-01f, 9.999997470e-01f,
  2.836621855e-01f, -9.460792693e-01f, -1.034231891e-02f, 6.300803045e-01f, 8.775825619e-01f, 9.607312606e-01f, 9.875260200e-01f, 9.960497564e-01f, 9.987502604e-01f, 9.996047413e-01f, 9.998750026e-01f, 9.999604718e-01f, 9.999875000e-01f, 9.999960472e-01f, 9.999987500e-01f, 9.999996047e-01f,
  9.601702867e-01f, -9.731037080e-01f, -3.207964584e-01f, 4.827820000e-01f, 8.253356149e-01f, 9.436169571e-01f, 9.820539352e-01f, 9.943132982e-01f, 9.982005399e-01f, 9.994308440e-01f, 9.998200054e-01f, 9.999430795e-01f, 9.999820001e-01f, 9.999943079e-01f, 9.999982000e-01f, 9.999994308e-01f,
  7.539022543e-01f, -7.004299352e-01f, -5.994373930e-01f, 3.202569776e-01f, 7.648421873e-01f, 9.235194611e-01f, 9.755998784e-01f, 9.922624187e-01f, 9.975510003e-01f, 9.992253420e-01f, 9.997550100e-01f, 9.999225252e-01f, 9.999755001e-01f, 9.999922524e-01f, 9.999975500e-01f, 9.999992252e-01f,
  -1.455000338e-01f, -2.120365045e-01f, -8.186324573e-01f, 1.476312003e-01f, 6.967067093e-01f, 9.005023096e-01f, 9.681703030e-01f, 9.898977666e-01f, 9.968017063e-01f, 9.989882418e-01f, 9.996800171e-01f, 9.998988088e-01f, 9.999680002e-01f, 9.999898807e-01f, 9.999968000e-01f, 9.999989881e-01f,
  -9.111302619e-01f, 3.416603061e-01f, -9.566441996e-01f, -2.965079584e-02f, 6.216099683e-01f, 8.746382701e-01f, 9.597726380e-01f, 9.872200896e-01f, 9.959527330e-01f, 9.987195509e-01f, 9.995950273e-01f, 9.998719305e-01f, 9.999595003e-01f, 9.999871928e-01f, 9.999959500e-01f, 9.999987193e-01f,
  -8.390715291e-01f, 7.901319677e-01f, -9.997860729e-01f, -2.059976198e-01f, 5.403023059e-01f, 8.460091103e-01f, 9.504152803e-01f, 9.842302345e-01f, 9.950041653e-01f, 9.984192778e-01f, 9.995000417e-01f, 9.998418903e-01f, 9.999500004e-01f, 9.999841887e-01f, 9.999950000e-01f, 9.999984189e-01f,
  4.425697988e-03f, 9.952573799e-01f, -9.437797217e-01f, -3.758473754e-01f, 4.535961214e-01f, 8.147053397e-01f, 9.401075865e-01f, 9.809291466e-01f, 9.939560980e-01f, 9.980874320e-01f, 9.993950610e-01f, 9.998086883e-01f, 9.999395006e-01f, 9.999808683e-01f, 9.999939500e-01f, 9.999980868e-01f,
  8.438539587e-01f, 8.938616532e-01f, -7.941792645e-01f, -5.338430810e-01f, 3.623577545e-01f, 7.808259235e-01f, 9.288598634e-01f, 9.773178698e-01f, 9.928086359e-01f, 9.977240240e-01f, 9.992800864e-01f, 9.997723246e-01f, 9.999280009e-01f, 9.999772317e-01f, 9.999928000e-01f, 9.999977232e-01f,
  9.074467815e-01f, 5.171728240e-01f, -5.658204948e-01f, -6.750016262e-01f, 2.674988286e-01f, 7.444779696e-01f, 9.166833580e-01f, 9.733975461e-01f, 9.915618937e-01f, 9.973290652e-01f, 9.991551190e-01f, 9.997327994e-01f, 9.999155012e-01f, 9.999732789e-01f, 9.999915500e-01f, 9.999973279e-01f,
  1.367372182e-01f, -1.879581181e-02f, -2.813496238e-01f, -7.948709366e-01f, 1.699671429e-01f, 7.057763899e-01f, 9.035902455e-01f, 9.691694153e-01f, 9.902159962e-01f, 9.969025682e-01f, 9.990201601e-01f, 9.996901128e-01f, 9.999020016e-01f, 9.999690098e-01f, 9.999902000e-01f, 9.999969010e-01f,
  -7.596879129e-01f, -5.489756801e-01f, 3.102253171e-02f, -8.896703905e-01f, 7.073720167e-02f, 6.648435374e-01f, 8.895936181e-01f, 9.646348142e-01f, 9.887710779e-01f, 9.964445465e-01f, 9.988752109e-01f, 9.996442649e-01f, 9.998875021e-01f, 9.999644246e-01f, 9.999887500e-01f, 9.999964424e-01f,
  -9.576594803e-01f, -9.100810415e-01f, 3.403182001e-01f, -9.564100574e-01f, -2.919952230e-02f, 6.218088190e-01f, 8.747074712e-01f, 9.597951768e-01f, 9.872272834e-01f, 9.959550145e-01f, 9.987202730e-01f, 9.995952558e-01f, 9.998720027e-01f, 9.999595231e-01f, 9.999872000e-01f, 9.999959523e-01f,
  -2.751633381e-01f, -9.908980244e-01f, 6.158647034e-01f, -9.929849996e-01f, -1.288444943e-01f, 5.768082866e-01f, 8.589466897e-01f, 9.546520336e-01f, 9.855847669e-01f, 9.954339878e-01f, 9.985553480e-01f, 9.995430857e-01f, 9.998555035e-01f, 9.999543054e-01f, 9.999855500e-01f, 9.999954305e-01f,
  6.603167082e-01f, -7.665364704e-01f, 8.303362493e-01f, -9.982416606e-01f, -2.272020947e-01f, 5.299842069e-01f, 8.423270331e-01f, 9.492070108e-01f, 9.838436928e-01f, 9.948814827e-01f, 9.983804374e-01f, 9.994877548e-01f, 9.998380044e-01f, 9.999487715e-01f, 9.999838000e-01f, 9.999948771e-01f,
  9.887046182e-01f, -3.060956503e-01f, 9.624638147e-01f, -9.720142477e-01f, -3.232895669e-01f, 4.814846115e-01f, 8.248651197e-01f, 9.434618303e-01f, 9.820042351e-01f, 9.942975168e-01f, 9.981955429e-01f, 9.994292632e-01f, 9.998195054e-01f, 9.999429214e-01f, 9.999819501e-01f, 9.999942921e-01f,
  4.080820618e-01f, 2.486170528e-01f, 9.991443830e-01f, -9.151299613e-01f, -4.161468365e-01f, 4.314628294e-01f, 8.065784099e-01f, 9.374183089e-01f, 9.800665778e-01f, 9.936821085e-01f, 9.980006666e-01f, 9.993676111e-01f, 9.998000067e-01f, 9.999367551e-01f, 9.999800001e-01f, 9.999936755e-01f,
  -5.477292602e-01f, 7.267602337e-01f, 9.367403630e-01f, -8.293829050e-01f, -5.048461046e-01f, 3.800770014e-01f, 7.874851889e-01f, 9.310783576e-01f, 9.780309147e-01f, 9.930352774e-01f, 9.977958102e-01f, 9.993027988e-01f, 9.997795081e-01f, 9.999302726e-01f, 9.999779501e-01f, 9.999930272e-01f,
  -9.999608264e-01f, 9.810745045e-01f, 7.814403262e-01f, -7.174775009e-01f, -5.885011173e-01f, 3.274895812e-01f, 7.676045483e-01f, 9.244439812e-01f, 9.758974493e-01f, 9.923570438e-01f, 9.975809759e-01f, 9.992348264e-01f, 9.997580098e-01f, 9.999234739e-01f, 9.999758001e-01f, 9.999923473e-01f,
  -5.328330203e-01f, 9.332357037e-01f, 5.486452902e-01f, -5.829431928e-01f, -6.662760213e-01f, 2.738668208e-01f, 7.469563671e-01f, 9.175172776e-01f, 9.736663950e-01f, 9.916474291e-01f, 9.973561658e-01f, 9.991636942e-01f, 9.997355117e-01f, 9.999163589e-01f, 9.999735501e-01f, 9.999916358e-01f,
  4.241790073e-01f, 5.979773102e-01f, 2.614414084e-01f, -4.300231298e-01f, -7.373937155e-01f, 2.193782457e-01f, 7.255612918e-01f, 9.103004373e-01f, 9.713379749e-01f, 9.909064559e-01f, 9.971213821e-01f, 9.990894023e-01f, 9.997120138e-01f, 9.999089278e-01f, 9.999712001e-01f, 9.999908927e-01f,
  9.912028119e-01f, 7.855280068e-02f, -5.168947139e-02f, -2.635403389e-01f, -8.011436155e-01f, 1.641961185e-01f, 7.034407157e-01f, 9.027957423e-01f, 9.689124217e-01f, 9.901341476e-01f, 9.968766273e-01f, 9.990119510e-01f, 9.996875163e-01f, 9.999011805e-01f, 9.999687502e-01f, 9.999901179e-01f,
  6.469193223e-01f, -4.650645402e-01f, -3.596943353e-01f, -8.874560929e-02f, -8.568887534e-01f, 1.084948944e-01f, 6.806167575e-01f, 8.950055657e-01f, 9.663899781e-01f, 9.893305286e-01f, 9.966219036e-01f, 9.989313405e-01f, 9.996620190e-01f, 9.998931169e-01f, 9.999662002e-01f, 9.999893115e-01f,
  -2.921388087e-01f, -8.654504764e-01f, -6.320285135e-01f, 8.884811520e-02f, -9.040721420e-01f, 5.245066969e-02f, 6.571122393e-01f, 8.869323709e-01f, 9.637708964e-01f, 9.884956243e-01f, 9.963572138e-01f, 9.988475712e-01f, 9.996355221e-01f, 9.998847372e-01f, 9.999635502e-01f, 9.999884735e-01f,
  -9.626058663e-01f, -9.992934349e-01f, -8.416847784e-01f, 2.636396118e-01f, -9.422223407e-01f, -3.759374883e-03f, 6.329506635e-01f, 8.785787110e-01f, 9.610554383e-01f, 9.876294611e-01f, 9.960825604e-01f, 9.987606432e-01f, 9.996080256e-01f, 9.998760413e-01f, 9.999608003e-01f, 9.999876039e-01f,
  -7.480575297e-01f, -8.253722231e-01f, -9.678716355e-01f, 4.301160387e-01f, -9.709581651e-01f, -5.995753440e-02f, 6.081561899e-01f, 8.699472273e-01f, 9.582438755e-01f, 9.867320664e-01f, 9.957979462e-01f, 9.986705569e-01f, 9.995795295e-01f, 9.998670292e-01f, 9.999579503e-01f, 9.999867027e-01f,
  1.542514499e-01f, -3.972514054e-01f, -9.980752051e-01f, 5.830268074e-01f, -9.899924966e-01f, -1.159661415e-01f, 5.827536107e-01f, 8.610406494e-01f, 9.553364891e-01f, 9.858034685e-01f, 9.955033740e-01f, 9.985773125e-01f, 9.995500337e-01f, 9.998577009e-01f, 9.999550003e-01f, 9.999857698e-01f,
  9.147423578e-01f, 1.532156071e-01f, -9.293002159e-01f, 7.175491840e-01f, -9.991351503e-01f, -1.716081281e-01f, 5.567683265e-01f, 8.518617938e-01f, 9.523335699e-01f, 9.848436969e-01f, 9.951988468e-01f, 9.984809103e-01f, 9.995195385e-01f, 9.998480564e-01f, 9.999519504e-01f, 9.999848053e-01f,
  8.342233605e-01f, 6.564950042e-01f, -7.683670453e-01f, 8.294403958e-01f, -9.982947758e-01f, -2.267075851e-01f, 5.302263203e-01f, 8.424135629e-01f, 9.492354181e-01f, 9.838527819e-01f, 9.948843676e-01f, 9.983813507e-01f, 9.994880437e-01f, 9.998380958e-01f, 9.999488004e-01f, 9.999838092e-01f,
  -1.327674722e-02f, 9.575859018e-01f, -5.312353455e-01f, 9.151714465e-01f, -9.874797699e-01f, -2.810903188e-01f, 5.031541321e-01f, 8.326989444e-01f, 9.460423435e-01f, 9.828307548e-01f, 9.945599395e-01f, 9.982786339e-01f, 9.994555494e-01f, 9.998278189e-01f, 9.999455505e-01f, 9.999827814e-01f,
  -8.485702748e-01f, 9.637577894e-01f, -2.414213342e-01f, 9.720384190e-01f, -9.667981926e-01f, -3.345844009e-01f, 4.755788316e-01f, 8.227210104e-01f, 9.427546655e-01f, 9.817776480e-01f, 9.942255659e-01f, 9.981727603e-01f, 9.994220557e-01f, 9.998172259e-01f, 9.999422006e-01f, 9.999817221e-01f,
  -9.036922051e-01f, 6.731098380e-01f, 7.233429552e-02f, 9.982477555e-01f, -9.364566873e-01f, -3.870207132e-01f, 4.475279919e-01f, 8.124829160e-01f, 9.393727128e-01f, 9.806934947e-01f, 9.938812501e-01f, 9.980637301e-01f, 9.993875625e-01f, 9.998063167e-01f, 9.999387506e-01f, 9.999806311e-01f,
  -1.279636896e-01f, 1.751563210e-01f, 3.789165737e-01f, 9.929728260e-01f, -8.967584163e-01f, -4.382334809e-01f, 4.190296615e-01f, 8.019878987e-01f, 9.358968237e-01f, 9.795783292e-01f, 9.935269954e-01f, 9.979515438e-01f, 9.993520700e-01f, 9.997950914e-01f, 9.999352007e-01f, 9.999795085e-01f,
  7.654140519e-01f, -3.767421515e-01f, 6.479219076e-01f, 9.563799991e-01f, -8.481000317e-01f, -4.880607978e-01f, 3.901123364e-01f, 7.912392773e-01f, 9.323273456e-01f, 9.784321869e-01f, 9.931628054e-01f, 9.978362017e-01f, 9.993155781e-01f, 9.997835499e-01f, 9.999315508e-01f, 9.999783543e-01f,
  9.550736440e-01f, -8.126109057e-01f, 8.526731891e-01f, 8.896233956e-01f, -7.909677119e-01f, -5.363451377e-01f, 3.608049314e-01f, 7.802404506e-01f, 9.286646356e-01f, 9.772551038e-01f, 9.927886839e-01f, 9.977177042e-01f, 9.992780869e-01f, 9.997716922e-01f, 9.999278009e-01f, 9.999771684e-01f,
  2.666429324e-01f, -9.982103072e-01f, 9.728653484e-01f, 7.948084874e-01f, -7.259323042e-01f, -5.829338522e-01f, 3.311367516e-01f, 7.689948967e-01f, 9.249090599e-01f, 9.760471174e-01f, 9.924046345e-01f, 9.975960516e-01f, 9.992395964e-01f, 9.997595184e-01f, 9.999239510e-01f, 9.999759510e-01f,
  -6.669380617e-01f, -8.763791221e-01f, 9.965789963e-01f, 6.749256921e-01f, -6.536436209e-01f, -6.276796538e-01f, 3.011374626e-01f, 7.575061717e-01f, 9.210609940e-01f, 9.748082656e-01f, 9.920106610e-01f, 9.974712444e-01f, 9.992001067e-01f, 9.997470285e-01f, 9.999200011e-01f, 9.999747019e-01f,
  -9.873392775e-01f, -4.846391354e-01f, 9.214624639e-01f, 5.337560571e-01f, -5.748239465e-01f, -6.704410810e-01f, 2.708370612e-01f, 7.457779085e-01f, 9.171208228e-01f, 9.735385879e-01f, 9.916067674e-01f, 9.973432828e-01f, 9.991596177e-01f, 9.997342223e-01f, 9.999159512e-01f, 9.999734212e-01f,
  -3.999853150e-01f, 5.636087450e-02f, 7.549650153e-01f, 3.757520063e-01f, -4.902608213e-01f, -7.110829460e-01f, 2.402658454e-01f, 7.338138159e-01f, 9.130889403e-01f, 9.722381242e-01f, 9.911929578e-01f, 9.972121674e-01f, 9.991181296e-01f, 9.997211001e-01f, 9.999118013e-01f, 9.999721088e-01f,
  5.551133015e-01f, 5.800027620e-01f, 5.135981094e-01f, 2.058969135e-01f, -4.007991721e-01f, -7.494767618e-01f, 2.094543837e-01f, 7.216176770e-01f, 9.089657497e-01f, 9.709069157e-01f, 9.907692362e-01f, 9.970778985e-01f, 9.990756424e-01f, 9.997076617e-01f, 9.999075514e-01f, 9.999707649e-01f,
  9.998433086e-01f, 9.250143668e-01f, 2.212979668e-01f, 2.954792850e-02f, -3.073328700e-01f, -7.855011484e-01f, 1.784334851e-01f, 7.091933487e-01f, 9.047516632e-01f, 9.695450046e-01f, 9.903356070e-01f, 9.969404766e-01f, 9.990321562e-01f, 9.996939071e-01f, 9.999032016e-01f, 9.999693893e-01f,
  5.253219888e-01f, 9.851384009e-01f, -9.294817111e-02f, -1.477329843e-01f, -2.107957994e-01f, -8.190422169e-01f, 1.472341679e-01f, 6.965447596e-01f, 9.004471024e-01f, 9.681524338e-01f, 9.898920744e-01f, 9.967999021e-01f, 9.989876708e-01f, 9.996798365e-01f, 9.998987517e-01f, 9.999679821e-01f,
  -4.321779449e-01f, 7.418577573e-01f, -3.979766910e-01f, -3.203544680e-01f, -1.121525269e-01f, -8.499939289e-01f, 1.158876288e-01f, 6.836759095e-01f, 8.960524975e-01f, 9.667292474e-01f, 9.894386429e-01f, 9.966561754e-01f, 9.989421865e-01f, 9.996654497e-01f, 9.998942019e-01f, 9.999665433e-01f,
  -9.923354692e-01f, 2.700984415e-01f, -6.635380855e-01f, -4.828721220e-01f, -1.238866346e-02f, -8.782584324e-01f, 8.442521171e-02f, 6.705908678e-01f, 8.915682882e-01f, 9.652754904e-01f, 9.889753170e-01f, 9.965092971e-01f, 9.988957033e-01f, 9.996507468e-01f, 9.998895520e-01f, 9.999650728e-01f,
  -6.401443395e-01f, -2.848462729e-01f, -8.632967800e-01f, -6.301602158e-01f, 8.749898344e-02f, -9.037463706e-01f, 5.287837645e-02f, 6.572937723e-01f, 8.869949228e-01f, 9.637912089e-01f, 9.885021014e-01f, 9.963592674e-01f, 9.988482212e-01f, 9.996357277e-01f, 9.998848022e-01f, 9.999635708e-01f,
  3.005925437e-01f, -7.520635254e-01f, -9.774428167e-01f, -7.575733518e-01f, 1.865123694e-01f, -9.263771649e-01f, 2.127866722e-02f, 6.437888276e-01f, 8.823328586e-01f, 9.622764496e-01f, 9.880190008e-01f, 9.962060871e-01f, 9.987997402e-01f, 9.996203926e-01f, 9.998799524e-01f, 9.999620371e-01f,
  9.649660285e-01f, -9.876589150e-01f, -9.946563971e-01f, -8.610929796e-01f, 2.836621855e-01f, -9.460792693e-01f, -1.034231891e-02f, 6.300803045e-01f, 8.775825619e-01f, 9.607312606e-01f, 9.875260200e-01f, 9.960497564e-01f, 9.987502604e-01f, 9.996047413e-01f, 9.998750026e-01f, 9.999604718e-01f,
  7.421541968e-01f, -9.190733545e-01f, -9.132304601e-01f, -9.374541386e-01f, 3.779777427e-01f, -9.627903967e-01f, -4.195296357e-02f, 6.161725377e-01f, 8.727445076e-01f, 9.591556907e-01f, 9.870231639e-01f, 9.958902760e-01f, 9.986997819e-01f, 9.995887740e-01f, 9.998699528e-01f, 9.999588749e-01f,
  -1.629907808e-01f, -5.674299469e-01f, -7.412399703e-01f, -9.842484337e-01f, 4.685166713e-01f, -9.764577158e-01f, -7.352165877e-02f, 6.020699252e-01f, 8.678191797e-01f, 9.575497897e-01f, 9.865104376e-01f, 9.957276462e-01f, 9.986483046e-01f, 9.995724905e-01f, 9.998648030e-01f, 9.999572463e-01f,
  -9.182827862e-01f, -4.102845452e-02f, -4.957411282e-01f, -9.999999947e-01f, 5.543743362e-01f, -9.870380181e-01f, -1.050168384e-01f, 5.877769265e-01f, 8.628070705e-01f, 9.559136084e-01f, 9.859878462e-01f, 9.955618678e-01f, 9.985958287e-01f, 9.995558910e-01f, 9.998595533e-01f, 9.999555861e-01f,
  -8.293098329e-01f, 4.980090543e-01f, -2.010799162e-01f, -9.842120249e-01f, 6.346928759e-01f, -9.944978545e-01f, -1.364070100e-01f, 5.732980613e-01f, 8.577086814e-01f, 9.542471985e-01f, 9.854553950e-01f, 9.953929410e-01f, 9.985423543e-01f, 9.995389753e-01f, 9.998542035e-01f, 9.999538943e-01f,
  2.212675626e-02f, 8.836688484e-01f, 1.135222784e-01f, -9.373824693e-01f, 7.086697743e-01f, -9.988136413e-01f, -1.676607860e-01f, 5.586379081e-01f, 8.525245221e-01f, 9.525506128e-01f, 9.849130892e-01f, 9.952208666e-01f, 9.984878812e-01f, 9.995217436e-01f, 9.998487538e-01f, 9.999521709e-01f,
  8.532201077e-01f, 9.971747381e-01f, 4.168665323e-01f, -8.609883102e-01f, 7.755658785e-01f, -9.999717342e-01f, -1.987469151e-01f, 5.438011027e-01f, 8.472551110e-01f, 9.508239048e-01f, 9.843609343e-01f, 9.950456450e-01f, 9.984324097e-01f, 9.995041958e-01f, 9.998432041e-01f, 9.999504159e-01f,
  8.998668270e-01f, 8.035689776e-01f, 6.788703658e-01f, -7.574389836e-01f, 8.347127848e-01f, -9.979684721e-01f, -2.296343139e-01f, 5.287923369e-01f, 8.419009752e-01f, 9.490671292e-01f, 9.837989357e-01f, 9.948672768e-01f, 9.983759398e-01f, 9.994863320e-01f, 9.998375544e-01f, 9.999486292e-01f,
  1.191801354e-01f, 3.624786135e-01f, 8.735510056e-01f, -6.300003866e-01f, 8.855195169e-01f, -9.928101881e-01f, -2.602920974e-01f, 5.136163566e-01f, 8.364626499e-01f, 9.472803416e-01f, 9.832270992e-01f, 9.946857625e-01f, 9.983184715e-01f, 9.994681520e-01f, 9.998318047e-01f, 9.999468110e-01f,
  -7.710802230e-01f, -1.902485591e-01f, 9.816020819e-01f, -4.826918728e-01f, 9.274784307e-01f, -9.845131900e-01f, -2.906896106e-01f, 4.982779609e-01f, 8.309406791e-01f, 9.454635984e-01f, 9.826454305e-01f, 9.945011028e-01f, 9.982600048e-01f, 9.994496561e-01f, 9.998259550e-01f, 9.999449611e-01f,
  -9.524129804e-01f, -6.843826418e-01f, 9.923082299e-01f, -3.201594838e-01f, 9.601702867e-01f, -9.731037080e-01f, -3.207964584e-01f, 4.827820000e-01f, 8.253356149e-01f, 9.436169571e-01f, 9.820539352e-01f, 9.943132982e-01f, 9.982005399e-01f, 9.994308440e-01f, 9.998200054e-01f, 9.999430795e-01f,
  -2.581016359e-01f, -9.677393408e-01f, 9.046077269e-01f, -1.475294147e-01f, 9.832684384e-01f, -9.586178129e-01f, -3.505825365e-01f, 4.671333740e-01f, 8.196480178e-01f, 9.417404761e-01f, 9.814526195e-01f, 9.941223493e-01f, 9.981400768e-01f, 9.994117159e-01f, 9.998139558e-01f, 9.999411664e-01f,
  6.735071623e-01f, -9.530499555e-01f, 7.271977827e-01f, 2.975366287e-02f, 9.965420970e-01f, -9.411013007e-01f, -3.800180612e-01f, 4.513370314e-01f, 8.138784567e-01f, 9.398342148e-01f, 9.808414892e-01f, 9.939282566e-01f, 9.980786156e-01f, 9.993922718e-01f, 9.998078062e-01f, 9.999392216e-01f,
  9.858965816e-01f, -6.448385490e-01f, 4.776720420e-01f, 2.060983239e-01f, 9.998586364e-01f, -9.206095492e-01f, -4.090735996e-01f, 4.353979673e-01f, 8.080275083e-01f, 9.378982333e-01f, 9.802205506e-01f, 9.937310210e-01f, 9.980161563e-01f, 9.993725116e-01f, 9.998015566e-01f, 9.999372453e-01f,
};
__device__ const float ROPE_SIN[64 * 16] = {
  0.000000000e+00f, 0.000000000e+00f, 0.000000000e+00f, 0.000000000e+00f, 0.000000000e+00f, 0.000000000e+00f, 0.000000000e+00f, 0.000000000e+00f, 0.000000000e+00f, 0.000000000e+00f, 0.000000000e+00f, 0.000000000e+00f, 0.000000000e+00f, 0.000000000e+00f, 0.000000000e+00f, 0.000000000e+00f,
  8.414709848e-01f, 5.331684399e-01f, 3.109835929e-01f, 1.768921862e-01f, 9.983341665e-02f, 5.620449921e-02f, 3.161750640e-02f, 1.778185688e-02f, 9.999833334e-03f, 5.623383614e-03f, 3.162272390e-03f, 1.778278473e-03f, 9.999998333e-04f, 5.623412956e-04f, 3.162277607e-04f, 1.778279401e-04f,
  9.092974268e-01f, 9.021307150e-01f, 5.911271172e-01f, 3.482052759e-01f, 1.986693308e-01f, 1.122313110e-01f, 6.320339793e-02f, 3.555809079e-02f, 1.999866669e-02f, 1.124658940e-02f, 6.324513157e-03f, 3.556551322e-03f, 1.999998667e-03f, 1.124682413e-03f, 6.324554899e-04f, 3.556558745e-04f,
  1.411200081e-01f, 9.932531671e-01f, 8.126488966e-01f, 5.085361344e-01f, 2.955202067e-01f, 1.679033098e-01f, 9.472609133e-02f, 5.332308054e-02f, 2.999550020e-02f, 1.686943954e-02f, 9.486690679e-03f, 5.334812925e-03f, 2.999995500e-03f, 1.687023175e-03f, 9.486831557e-04f, 5.334837977e-04f,
  -7.568024953e-01f, 7.784717415e-01f, 9.535807405e-01f, 6.528280017e-01f, 3.894183423e-01f, 2.230444916e-01f, 1.261540665e-01f, 7.107120850e-02f, 3.998933419e-02f, 2.249175622e-02f, 1.264877333e-02f, 7.113057657e-03f, 3.999989333e-03f, 2.249363404e-03f, 1.264910727e-03f, 7.113117040e-04f,
  -9.589242747e-01f, 3.239352036e-01f, 9.999465168e-01f, 7.765299800e-01f, 4.794255386e-01f, 2.774805306e-01f, 1.574558982e-01f, 8.879686236e-02f, 4.997916927e-02f, 2.811336166e-02f, 1.581072950e-02f, 8.891279896e-03f, 4.999979167e-03f, 2.811702921e-03f, 1.581138171e-03f, 8.891395879e-04f,
  -2.794154982e-01f, -2.303674747e-01f, 9.471481575e-01f, 8.757405669e-01f, 5.646424734e-01f, 3.310393303e-01f, 1.886002871e-01f, 1.064944369e-01f, 5.996400648e-02f, 3.373407807e-02f, 1.897252756e-02f, 1.066947402e-02f, 5.999964000e-03f, 3.374041549e-03f, 1.897365458e-03f, 1.066967444e-03f,
  6.569865987e-01f, -7.137211682e-01f, 8.004216463e-01f, 9.473307069e-01f, 6.442176872e-01f, 3.835515676e-01f, 2.195560914e-01f, 1.241583359e-01f, 6.994284734e-02f, 3.935372772e-02f, 2.213413590e-02f, 1.244763440e-02f, 6.999942833e-03f, 3.936379111e-03f, 2.213592554e-03f, 1.244795266e-03f,
  9.893582466e-01f, -9.772617463e-01f, 5.743177691e-01f, 9.890424807e-01f, 7.173560909e-01f, 4.348512280e-01f, 2.502923579e-01f, 1.417829736e-01f, 7.991469397e-02f, 4.497213290e-02f, 2.529552289e-02f, 1.422575542e-02f, 7.999914667e-03f, 4.498715427e-03f, 2.529819430e-03f, 1.422623048e-03f,
  4.121184852e-01f, -9.398235128e-01f, 2.912591207e-01f, 9.995603185e-01f, 7.833269096e-01f, 4.847761303e-01f, 2.807783529e-01f, 1.593627767e-01f, 8.987854920e-02f, 5.058911594e-02f, 2.845665693e-02f, 1.600383145e-02f, 8.999878500e-03f, 5.061050321e-03f, 2.846046052e-03f, 1.600450786e-03f,
  -5.440211109e-01f, -6.129367615e-01f, -2.068353153e-02f, 9.785524925e-01f, 8.414709848e-01f, 5.331684399e-01f, 3.109835929e-01f, 1.768921862e-01f, 9.983341665e-02f, 5.620449921e-02f, 3.161750640e-02f, 1.778185688e-02f, 9.999833334e-03f, 5.623383614e-03f, 3.162272390e-03f, 1.778278473e-03f,
  -9.999902066e-01f, -9.727665569e-02f, -3.305750095e-01f, 9.266815798e-01f, 8.912073601e-01f, 5.798751671e-01f, 3.408778753e-01f, 1.943656590e-01f, 1.097783008e-01f, 6.181810515e-02f, 3.477803970e-02f, 1.955982607e-02f, 1.099977817e-02f, 6.185715129e-03f, 3.478498411e-03f, 1.956106104e-03f,
  -5.365729180e-01f, 4.483428876e-01f, -6.076835491e-01f, 8.455835647e-01f, 9.320390860e-01f, 6.247486512e-01f, 3.704313082e-01f, 2.117776696e-01f, 1.197122073e-01f, 6.742975624e-02f, 3.793822522e-02f, 2.133773341e-02f, 1.199971200e-02f, 6.748044688e-03f, 3.794724085e-03f, 2.133933673e-03f,
  4.201670368e-01f, 8.558809906e-01f, -8.245284517e-01f, 7.378162404e-01f, 9.635581854e-01f, 6.676470271e-01f, 3.996143406e-01f, 2.291227120e-01f, 1.296341426e-01f, 7.303927501e-02f, 4.109803135e-02f, 2.311557328e-02f, 1.299963384e-02f, 7.310372113e-03f, 4.110949379e-03f, 2.311761174e-03f,
  9.906073557e-01f, 9.998233431e-01f, -9.596053299e-01f, 6.067785379e-01f, 9.854497300e-01f, 7.084346741e-01f, 4.283977921e-01f, 2.463953013e-01f, 1.395431146e-01f, 7.864648408e-02f, 4.425742651e-02f, 2.489334005e-02f, 1.399954267e-02f, 7.872697226e-03f, 4.427174262e-03f, 2.489588602e-03f,
  6.502878402e-01f, 8.358383233e-01f, -9.995186854e-01f, 4.566033249e-01f, 9.974949866e-01f, 7.469826442e-01f, 4.567528814e-01f, 2.635899757e-01f, 1.494381325e-01f, 8.425120614e-02f, 4.741637909e-02f, 2.667102809e-02f, 1.499943751e-02f, 8.435019850e-03f, 4.743398702e-03f, 2.667415952e-03f,
  -2.879033167e-01f, 4.144303293e-01f, -9.403103332e-01f, 2.920270571e-01f, 9.995736030e-01f, 7.831690702e-01f, 4.846512559e-01f, 2.807012978e-01f, 1.593182066e-01f, 8.985326395e-02f, 5.057485751e-02f, 2.844863180e-02f, 1.599931734e-02f, 8.997339806e-03f, 5.059622668e-03f, 2.845243217e-03f,
  -9.613974919e-01f, -1.346146549e-01f, -7.878519322e-01f, 1.182403929e-01f, 9.916648105e-01f, 8.168795508e-01f, 5.120650195e-01f, 2.977238566e-01f, 1.691823491e-01f, 9.545248036e-02f, 5.373283018e-02f, 3.022614554e-02f, 1.699918118e-02f, 9.559656917e-03f, 5.375846129e-03f, 3.023070392e-03f,
  -7.509872468e-01f, -6.422007782e-01f, -5.572626967e-01f, -5.927551787e-02f, 9.738476309e-01f, 8.480075120e-01f, 5.389667608e-01f, 3.146522694e-01f, 1.790295734e-01f, 1.010486783e-01f, 5.689026552e-02f, 3.200356370e-02f, 1.799902802e-02f, 1.012197101e-02f, 5.692069051e-03f, 3.200897472e-03f,
  1.498772097e-01f, -9.520007631e-01f, -2.714100320e-01f, -2.349219066e-01f, 9.463000877e-01f, 8.764545447e-01f, 5.653295802e-01f, 3.314811830e-01f, 1.888588950e-01f, 1.066416808e-01f, 6.004713196e-02f, 3.378088066e-02f, 1.899885685e-02f, 1.068428189e-02f, 6.008291404e-03f, 3.378724451e-03f,
  9.129452507e-01f, -9.686018589e-01f, 4.135821352e-02f, -4.031589686e-01f, 9.092974268e-01f, 9.021307150e-01f, 5.911271172e-01f, 3.482052759e-01f, 1.986693308e-01f, 1.122313110e-01f, 6.320339793e-02f, 3.555809079e-02f, 1.999866669e-02f, 1.124658940e-02f, 6.324513157e-03f, 3.556551322e-03f,
  8.366556385e-01f, -6.868912307e-01f, 3.500249882e-01f, -5.586805857e-01f, 8.632093666e-01f, 9.249548492e-01f, 6.163335763e-01f, 3.648192595e-01f, 2.084598998e-01f, 1.178173922e-01f, 6.635903187e-02f, 3.733518848e-02f, 2.099845653e-02f, 1.180889335e-02f, 6.640734277e-03f, 3.734378081e-03f,
  -8.851309290e-03f, -1.936306189e-01f, 6.239799809e-01f, -6.965816792e-01f, 8.084964038e-01f, 9.448547900e-01f, 6.409237532e-01f, 3.813178801e-01f, 2.182296231e-01f, 1.233997476e-01f, 6.951400222e-02f, 3.911216810e-02f, 2.199822538e-02f, 1.237119357e-02f, 6.956954733e-03f, 3.912204722e-03f,
  -8.462204042e-01f, 3.592646954e-01f, 8.360552287e-01f, -8.125129131e-01f, 7.457052122e-01f, 9.617676250e-01f, 6.648730598e-01f, 3.976959206e-01f, 2.279775235e-01f, 1.289782009e-01f, 7.266827742e-02f, 4.088902404e-02f, 2.299797222e-02f, 1.293348988e-02f, 7.273174493e-03f, 4.090031240e-03f,
  -9.055783620e-01f, 8.015130295e-01f, 9.652193481e-01f, -9.028178708e-01f, 6.754631806e-01f, 9.756398851e-01f, 6.881575487e-01f, 4.139482019e-01f, 2.377026264e-01f, 1.345525755e-01f, 7.582182595e-02f, 4.266575068e-02f, 2.399769607e-02f, 1.349578209e-02f, 7.589393526e-03f, 4.267857628e-03f,
  -1.323517501e-01f, 9.969099546e-01f, 9.986632058e-01f, -9.646483762e-01f, 5.984721441e-01f, 9.864277139e-01f, 7.107539373e-01f, 4.300695848e-01f, 2.474039593e-01f, 1.401226951e-01f, 7.897461625e-02f, 4.444234239e-02f, 2.499739591e-02f, 1.405807004e-02f, 7.905611800e-03f, 4.445683881e-03f,
  7.625584505e-01f, 8.852767779e-01f, 9.330701931e-01f, -9.960543242e-01f, 5.155013718e-01f, 9.940970063e-01f, 7.326396313e-01f, 4.460549713e-01f, 2.570805519e-01f, 1.456883837e-01f, 8.212661682e-02f, 4.621879357e-02f, 2.599707077e-02f, 1.462035354e-02f, 8.221829283e-03f, 4.623509993e-03f,
  9.563759284e-01f, 5.009944839e-01f, 7.749451323e-01f, -9.960451859e-01f, 4.273798802e-01f, 9.986235163e-01f, 7.537927467e-01f, 4.618993065e-01f, 2.667314367e-01f, 1.512494653e-01f, 8.527779611e-02f, 4.799509859e-02f, 2.699671962e-02f, 1.518263242e-02f, 8.538045944e-03f, 4.801335960e-03f,
  2.709057883e-01f, -3.758498280e-02f, 5.399691971e-01f, -9.646212496e-01f, 3.349881502e-01f, 9.999929335e-01f, 7.741921322e-01f, 4.775975802e-01f, 2.763556486e-01f, 1.568057639e-01f, 8.842812263e-02f, 4.977125184e-02f, 2.799634148e-02f, 1.574490650e-02f, 8.854261752e-03f, 4.979161774e-03f,
  -6.636338842e-01f, -5.645889596e-01f, 2.514448194e-01f, -9.027736113e-01f, 2.392493292e-01f, 9.982009287e-01f, 7.938173900e-01f, 4.931448283e-01f, 2.859522251e-01f, 1.623571039e-01f, 9.157756487e-02f, 5.154724769e-02f, 2.899593534e-02f, 1.630717560e-02f, 9.170476674e-03f, 5.156987431e-03f,
  -9.880316241e-01f, -9.177098239e-01f, -6.201520023e-02f, -8.124529167e-01f, 1.411200081e-01f, 9.932531671e-01f, 8.126488966e-01f, 5.085361344e-01f, 2.955202067e-01f, 1.679033098e-01f, 9.472609133e-02f, 5.332308054e-02f, 2.999550020e-02f, 1.686943954e-02f, 9.486690679e-03f, 5.334812925e-03f,
  -4.040376453e-01f, -9.881927837e-01f, -3.693252072e-01f, -6.965078381e-01f, 4.158066243e-02f, 9.851652909e-01f, 8.306678221e-01f, 5.237666315e-01f, 3.050586364e-01f, 1.734442061e-01f, 9.787367054e-02f, 5.509874477e-02f, 3.099503507e-02f, 1.743169815e-02f, 9.802903735e-03f, 5.512638250e-03f,
  5.514266812e-01f, -7.543303715e-01f, -6.400094403e-01f, -5.585952289e-01f, -5.837414343e-02f, 9.739628693e-01f, 8.478561489e-01f, 5.388315034e-01f, 3.145665606e-01f, 1.789796176e-01f, 1.010202710e-01f, 5.687423476e-02f, 3.199453895e-02f, 1.799395124e-02f, 1.011911581e-02f, 5.690463401e-03f,
  9.999118601e-01f, -2.881479492e-01f, -8.472242960e-01f, -4.030647882e-01f, -1.577456941e-01f, 9.596813183e-01f, 8.641966902e-01f, 5.537259863e-01f, 3.240430284e-01f, 1.845093693e-01f, 1.041658613e-01f, 5.864954490e-02f, 3.299401083e-02f, 1.855619865e-02f, 1.043532687e-02f, 5.868288372e-03f,
  5.290826861e-01f, 2.667787912e-01f, -9.704203931e-01f, -2.348218730e-01f, -2.555411020e-01f, 9.423657881e-01f, 8.796731069e-01f, 5.684453703e-01f, 3.334870921e-01f, 1.900332863e-01f, 1.073104099e-01f, 6.042466957e-02f, 3.399344971e-02f, 1.911844019e-02f, 1.075153690e-02f, 6.046113157e-03f,
  -4.281826695e-01f, 7.395425248e-01f, -9.973804438e-01f, -5.917278607e-02f, -3.507832277e-01f, 9.220710209e-01f, 8.942699237e-01f, 5.829850008e-01f, 3.428978075e-01f, 1.955511940e-01f, 1.104538854e-01f, 6.219960316e-02f, 3.499285460e-02f, 1.968067568e-02f, 1.106774584e-02f, 6.223937751e-03f,
  -9.917788534e-01f, 9.845406356e-01f, -9.254308349e-01f, 1.183425828e-01f, -4.425204433e-01f, 8.988611774e-01f, 9.079725452e-01f, 5.973402802e-01f, 3.522742333e-01f, 2.010629178e-01f, 1.135962563e-01f, 6.397434006e-02f, 3.599222450e-02f, 2.024290495e-02f, 1.138395368e-02f, 6.401762149e-03f,
  -6.435381334e-01f, 9.263181696e-01f, -7.617067688e-01f, 2.921254821e-01f, -5.298361409e-01f, 8.728096342e-01f, 9.207672697e-01f, 6.115066689e-01f, 3.616154320e-01f, 2.065682834e-01f, 1.167374914e-01f, 6.574887465e-02f, 3.699155841e-02f, 2.080512781e-02f, 1.170016038e-02f, 6.579586343e-03f,
  2.963685787e-01f, 5.828065854e-01f, -5.224446694e-01f, 4.566948806e-01f, -6.118578909e-01f, 8.439987519e-01f, 9.326413038e-01f, 6.254796874e-01f, 3.709204694e-01f, 2.120671168e-01f, 1.198775590e-01f, 6.752320133e-02f, 3.799085533e-02f, 2.136734410e-02f, 1.201636591e-02f, 6.757410330e-03f,
  9.637953863e-01f, 5.980119189e-02f, -2.313720250e-01f, 6.068603368e-01f, -6.877661592e-01f, 8.125196145e-01f, 9.435827742e-01f, 6.392549170e-01f, 3.801884151e-01f, 2.175592441e-01f, 1.230164278e-01f, 6.929731449e-02f, 3.899011425e-02f, 2.192955363e-02f, 1.233257024e-02f, 6.935234103e-03f,
  7.451131605e-01f, -4.816218791e-01f, 8.264565347e-02f, 7.378857026e-01f, -7.568024953e-01f, 7.784717415e-01f, 9.535807405e-01f, 6.528280017e-01f, 3.894183423e-01f, 2.230444916e-01f, 1.261540665e-01f, 7.107120850e-02f, 3.998933419e-02f, 2.249175622e-02f, 1.264877333e-02f, 7.113057657e-03f,
  -1.586226688e-01f, -8.747141867e-01f, 3.884674088e-01f, 8.456384993e-01f, -8.182771111e-01f, 7.419627733e-01f, 9.626252055e-01f, 6.661946496e-01f, 3.986093280e-01f, 2.285226858e-01f, 1.292904437e-01f, 7.284487777e-02f, 4.098851413e-02f, 2.305395171e-02f, 1.296497516e-02f, 7.290880986e-03f,
  -9.165215479e-01f, -9.984104626e-01f, 6.557650689e-01f, 9.267202543e-01f, -8.715757724e-01f, 7.031081310e-01f, 9.707071255e-01f, 6.793506338e-01f, 4.077604531e-01f, 2.339936535e-01f, 1.324255279e-01f, 7.461831668e-02f, 4.198765309e-02f, 2.361613990e-02f, 1.328117570e-02f, 7.468704084e-03f,
  -8.317747426e-01f, -8.146145076e-01f, 8.580308748e-01f, 9.785736871e-01f, -9.161659367e-01f, 6.620306515e-01f, 9.778184193e-01f, 6.922917941e-01f, 4.168708024e-01f, 2.394572216e-01f, 1.355592879e-01f, 7.639151963e-02f, 4.298675006e-02f, 2.417832062e-02f, 1.359737490e-02f, 7.646526947e-03f,
  1.770192511e-02f, -3.799321270e-01f, 9.752062397e-01f, 9.995633646e-01f, -9.516020739e-01f, 6.188601989e-01f, 9.839519762e-01f, 7.050140383e-01f, 4.259394651e-01f, 2.449132175e-01f, 1.386916923e-01f, 7.816448100e-02f, 4.398580404e-02f, 2.474049370e-02f, 1.391357275e-02f, 7.824349567e-03f,
  8.509035245e-01f, 1.717624261e-01f, 9.956709484e-01f, 9.890272824e-01f, -9.775301177e-01f, 5.737332542e-01f, 9.891016630e-01f, 7.175133434e-01f, 4.349655341e-01f, 2.503614686e-01f, 1.418227098e-01f, 7.993719520e-02f, 4.498481404e-02f, 2.530265896e-02f, 1.422976920e-02f, 8.002171940e-03f,
  9.017883476e-01f, 6.705572816e-01f, 9.173955273e-01f, 9.472977435e-01f, -9.936910036e-01f, 5.267924836e-01f, 9.932623307e-01f, 7.297857568e-01f, 4.439481070e-01f, 2.558018026e-01f, 1.449523091e-01f, 8.170965662e-02f, 4.598377905e-02f, 2.586481621e-02f, 1.454596424e-02f, 8.179994060e-03f,
  1.235731227e-01f, 9.628327123e-01f, 7.481425059e-01f, 8.756908780e-01f, -9.999232576e-01f, 4.781862879e-01f, 9.964298187e-01f, 7.418273977e-01f, 4.528862854e-01f, 2.612340474e-01f, 1.480804588e-01f, 8.348185965e-02f, 4.698269808e-02f, 2.642696529e-02f, 1.486215781e-02f, 8.357815921e-03f,
  -7.682546613e-01f, 9.585732110e-01f, 5.046966116e-01f, 7.764651328e-01f, -9.961646088e-01f, 4.280683329e-01f, 9.986009600e-01f, 7.536344584e-01f, 4.617791755e-01f, 2.666580314e-01f, 1.512071278e-01f, 8.525379868e-02f, 4.798157012e-02f, 2.698910600e-02f, 1.517834990e-02f, 8.535637518e-03f,
  -9.537526528e-01f, 6.590906264e-01f, 2.112002371e-01f, 6.527500415e-01f, -9.824526126e-01f, 3.765970636e-01f, 9.997735835e-01f, 7.652032053e-01f, 4.706258882e-01f, 2.720735828e-01f, 1.543322846e-01f, 8.702546812e-02f, 4.898039419e-02f, 2.755123819e-02f, 1.549454048e-02f, 8.713458845e-03f,
  -2.623748537e-01f, 1.566201379e-01f, -1.032407464e-01f, 5.084475199e-01f, -9.589242747e-01f, 3.239352036e-01f, 9.999465168e-01f, 7.765299800e-01f, 4.794255386e-01f, 2.774805306e-01f, 1.574558982e-01f, 8.879686236e-02f, 4.997916927e-02f, 2.811336166e-02f, 1.581072950e-02f, 8.891279896e-03f,
  6.702291758e-01f, -3.940864994e-01f, -4.074434030e-01f, 3.481088020e-01f, -9.258146823e-01f, 2.702492405e-01f, 9.991195869e-01f, 7.876112009e-01f, 4.881772469e-01f, 2.828787037e-01f, 1.605779372e-01f, 9.056797580e-02f, 5.097789438e-02f, 2.867547624e-02f, 1.612691694e-02f, 9.069100666e-03f,
  9.866275920e-01f, -8.234216753e-01f, -6.712401257e-01f, 1.767908958e-01f, -8.834546557e-01f, 2.157088994e-01f, 9.972936206e-01f, 7.984433638e-01f, 4.968801378e-01f, 2.882679314e-01f, 1.636983704e-01f, 9.233880284e-02f, 5.197656850e-02f, 2.923758175e-02f, 1.644310277e-02f, 9.246921150e-03f,
  3.959251502e-01f, -9.991579785e-01f, -8.684703414e-01f, -1.029124367e-04f, -8.322674422e-01f, 1.604866066e-01f, 9.944704438e-01f, 8.090230434e-01f, 5.055333412e-01f, 2.936480433e-01f, 1.668171666e-01f, 9.410933788e-02f, 5.297519065e-02f, 2.979967802e-02f, 1.675928696e-02f, 9.424741341e-03f,
  -5.587890489e-01f, -8.671718295e-01f, -9.795748401e-01f, -1.769934748e-01f, -7.727644876e-01f, 1.047569444e-01f, 9.906528795e-01f, 8.193468942e-01f, 5.141359917e-01f, 2.990188692e-01f, 1.699342947e-01f, 9.587957531e-02f, 5.397375983e-02f, 3.036176486e-02f, 1.707546947e-02f, 9.602561234e-03f,
  -9.997551734e-01f, -4.681125574e-01f, -9.935354510e-01f, -3.483017460e-01f, -7.055403256e-01f, 4.869609889e-02f, 9.858447448e-01f, 8.294116515e-01f, 5.226872289e-01f, 3.043802394e-01f, 1.730497234e-01f, 9.764950955e-02f, 5.497227503e-02f, 3.092384210e-02f, 1.739165027e-02f, 9.780380823e-03f,
  -5.215510021e-01f, 7.511685313e-02f, -9.089677080e-01f, -5.086247435e-01f, -6.312666379e-01f, -7.518696635e-03f, 9.800508475e-01f, 8.392141328e-01f, 5.311861979e-01f, 3.097319842e-01f, 1.761634216e-01f, 9.941913500e-02f, 5.597073526e-02f, 3.148590956e-02f, 1.770782933e-02f, 9.958200103e-03f,
  4.361647552e-01f, 5.952116415e-01f, -7.342581470e-01f, -6.529059551e-01f, -5.506855426e-01f, -6.370972221e-02f, 9.732769811e-01f, 8.487512383e-01f, 5.396320487e-01f, 3.150739345e-01f, 1.792753582e-01f, 1.011884461e-01f, 5.696913951e-02f, 3.204796707e-02f, 1.802400663e-02f, 1.013601907e-02f,
  9.928726481e-01f, 9.319920894e-01f, -4.867326171e-01f, -7.765948190e-01f, -4.646021794e-01f, -1.196993330e-01f, 9.655299188e-01f, 8.580199521e-01f, 5.480239368e-01f, 3.204059213e-01f, 1.823855020e-01f, 1.029574371e-01f, 5.796748680e-02f, 3.261001444e-02f, 1.834018212e-02f, 1.031383771e-02f,
  6.367380071e-01f, 9.817359552e-01f, -1.909380864e-01f, -8.757902465e-01f, -3.738766648e-01f, -1.753105211e-01f, 9.568174070e-01f, 8.670173434e-01f, 5.563610229e-01f, 3.257277760e-01f, 1.854938220e-01f, 1.047261026e-01f, 5.896577612e-02f, 3.317205150e-02f, 1.865635577e-02f, 1.049165603e-02f,
  -3.048106211e-01f, 7.291230346e-01f, 1.237916674e-01f, -9.473636604e-01f, -2.794154982e-01f, -2.303674747e-01f, 9.471481575e-01f, 8.757405669e-01f, 5.646424734e-01f, 3.310393303e-01f, 1.886002871e-01f, 1.064944369e-01f, 5.996400648e-02f, 3.373407807e-02f, 1.897252756e-02f, 1.066947402e-02f,
  -9.661177700e-01f, 2.519535043e-01f, 4.262450708e-01f, -9.890576686e-01f, -1.821625043e-01f, -2.846961343e-01f, 9.365318388e-01f, 8.841868642e-01f, 5.728674601e-01f, 3.363404163e-01f, 1.917048661e-01f, 1.082624345e-01f, 6.096217687e-02f, 3.429609397e-02f, 1.928869745e-02f, 1.084729167e-02f,
  -7.391806966e-01f, -3.028131145e-01f, 6.864279895e-01f, -9.995572618e-01f, -8.308940282e-02f, -3.381247429e-01f, 9.249790663e-01f, 8.923535645e-01f, 5.810351605e-01f, 3.416308663e-01f, 1.948075281e-01f, 1.100300897e-01f, 6.196028630e-02f, 3.485809903e-02f, 1.960486542e-02f, 1.102510897e-02f,
  1.673557003e-01f, -7.643188115e-01f, 8.785382293e-01f, -9.785312876e-01f, 1.681390048e-02f, -3.904843889e-01f, 9.125013918e-01f, 9.002380852e-01f, 5.891447579e-01f, 3.469105129e-01f, 1.979082420e-01f, 1.117973969e-01f, 6.295833377e-02f, 3.542009306e-02f, 1.992103142e-02f, 1.120292593e-02f,
};

namespace pg8 {
#define PG8_LAS __attribute__((address_space(3)))
typedef unsigned short bf16_t;
typedef short bf16x8 __attribute__((ext_vector_type(8)));
typedef float f32x4 __attribute__((ext_vector_type(4)));
typedef unsigned u32x4 __attribute__((ext_vector_type(4)));
constexpr int BM = 256, BK = 64, HALF = 128, HTB = HALF * BK * 2  , STAGE_BYTES = 8 * HTB, NXCD = 8, WGM = 8;

__host__ __device__ __forceinline__ int lds_byte(int r, int c) { const int st = (r >> 4) * 2 + (c >> 5), rr = r & 15, cc = c & 31, ob = rr * 64 + cc * 2; return st * 1024 + (ob ^ (((ob >> 9) & 1) << 5)); }
__host__ __device__ __forceinline__ void stage_rc(int b, int& R, int& C) { const int st = b / 1024, sb = b % 1024, swz = sb ^ (((sb >> 9) & 1) << 5); R = (st >> 1) * 16 + swz / 64; C = (st & 1) * 32 + (swz % 64) / 2; }
__host__ __device__ __forceinline__ int perm32(int rho) { const int n = rho >> 4, i = rho & 15; return 8 * (i >> 2) + 4 * n + (i & 3); }

struct Unit { int pm, pn; };
struct Gemm { const bf16_t* A; const bf16_t* Bt; int M, N, K; };

struct StaticOrder {
    int nM, nN, nwg, G, c;
    __host__ __device__ void init(int M, int N, int G_, int c_) { nM = M / BM; nN = N / BM; nwg = nM * nN; G = G_; c = c_; }
    __host__ __device__ bool next(int i, Unit& u) const {
        const long L = (long)i * G + c; if (L >= nwg) return false;
        int wgid = (int)L; { const int q = nwg / NXCD, r = nwg % NXCD, xcd = wgid % NXCD, off = wgid / NXCD; wgid = (xcd < r ? xcd * (q + 1) : r * (q + 1) + (xcd - r) * q) + off; }
        const int nig = WGM * nN, gid = wgid / nig, fm = gid * WGM, gsz = (nM - fm) < WGM ? (nM - fm) : WGM;
        u.pm = fm + ((wgid % nig) % gsz); u.pn = (wgid % nig) / gsz; return true;
    }
    __device__ __forceinline__ void a_ready(const Unit&) const {}
    __device__ __forceinline__ void done(const Unit&) const {}
};

__device__ __forceinline__ unsigned cvt_pk_bf16(float lo, float hi) { unsigned r; asm volatile("v_cvt_pk_bf16_f32 %0, %1, %2" : "=v"(r) : "v"(lo), "v"(hi)); return r; }
typedef float f32x2 __attribute__((ext_vector_type(2)));

__device__ __forceinline__ int opaque_tid() { int t = threadIdx.x; asm volatile("" : "+v"(t)); return t; }
#define EPI_FENCE() asm volatile("" ::: "memory")
constexpr int MOD_STRIDE = 9 * 1024;
__device__ __forceinline__ int cond_of_panel(int pm) { return pm < 16 ? 8 : ((pm - 16) >> 3); }
__device__ __forceinline__ f32x2 silu_mul_pk(f32x2 g, f32x2 u) {
    const f32x2 t = g * (-1.4426950408889634f);
    f32x2 e; e.x = __builtin_amdgcn_exp2f(t.x); e.y = __builtin_amdgcn_exp2f(t.y);
    const f32x2 d = e + 1.0f;
    f32x2 r; r.x = __builtin_amdgcn_rcpf(d.x); r.y = __builtin_amdgcn_rcpf(d.y);
    return (g * u) * r;
}
__device__ __forceinline__ float fast_silu(float g) { return g * __builtin_amdgcn_rcpf(1.0f + __builtin_amdgcn_exp2f(-1.4426950408889634f * g)); }

struct EpiSwiGLU {
    static constexpr bool PERM = true, AFTER_DRAIN = false;
    bf16_t* H; int ldh;
    __device__ __forceinline__ void operator()(const f32x4 (&acc)[2][2][4][2], const Unit& u, int wr, int wc, int fr, int fq) const {
        const int row0 = u.pm * BM + wr * 64 + fr, col0 = u.pn * HALF + wc * 32 + 8 * fq;
#pragma unroll
        for (int ai = 0; ai < 2; ++ai)
#pragma unroll
            for (int m = 0; m < 4; ++m) {
                bf16_t* rowp = H + (size_t)(row0 + ai * HALF + m * 16) * ldh + col0;
                const f32x4 g0 = acc[ai][0][m][0], g1 = acc[ai][0][m][1], u0 = acc[ai][1][m][0], u1 = acc[ai][1][m][1];
                const f32x2 h0 = silu_mul_pk((f32x2){g0[0], g0[1]}, (f32x2){u0[0], u0[1]}), h1 = silu_mul_pk((f32x2){g0[2], g0[3]}, (f32x2){u0[2], u0[3]});
                const f32x2 h2 = silu_mul_pk((f32x2){g1[0], g1[1]}, (f32x2){u1[0], u1[1]}), h3 = silu_mul_pk((f32x2){g1[2], g1[3]}, (f32x2){u1[2], u1[3]});
                u32x4 w;
                w.x = cvt_pk_bf16(h0.x, h0.y); w.y = cvt_pk_bf16(h1.x, h1.y); w.z = cvt_pk_bf16(h2.x, h2.y); w.w = cvt_pk_bf16(h3.x, h3.y);
                *(u32x4*)rowp = w;
            }
    }
};

__device__ __forceinline__ float bflo(unsigned w) { return __builtin_bit_cast(float, w << 16); }
__device__ __forceinline__ float bfhi(unsigned w) { return __builtin_bit_cast(float, w & 0xffff0000u); }
struct EpiResid {
    static constexpr bool PERM = true, AFTER_DRAIN = false;
    const float* xinP; const float* xinS; float* out; const float* gate; int half_gate;
    int defer; bf16_t* dout;
    int npend; const bf16_t* pd0; const bf16_t* pd1;
    __device__ __forceinline__ void operator()(const f32x4 (&acc)[2][2][4][2], const Unit& u, int wr, int wc, int fr, int fq) const {
        const float gs = half_gate ? 0.5f : 1.0f;
        const int cl = u.pn * BM + wc * 32 + 8 * fq;
        const float* gp = gate + (size_t)cond_of_panel(u.pm) * MOD_STRIDE + cl;
        f32x4 gv[2][2];
#pragma unroll
        for (int bj = 0; bj < 2; ++bj)
#pragma unroll
            for (int n = 0; n < 2; ++n) gv[bj][n] = *(const f32x4*)(gp + bj * HALF + 4 * n) * gs;
        const size_t r0 = (size_t)(u.pm * BM + wr * 64 + fr) * 1024 + cl;
        if (defer) {
#pragma unroll
            for (int ai = 0; ai < 2; ++ai)
#pragma unroll
                for (int m = 0; m < 4; ++m)
#pragma unroll
                    for (int bj = 0; bj < 2; ++bj) { const f32x4 v0 = gv[bj][0] * acc[ai][bj][m][0], v1 = gv[bj][1] * acc[ai][bj][m][1];
                        u32x4 w; w.x = cvt_pk_bf16(v0[0], v0[1]); w.y = cvt_pk_bf16(v0[2], v0[3]); w.z = cvt_pk_bf16(v1[0], v1[1]); w.w = cvt_pk_bf16(v1[2], v1[3]);
                        *(u32x4*)(dout + r0 + (size_t)(ai * HALF + m * 16) * 1024 + bj * HALF) = w; }
        } else {
            const float* xb = (u.pm < 16) ? xinP + r0 : xinS + (r0 - (size_t)4096 * 1024);
#pragma unroll
            for (int ai = 0; ai < 2; ++ai)
#pragma unroll
                for (int mp = 0; mp < 2; ++mp) {
                    EPI_FENCE();
                    f32x4 xv[2][2][2]; u32x4 p0[2][2], p1[2][2];
#pragma unroll
                    for (int mm = 0; mm < 2; ++mm)
#pragma unroll
                        for (int bj = 0; bj < 2; ++bj) { const size_t o = (size_t)(ai * HALF + (2 * mp + mm) * 16) * 1024 + bj * HALF;
                            xv[mm][bj][0] = __builtin_nontemporal_load((const f32x4*)(xb + o)); xv[mm][bj][1] = __builtin_nontemporal_load((const f32x4*)(xb + o + 4));
                            if (npend > 0) p0[mm][bj] = __builtin_nontemporal_load((const u32x4*)(pd0 + r0 + o));
                            if (npend > 1) p1[mm][bj] = __builtin_nontemporal_load((const u32x4*)(pd1 + r0 + o)); }
                    EPI_FENCE();
#pragma unroll
                    for (int mm = 0; mm < 2; ++mm)
#pragma unroll
                        for (int bj = 0; bj < 2; ++bj) { const int m = 2 * mp + mm; const size_t o = (size_t)(ai * HALF + m * 16) * 1024 + bj * HALF;
                            f32x4 a = xv[mm][bj][0] + gv[bj][0] * acc[ai][bj][m][0], b = xv[mm][bj][1] + gv[bj][1] * acc[ai][bj][m][1];
                            if (npend > 0) { const u32x4 w = p0[mm][bj]; a += (f32x4){bflo(w.x), bfhi(w.x), bflo(w.y), bfhi(w.y)}; b += (f32x4){bflo(w.z), bfhi(w.z), bflo(w.w), bfhi(w.w)}; }
                            if (npend > 1) { const u32x4 w = p1[mm][bj]; a += (f32x4){bflo(w.x), bfhi(w.x), bflo(w.y), bfhi(w.y)}; b += (f32x4){bflo(w.z), bfhi(w.z), bflo(w.w), bfhi(w.w)}; }
                            *(f32x4*)(out + r0 + o) = a; *(f32x4*)(out + r0 + o + 4) = b; }
                }
        }
    }
};

typedef unsigned u32x2 __attribute__((ext_vector_type(2)));
__device__ __forceinline__ void store_bf16x4(bf16_t* p, f32x4 v) { u32x2 w; w.x = cvt_pk_bf16(v[0], v[1]); w.y = cvt_pk_bf16(v[2], v[3]); *(u32x2*)p = w; }

__device__ __forceinline__ void plain_tile(const f32x4 (&acc)[2][2][4][2], int pm, int wr, int wc, int fr, int fq, bf16_t* dst, int dpitch, int dcol0, float* fdst, int fpitch, int fcol0) {
    const int row0 = pm * BM + wr * 64 + fr, c0 = wc * 32 + 4 * fq;
#pragma unroll
    for (int ai = 0; ai < 2; ++ai)
#pragma unroll
        for (int m = 0; m < 4; ++m) {
            EPI_FENCE();
            int row = row0 + ai * HALF + m * 16; asm volatile("" : "+v"(row));
#pragma unroll
            for (int bj = 0; bj < 2; ++bj)
#pragma unroll
                for (int n = 0; n < 2; ++n) {
                    const int c = c0 + bj * HALF + n * 16;
                    store_bf16x4(dst + (size_t)row * dpitch + dcol0 + c, acc[ai][bj][m][n]);
                    if (fdst) *(f32x4*)(fdst + (size_t)row * fpitch + fcol0 + c) = acc[ai][bj][m][n];
                }
        }
}
__device__ __forceinline__ void prod_tile(const f32x4 (&acc)[2][2][4][2], int pm, int wr, int wc, int fr, int fq, bf16_t* dst, int dpitch, int dcol0) {
    const int row0 = pm * BM + wr * 64 + fr, c0 = wc * 32 + 4 * fq;
#pragma unroll
    for (int ai = 0; ai < 2; ++ai)
#pragma unroll
        for (int m = 0; m < 4; ++m) {
            const int row = row0 + ai * HALF + m * 16;
#pragma unroll
            for (int n = 0; n < 2; ++n) store_bf16x4(dst + (size_t)row * dpitch + dcol0 + c0 + n * 16, acc[ai][0][m][n] * acc[ai][1][m][n]);
        }
}
__device__ __forceinline__ void head_tile(const f32x4 (&acc)[2][2][4][2], int pm, int wr, int wc, int fr, int fq, const float* gq, bool rope, float outscale,
                                          bf16_t* dst, int dpitch, int dcol, float* fdst, int fpitch, int fcol, const float* rcos, const float* rsin) {
    f32x4 gv[2][2];
#pragma unroll
    for (int bj = 0; bj < 2; ++bj)
#pragma unroll
        for (int n = 0; n < 2; ++n) gv[bj][n] = *(const f32x4*)(gq + 32 * bj + 16 * n + 4 * fq);
    f32x4 cr[2], sr[2];
    const int rbase = pm * BM + wr * 64;
    if (rope) {
#pragma unroll
        for (int ai = 0; ai < 2; ++ai) { const int p = (((rbase + ai * HALF) - 4096) & 2047) >> 6; cr[ai] = *(const f32x4*)(rcos + p * 16 + 4 * fq); sr[ai] = *(const f32x4*)(rsin + p * 16 + 4 * fq); }
    }
#pragma unroll
    for (int m = 0; m < 4; ++m) {
        EPI_FENCE();
        f32x4 cc, sc;
        if (rope) { const int p = 16 * m + fr; cc = *(const f32x4*)(rcos + p * 16 + 4 * fq); sc = *(const f32x4*)(rsin + p * 16 + 4 * fq); }
#pragma unroll
        for (int ai = 0; ai < 2; ++ai) {
            int row = rbase + ai * HALF + m * 16 + fr; asm volatile("" : "+v"(row));
            f32x4 v[2][2]; float ss = 0.f;
#pragma unroll
            for (int bj = 0; bj < 2; ++bj)
#pragma unroll
                for (int n = 0; n < 2; ++n) { v[bj][n] = acc[ai][bj][m][n]; const f32x4 q = v[bj][n] * v[bj][n]; ss += (q[0] + q[1]) + (q[2] + q[3]); }
            ss += __shfl_xor(ss, 16); ss += __shfl_xor(ss, 32);
            const float r = 1.0f / sqrtf(ss * (1.0f / 64.0f) + 1e-6f);
#pragma unroll
            for (int bj = 0; bj < 2; ++bj)
#pragma unroll
                for (int n = 0; n < 2; ++n) v[bj][n] = v[bj][n] * r * gv[bj][n];
            if (fdst) {
#pragma unroll
                for (int bj = 0; bj < 2; ++bj)
#pragma unroll
                    for (int n = 0; n < 2; ++n) *(f32x4*)(fdst + (size_t)row * fpitch + fcol + 32 * bj + 16 * n + 4 * fq) = v[bj][n];
            }
            if (rope) {
                { const f32x4 a = v[0][0], b = v[0][1]; v[0][0] = a * cr[ai] - b * sr[ai]; v[0][1] = b * cr[ai] + a * sr[ai]; }
                { const f32x4 a = v[1][0], b = v[1][1]; v[1][0] = a * cc - b * sc; v[1][1] = b * cc + a * sc; }
            }
#pragma unroll
            for (int bj = 0; bj < 2; ++bj)
#pragma unroll
                for (int n = 0; n < 2; ++n) store_bf16x4(dst + (size_t)row * dpitch + dcol + 32 * bj + 16 * n + 4 * fq, v[bj][n] * outscale);
        }
    }
}
constexpr float QSCALE = 0.125f * 1.4426950408889634f;

constexpr int HBP = 2816;
struct EpiQKVEven {
    static constexpr bool PERM = false, AFTER_DRAIN = false;
    bf16_t* HB;
    float *newk, *newv;
    const float* qkg;
    const float *rcos, *rsin;
    __device__ __forceinline__ void operator()(const f32x4 (&acc)[2][2][4][2], const Unit& u, int wr, int wc, int fr, int fq) const {
        const int pn = u.pn; const bool sample = u.pm >= 16;
        if (pn < 2)      head_tile(acc, u.pm, wr, wc, fr, fq, qkg, sample, QSCALE, HB, HBP, 64 * (4 * pn + wc), nullptr, 0, 0, rcos, rsin);
        else if (pn < 4) head_tile(acc, u.pm, wr, wc, fr, fq, qkg + 64, sample, 1.0f, HB, HBP, 512 + 64 * (4 * (pn - 2) + wc), sample ? nullptr : newk, 512, 64 * (4 * (pn - 2) + wc), rcos, rsin);
        else if (pn < 6) plain_tile(acc, u.pm, wr, wc, fr, fq, HB, HBP, 1024 + 256 * (pn - 4), sample ? nullptr : newv, 512, 256 * (pn - 4));
        else if (pn < 8) plain_tile(acc, u.pm, wr, wc, fr, fq, HB, HBP, 1536 + 256 * (pn - 6), nullptr, 0, 0);
        else             prod_tile(acc, u.pm, wr, wc, fr, fq, HB, HBP, 2048 + 128 * (pn - 8));
    }
};
struct EpiQKVOdd {
    static constexpr bool PERM = false, AFTER_DRAIN = false;
    bf16_t* HB;
    float *newk, *newv;
    const float* qkg; const float *rcos, *rsin;
    __device__ __forceinline__ void operator()(const f32x4 (&acc)[2][2][4][2], const Unit& u, int wr, int wc, int fr, int fq) const {
        const int pn = u.pn; const bool sample = u.pm >= 16;
        if (pn < 4)       head_tile(acc, u.pm, wr, wc, fr, fq, qkg, sample, QSCALE, HB, HBP, 64 * (4 * pn + wc), nullptr, 0, 0, rcos, rsin);
        else if (pn == 4) head_tile(acc, u.pm, wr, wc, fr, fq, qkg + 64, sample, 1.0f, HB, HBP, 1024 + 64 * wc, sample ? nullptr : newk, 256, 64 * wc, rcos, rsin);
        else              plain_tile(acc, u.pm, wr, wc, fr, fq, HB, HBP, 1280, sample ? nullptr : newv, 256, 0);
    }
};

struct GroupOrder {
    int nM, nN, nwg, G, c, pm0, nbig, skip;
    __device__ void init(int pm0_, int nM_, int N, int G_, int c_, int nbig_, int skip_) { pm0 = pm0_; nM = nM_; nN = N / BM; nwg = nM * nN; G = G_; c = c_; nbig = nbig_; skip = skip_; }
    __device__ bool next(int i, Unit& u) const {
        long L;
        if (c < nbig) L = (long)skip * (G - nbig) + (long)i * G + c;
        else if (i < skip) L = (long)i * (G - nbig) + (c - nbig);
        else L = (long)skip * (G - nbig) + (long)(i - skip) * G + c;
        if (L >= nwg) return false;
        int wgid = (int)L; { const int q = nwg / NXCD, r = nwg % NXCD, xcd = wgid % NXCD, off = wgid / NXCD; wgid = (xcd < r ? xcd * (q + 1) : r * (q + 1) + (xcd - r) * q) + off; }
        const int nig = WGM * nN, gid = wgid / nig, fm = gid * WGM, gsz = (nM - fm) < WGM ? (nM - fm) : WGM;
        u.pm = pm0 + fm + ((wgid % nig) % gsz); u.pn = (wgid % nig) / gsz; return true;
    }
    __device__ __forceinline__ void a_ready(const Unit&) const {}
    __device__ __forceinline__ void done(const Unit&) const {}
};

template <class Epi, class Sched, bool ALIGN_EPI = false, bool SP2 = false>
__device__ __forceinline__ void gemm_phase(PG8_LAS unsigned char* lds, const Gemm g, const Sched& S, const Epi& E) {
    const int tid = opaque_tid(), wid = __builtin_amdgcn_readfirstlane(tid >> 6), lane = tid & 63, wr = wid >> 2, wc = wid & 3, fr = lane & 15, fq = lane >> 4;
    const int K = g.K, nt = K / BK;
    unsigned voffA[2], voffB[2];
#pragma unroll
    for (int i = 0; i < 2; ++i) { int R, C; stage_rc(tid * 16 + i * 8192, R, C); const int Rb = Epi::PERM ? ((R & ~31) + perm32(R & 31)) : R;
        voffA[i] = (unsigned)(R * K + C) * 2u; voffB[i] = (unsigned)(Rb * K + C) * 2u; }
    const size_t kstep = (size_t)(BK * 2);
    const size_t hstep = (size_t)HALF * K * 2;
    const size_t tstep = 2 * hstep;
    const unsigned ldsw = (unsigned)wid * 1024u;
    const int aoff = lds_byte(wr * 64 + fr, fq * 8), boff = lds_byte(wc * 32 + fr, fq * 8);
#define PG8_SA(b, h) (((b) * 2 + (h)) * HTB)
#define PG8_SB(b, h) ((4 + (b) * 2 + (h)) * HTB)
#define PG8_STAGE(bufoff, gbase, voff) do { _Pragma("unroll") for (int _i = 0; _i < 2; ++_i) \
        __builtin_amdgcn_global_load_lds((const unsigned*)((const char*)(gbase) + (voff)[_i]), (PG8_LAS unsigned*)(lds + (bufoff) + ldsw + _i * 8192), 16, 0, 0); } while (0)
#define PG8_LDA(dst, b, h) do { _Pragma("unroll") for (int m = 0; m < 4; ++m) _Pragma("unroll") for (int k = 0; k < 2; ++k) dst[m][k] = *(const PG8_LAS bf16x8*)(lds + PG8_SA(b, h) + aoff + m * 2048 + k * 1024); } while (0)
#define PG8_LDB(dst, b, h) do { _Pragma("unroll") for (int n = 0; n < 2; ++n) _Pragma("unroll") for (int k = 0; k < 2; ++k) dst[n][k] = *(const PG8_LAS bf16x8*)(lds + PG8_SB(b, h) + boff + n * 2048 + k * 1024); } while (0)
#define PG8_MMA(ai, bj, At, Bt) do { __builtin_amdgcn_s_setprio(1); _Pragma("unroll") for (int m = 0; m < 4; ++m) _Pragma("unroll") for (int n = 0; n < 2; ++n) _Pragma("unroll") for (int k = 0; k < 2; ++k) \
        acc[ai][bj][m][n] = __builtin_amdgcn_mfma_f32_16x16x32_bf16(Bt[n][k], At[m][k], acc[ai][bj][m][n], 0, 0, 0); __builtin_amdgcn_s_setprio(0); } while (0)
#define PG8_WAIT_V(n) asm volatile("s_waitcnt vmcnt(" #n ")" ::: "memory")
#define PG8_WAIT_L(n) asm volatile("s_waitcnt lgkmcnt(" #n ")" ::: "memory")
#define PG8_BAR __builtin_amdgcn_s_barrier()
#define PG8_SCHED __builtin_amdgcn_sched_barrier(0)
    Unit cur, nxt; int ui = 0;
    if (!S.next(0, cur)) return;
    f32x4 acc[2][2][4][2];
#pragma unroll
    for (int a = 0; a < 2; ++a)
#pragma unroll
        for (int b = 0; b < 2; ++b)
#pragma unroll
            for (int m = 0; m < 4; ++m)
#pragma unroll
                for (int n = 0; n < 2; ++n) acc[a][b][m][n] = (f32x4){0.f, 0.f, 0.f, 0.f};
    bf16x8 At[4][2], B0[2][2], B1[2][2];
    const char* cA = (const char*)g.A + (size_t)cur.pm * tstep; const char* cB = (const char*)g.Bt + (size_t)cur.pn * tstep;
    S.a_ready(cur);
    if constexpr (SP2) {
        PG8_STAGE(PG8_SB(0, 0), cB, voffB); PG8_STAGE(PG8_SB(0, 1), cB + hstep, voffB); PG8_STAGE(PG8_SA(0, 0), cA, voffA); PG8_STAGE(PG8_SA(0, 1), cA + hstep, voffA);
        if (wr == 1) PG8_BAR;
        PG8_WAIT_V(2); PG8_BAR;
        PG8_STAGE(PG8_SB(1, 0), cB + kstep, voffB); PG8_STAGE(PG8_SA(1, 0), cA + kstep, voffA); PG8_STAGE(PG8_SB(1, 1), cB + hstep + kstep, voffB);
        PG8_WAIT_V(6); PG8_BAR;
    } else {
        PG8_STAGE(PG8_SB(0, 0), cB, voffB); PG8_STAGE(PG8_SA(0, 0), cA, voffA); PG8_STAGE(PG8_SB(0, 1), cB + hstep, voffB); PG8_STAGE(PG8_SA(0, 1), cA + hstep, voffA);
        if (wr == 1) PG8_BAR;
        PG8_WAIT_V(4); PG8_BAR;
        PG8_STAGE(PG8_SB(1, 0), cB + kstep, voffB); PG8_STAGE(PG8_SA(1, 0), cA + kstep, voffA); PG8_STAGE(PG8_SB(1, 1), cB + hstep + kstep, voffB);
        PG8_WAIT_V(6); PG8_BAR;
    }
    for (;;) {
        const bool has_next = S.next(ui + 1, nxt);
        const char* nA = has_next ? (const char*)g.A + (size_t)nxt.pm * tstep : cA; const char* nB = has_next ? (const char*)g.Bt + (size_t)nxt.pn * tstep : cB;
        for (int t = 0; t < nt; t += 2) {
            const bool last = (t == nt - 2);
            const char* a1 = cA + (size_t)(t + 1) * kstep;
            const char* a2 = last ? nA : cA + (size_t)(t + 2) * kstep; const char* b2 = last ? nB : cB + (size_t)(t + 2) * kstep;
            const char* a3 = a2 + kstep; const char* b3 = b2 + kstep;
            if (last && has_next) S.a_ready(nxt);
            if constexpr (SP2) {
            PG8_LDB(B0, 0, 0); PG8_LDB(B1, 0, 1); PG8_SCHED; PG8_LDA(At, 0, 0); PG8_STAGE(PG8_SA(1, 1), a1 + hstep, voffA);
            PG8_WAIT_V(8); PG8_WAIT_L(0); PG8_BAR; PG8_MMA(0, 0, At, B0); PG8_MMA(0, 1, At, B1); PG8_BAR; PG8_SCHED;
            PG8_LDA(At, 0, 1); PG8_STAGE(PG8_SB(0, 0), b2, voffB); PG8_STAGE(PG8_SB(0, 1), b2 + hstep, voffB); PG8_STAGE(PG8_SA(0, 0), a2, voffA);
            PG8_WAIT_V(8); PG8_WAIT_L(0); PG8_BAR; PG8_MMA(1, 0, At, B0); PG8_MMA(1, 1, At, B1); PG8_BAR; PG8_SCHED;
            PG8_LDB(B0, 1, 0); PG8_LDB(B1, 1, 1); PG8_SCHED; PG8_LDA(At, 1, 0); PG8_STAGE(PG8_SA(0, 1), a2 + hstep, voffA);
            PG8_WAIT_V(8); PG8_WAIT_L(0); PG8_BAR; PG8_MMA(0, 0, At, B0); PG8_MMA(0, 1, At, B1); PG8_BAR; PG8_SCHED;
            PG8_LDA(At, 1, 1); PG8_STAGE(PG8_SB(1, 0), b3, voffB); PG8_STAGE(PG8_SB(1, 1), b3 + hstep, voffB); PG8_STAGE(PG8_SA(1, 0), a3, voffA);
            PG8_WAIT_V(8); PG8_WAIT_L(0); PG8_BAR; PG8_MMA(1, 0, At, B0); PG8_MMA(1, 1, At, B1); PG8_BAR; PG8_SCHED;
            } else {
            PG8_LDB(B0, 0, 0); PG8_SCHED; PG8_LDA(At, 0, 0); PG8_STAGE(PG8_SA(1, 1), a1 + hstep, voffA);
            PG8_WAIT_L(8); PG8_BAR; PG8_WAIT_L(0); PG8_MMA(0, 0, At, B0); PG8_BAR; PG8_SCHED;
            PG8_LDB(B1, 0, 1); PG8_STAGE(PG8_SB(0, 0), b2, voffB);
            PG8_BAR; PG8_WAIT_L(0); PG8_MMA(0, 1, At, B1); PG8_BAR;
            PG8_LDA(At, 0, 1); PG8_STAGE(PG8_SA(0, 0), a2, voffA);
            PG8_BAR; PG8_WAIT_L(0); PG8_MMA(1, 0, At, B0); PG8_BAR; PG8_SCHED;
            PG8_STAGE(PG8_SB(0, 1), b2 + hstep, voffB);
            PG8_WAIT_V(6); PG8_BAR; PG8_MMA(1, 1, At, B1); PG8_BAR;
            PG8_LDB(B0, 1, 0); PG8_SCHED; PG8_LDA(At, 1, 0); PG8_STAGE(PG8_SA(0, 1), a2 + hstep, voffA);
            PG8_WAIT_L(8); PG8_BAR; PG8_WAIT_L(0); PG8_MMA(0, 0, At, B0); PG8_BAR; PG8_SCHED;
            PG8_LDB(B1, 1, 1); PG8_STAGE(PG8_SB(1, 0), b3, voffB);
            PG8_BAR; PG8_WAIT_L(0); PG8_MMA(0, 1, At, B1); PG8_BAR;
            PG8_LDA(At, 1, 1); PG8_STAGE(PG8_SA(1, 0), a3, voffA);
            PG8_BAR; PG8_WAIT_L(0); PG8_MMA(1, 0, At, B0); PG8_BAR; PG8_SCHED;
            PG8_STAGE(PG8_SB(1, 1), b3 + hstep, voffB);
            PG8_WAIT_V(6); PG8_BAR; PG8_MMA(1, 1, At, B1); PG8_BAR;
            }
        }
        if constexpr (ALIGN_EPI) { if (wr == 0) PG8_BAR; }
        if constexpr (!Epi::AFTER_DRAIN) { E(acc, cur, wr, wc, fr, fq); S.done(cur); }
        if (!has_next) break;
#pragma unroll
        for (int a = 0; a < 2; ++a)
#pragma unroll
            for (int b = 0; b < 2; ++b)
#pragma unroll
                for (int m = 0; m < 4; ++m)
#pragma unroll
                    for (int n = 0; n < 2; ++n) acc[a][b][m][n] = (f32x4){0.f, 0.f, 0.f, 0.f};
        cur = nxt; cA = nA; cB = nB; ++ui;
        if constexpr (ALIGN_EPI) { if (wr == 1) PG8_BAR; }
    }
    PG8_WAIT_V(0);
    if constexpr (!ALIGN_EPI) { if (wr == 0) PG8_BAR; }
    PG8_BAR;
    if constexpr (Epi::AFTER_DRAIN) { E.fused(acc, cur, wr, wc, fr, fq, lds, wid, lane); S.done(cur); }
#undef PG8_SA
#undef PG8_SB
#undef PG8_STAGE
#undef PG8_LDA
#undef PG8_LDB
#undef PG8_MMA
#undef PG8_WAIT_V
#undef PG8_WAIT_L
#undef PG8_BAR
#undef PG8_SCHED
}
}

namespace att {
typedef unsigned short bf16_t;
typedef short bf16x8 __attribute__((ext_vector_type(8)));
typedef short s16x4 __attribute__((ext_vector_type(4)));
typedef short v4i16_t __attribute__((ext_vector_type(4)));
typedef float f32x16 __attribute__((ext_vector_type(16)));
typedef float f32x4 __attribute__((ext_vector_type(4)));
typedef unsigned u32x4 __attribute__((ext_vector_type(4)));
typedef unsigned u32x2 __attribute__((ext_vector_type(2)));
#define ATT_LAS __attribute__((address_space(3)))
__device__ __forceinline__ int crow(int r, int hi) { return (r & 3) + 8 * (r >> 2) + 4 * hi; }
typedef float f32x2_t __attribute__((ext_vector_type(2))); typedef __bf16 bf16x2_t __attribute__((ext_vector_type(2)));
__device__ __forceinline__ unsigned cvtpk(float lo, float hi) { f32x2_t v = {lo, hi}; bf16x2_t b = __builtin_convertvector(v, bf16x2_t); return __builtin_bit_cast(unsigned, b); }
__device__ __forceinline__ s16x4 vtr(const ATT_LAS unsigned char* p) { return __builtin_bit_cast(s16x4, __builtin_amdgcn_ds_read_tr16_b64_v4i16((ATT_LAS v4i16_t*)p)); }
__device__ __forceinline__ float max3f(float a, float b, float c) { float r; asm("v_max3_f32 %0, %1, %2, %3" : "=v"(r) : "v"(a), "v"(b), "v"(c)); return r; }
constexpr float THR = 6.0f;
constexpr float NEG_BIG = -1.0e30f;

struct KvStream {
    const bf16_t *Kc, *Vc, *Kb, *Vb; int ncache, nown, kp, kpc;
};

template <int KW, int DV>
__device__ __forceinline__ float attn_core(ATT_LAS unsigned char* lds, ATT_LAS float* wsf, const bf16_t* Qw, int qpitch, int kslice, const KvStream& S,
                                           bool masked, int qpos, int kpos0, float m_init, float l_init, f32x16 (&o)[DV / 32]) {
    constexpr int KB = 64 * KW * 2, VB = 64 * DV * 2, TB = KB + VB, NKC = KW / 64, NVC = DV / 64;
    const int tid = pg8::opaque_tid(), lane = tid & 63, r32 = lane & 31, hi = lane >> 5;
    static_assert(KW == DV, "K and V tiles share one staging map");
    int skey[NKC], scol[NKC], kdoff[NKC], vdoff[NVC];
#pragma unroll
    for (int q = 0; q < NKC; ++q) { const int L = q * 512 + tid, cw = L >> 8, key = (L & 255) >> 2, c4 = L & 3; skey[q] = key; scol[q] = cw * 32 + c4 * 8; kdoff[q] = cw * 4096 + key * 64 + ((c4 ^ ((key >> 2) & 3)) << 4); vdoff[q] = KB + cw * 4096 + key * 64 + (c4 << 4); }
    int kaoff[4];
#pragma unroll
    for (int d0 = 0; d0 < 4; ++d0) kaoff[d0] = (kslice * 2 + (d0 >> 1)) * 4096 + r32 * 64 + (((((d0 & 1) << 1) | hi) ^ ((r32 >> 2) & 3)) << 4);
    const int vb0 = KB + ((lane >> 4) & 1) * 32 + (lane & 3) * 8 + (4 * hi + ((lane & 15) >> 2)) * 64;
    bf16x8 qr[4];
#pragma unroll
    for (int d0 = 0; d0 < 4; ++d0) qr[d0] = *(const bf16x8*)(Qw + (size_t)r32 * qpitch + d0 * 16 + hi * 8);
#pragma unroll
    for (int d = 0; d < DV / 32; ++d) o[d] = f32x16{};
    const bool nosink = !(m_init > -1.0e37f);
    float mhat = nosink ? 0.0f : m_init, l = l_init;
    f32x16 negm;
#pragma unroll
    for (int r = 0; r < 16; ++r) negm[r] = -mhat;
    const int NT = S.ncache + S.nown;
    u32x4 kreg[NKC], vreg[NVC];
    const int half = __builtin_amdgcn_readfirstlane(tid >> 8);
#define ATT_LOAD(tn) do { const bool cch_ = (tn) < S.ncache; const int pt_ = cch_ ? S.kpc : S.kp; \
        const bf16_t* ks_ = cch_ ? S.Kc + (size_t)(tn) * 64 * pt_ : S.Kb + (size_t)((tn) - S.ncache) * 64 * pt_; \
        const bf16_t* vs_ = cch_ ? S.Vc + (size_t)(tn) * 64 * pt_ : S.Vb + (size_t)((tn) - S.ncache) * 64 * pt_; \
        _Pragma("unroll") for (int q = 0; q < NKC; ++q) { kreg[q] = *(const u32x4*)(ks_ + skey[q] * pt_ + scol[q]); vreg[q] = *(const u32x4*)(vs_ + skey[q] * pt_ + scol[q]); } } while (0)
#define ATT_WRITE(tn) do { ATT_LAS unsigned char* wb_ = lds + ((tn) & 1) * TB; \
        _Pragma("unroll") for (int q = 0; q < NKC; ++q) *(ATT_LAS u32x4*)(wb_ + kdoff[q]) = kreg[q]; \
        _Pragma("unroll") for (int q = 0; q < NVC; ++q) *(ATT_LAS u32x4*)(wb_ + vdoff[q]) = vreg[q]; } while (0)
#define ATT_STAGE(t) do { if ((t) + 1 < NT) { ATT_WRITE((t) + 1); if ((t) + 2 < NT) ATT_LOAD((t) + 2); } } while (0)
    ATT_LOAD(0);
    ATT_WRITE(0);
    if (NT > 1) ATT_LOAD(1);
    __syncthreads();
    if (half == 1) __syncthreads();
    for (int t = 0; t < NT; ++t) {
        ATT_LAS unsigned char* buf = lds + (t & 1) * TB;
        if (half == 1) ATT_STAGE(t);
        f32x16 p0 = negm, p1 = negm;
        {   bf16x8 kf[8];
#pragma unroll
            for (int d0 = 0; d0 < 4; ++d0) { kf[2 * d0] = *(const ATT_LAS bf16x8*)(buf + kaoff[d0]); kf[2 * d0 + 1] = *(const ATT_LAS bf16x8*)(buf + kaoff[d0] + 2048); }
            __builtin_amdgcn_sched_barrier(0);
#pragma unroll
            for (int d0 = 0; d0 < 4; ++d0) {
                p0 = __builtin_amdgcn_mfma_f32_32x32x16_bf16(kf[2 * d0], qr[d0], p0, 0, 0, 0);
                p1 = __builtin_amdgcn_mfma_f32_32x32x16_bf16(kf[2 * d0 + 1], qr[d0], p1, 0, 0, 0);
            }
        }
        asm volatile("s_nop 15\n\ts_nop 7" : "+v"(p0), "+v"(p1));
        if (masked && t >= S.ncache) {
            const int kb = kpos0 + (t - S.ncache) * 64, qlo = qpos - r32;
            if (kb + 63 - qlo > 128 || qlo + 31 - kb > 128) {
#pragma unroll
                for (int r = 0; r < 16; ++r) { const int k0 = kb + crow(r, hi); int dd = qpos - k0; if (dd < 0) dd = -dd; if (dd > 128) p0[r] = NEG_BIG; dd = qpos - (k0 + 32); if (dd < 0) dd = -dd; if (dd > 128) p1[r] = NEG_BIG; }
            }
        }
        float rm;
        {   float ma = max3f(p0[0], p0[1], p1[0]), mb = max3f(p0[2], p0[3], p1[1]); ma = max3f(ma, p1[2], p1[3]);
#pragma unroll
            for (int r = 4; r < 16; r += 4) { ma = max3f(ma, p0[r], p0[r + 1]); mb = max3f(mb, p0[r + 2], p0[r + 3]); ma = max3f(ma, p1[r], p1[r + 1]); mb = max3f(mb, p1[r + 2], p1[r + 3]); }
            rm = max3f(ma, mb, mb);
            auto rr = __builtin_amdgcn_permlane32_swap(__float_as_uint(rm), __float_as_uint(rm), false, false); rm = max3f(__uint_as_float(rr[0]), __uint_as_float(rr[1]), __uint_as_float(rr[1])); }
        if (__any(rm > THR) || (nosink && t == 0)) {
            const float dl = (nosink && t == 0) ? rm : fmaxf(rm, 0.0f);
            const float f = (nosink && t == 0) ? 0.0f : __builtin_amdgcn_exp2f(-dl);
            l *= f; mhat += dl;
#pragma unroll
            for (int r = 0; r < 16; ++r) { p0[r] -= dl; p1[r] -= dl; negm[r] = -mhat; }
            if (hi == 0) wsf[r32] = f;
#pragma unroll
            for (int r = 0; r < 16; ++r) { const float fr_ = wsf[crow(r, hi)];
#pragma unroll
                for (int d = 0; d < DV / 32; ++d) o[d][r] *= fr_; }
        }
        float ls = 0.f;
#pragma unroll
        for (int r = 0; r < 16; ++r) { p0[r] = __builtin_amdgcn_exp2f(p0[r]); p1[r] = __builtin_amdgcn_exp2f(p1[r]); ls += p0[r] + p1[r]; }
        l += ls;
        bf16x8 pa[4];
        { u32x4 w;
          w.x = cvtpk(p0[0], p0[1]); w.y = cvtpk(p0[2], p0[3]); w.z = cvtpk(p0[4], p0[5]); w.w = cvtpk(p0[6], p0[7]); pa[0] = __builtin_bit_cast(bf16x8, w);
          w.x = cvtpk(p0[8], p0[9]); w.y = cvtpk(p0[10], p0[11]); w.z = cvtpk(p0[12], p0[13]); w.w = cvtpk(p0[14], p0[15]); pa[1] = __builtin_bit_cast(bf16x8, w);
          w.x = cvtpk(p1[0], p1[1]); w.y = cvtpk(p1[2], p1[3]); w.z = cvtpk(p1[4], p1[5]); w.w = cvtpk(p1[6], p1[7]); pa[2] = __builtin_bit_cast(bf16x8, w);
          w.x = cvtpk(p1[8], p1[9]); w.y = cvtpk(p1[10], p1[11]); w.z = cvtpk(p1[12], p1[13]); w.w = cvtpk(p1[14], p1[15]); pa[3] = __builtin_bit_cast(bf16x8, w); }
        __syncthreads();
        if (half == 0) ATT_STAGE(t);
#pragma unroll
        for (int g = 0; g < DV / 64; ++g) {
            s16x4 lo[8], hh[8];
#pragma unroll
            for (int i = 0; i < 8; ++i) { const int d = 2 * g + (i >> 2), ks = i & 3; lo[i] = vtr(buf + vb0 + d * 4096 + ks * 1024); hh[i] = vtr(buf + vb0 + d * 4096 + ks * 1024 + 512); }
            __builtin_amdgcn_sched_barrier(0);
#pragma unroll
            for (int i = 0; i < 8; ++i) { const int d = 2 * g + (i >> 2), ks = i & 3;
                const bf16x8 vf = (bf16x8){lo[i][0], lo[i][1], lo[i][2], lo[i][3], hh[i][0], hh[i][1], hh[i][2], hh[i][3]};
                o[d] = __builtin_amdgcn_mfma_f32_32x32x16_bf16(pa[ks], vf, o[d], 0, 0, 0); }
        }
        __syncthreads();
    }
    if (half == 0) __syncthreads();
#undef ATT_LOAD
#undef ATT_WRITE
#undef ATT_STAGE
    { auto rr = __builtin_amdgcn_permlane32_swap(__float_as_uint(l), __float_as_uint(l), false, false); l = __uint_as_float(rr[0]) + __uint_as_float(rr[1]); }
    return l;
}

__device__ __forceinline__ void row_recips(ATT_LAS float* wsf, float l, int r32, int hi, float (&rli)[16]) {
    if (hi == 0) wsf[32 + r32] = l;
#pragma unroll
    for (int r = 0; r < 16; ++r) rli[r] = 1.0f / wsf[32 + crow(r, hi)];
}

constexpr int ODD_KV = 2 * (64 + 64) * 64 * 2;
constexpr int ODD_WSF = ODD_KV, ODD_STG = ODD_WSF + 8 * 256;
__device__ __forceinline__ void odd_unit(ATT_LAS unsigned char* lds, const bf16_t* HB, const bf16_t* CK, const bf16_t* CV, bf16_t* O, const float* sink,
                                         bool sample, int b, int g, int qb) {
    const int tid = pg8::opaque_tid(), lane = tid & 63, r32 = lane & 31, hi = lane >> 5; const int wid = __builtin_amdgcn_readfirstlane(tid >> 6);
    const int head = 4 * g + (wid >> 1);
    const int rowbase = sample ? 4096 + b * 2048 : b * 256;
    const int q0 = qb * 64 + 32 * (wid & 1);
    KvStream S; S.kp = 2816; S.kpc = 256;
    int kpos0 = 0;
    if (sample) { const int ts = qb - 2 < 0 ? 0 : qb - 2, te = qb + 3 > 32 ? 32 : qb + 3; kpos0 = ts * 64;
        S.Kc = CK + (size_t)b * 512 * 256 + g * 64; S.Vc = CV + (size_t)b * 512 * 256 + g * 64; S.ncache = 8;
        S.Kb = HB + (size_t)(rowbase + kpos0) * 2816 + 1024 + g * 64; S.Vb = HB + (size_t)(rowbase + kpos0) * 2816 + 1280 + g * 64; S.nown = te - ts; }
    else { S.Kc = nullptr; S.Vc = nullptr; S.ncache = 0; S.Kb = HB + (size_t)rowbase * 2816 + 1024 + g * 64; S.Vb = HB + (size_t)rowbase * 2816 + 1280 + g * 64; S.nown = 4; }
    ATT_LAS float* wsf = (ATT_LAS float*)(lds + ODD_WSF) + wid * 64;
    f32x16 o[2];
    const float l = attn_core<64, 64>(lds, wsf, HB + (size_t)(rowbase + q0) * 2816 + head * 64, 2816, 0, S, sample, q0 + r32, kpos0, sink[head] * 1.4426950408889634f, hi == 0 ? 1.0f : 0.0f, o);
    float rli[16]; row_recips(wsf, l, r32, hi, rli);
    ATT_LAS bf16_t* stg = (ATT_LAS bf16_t*)(lds + ODD_STG) + wid * 2048;
#pragma unroll
    for (int r = 0; r < 16; ++r) { const int orow = crow(r, hi);
#pragma unroll
        for (int d = 0; d < 2; ++d) { const float v = o[d][r] * rli[r]; stg[orow * 64 + d * 32 + r32] = (bf16_t)(cvtpk(v, v) & 0xffffu); } }
    bf16_t* Ow = O + (size_t)(rowbase + q0) * 1024 + head * 64;
#pragma unroll
    for (int i = 0; i < 4; ++i) { const int row = i * 8 + (lane >> 3), ch = lane & 7; const u32x4 v = *(const ATT_LAS u32x4*)(stg + row * 64 + ch * 8); *(u32x4*)(Ow + (size_t)row * 1024 + ch * 8) = v; }
    __syncthreads();
}

constexpr int EVEN_KV = 2 * (128 + 128) * 64 * 2;
constexpr int EVEN_WSF = 72 * 1024;
constexpr int EVEN_SROW = 136;
__device__ __forceinline__ void even_unit(ATT_LAS unsigned char* lds, const bf16_t* HB, const bf16_t* CK, const bf16_t* CV, bf16_t* O, const float* subln, float lam, float post,
                                          bool sample, int b, int h, int qb) {
    const int tid = pg8::opaque_tid(), lane = tid & 63, r32 = lane & 31, hi = lane >> 5; const int wid = __builtin_amdgcn_readfirstlane(tid >> 6);
    const int mp = wid >> 2, wq = wid & 3;
    const int rowbase = sample ? 4096 + b * 2048 : b * 256;
    const int q0 = qb * 128 + 32 * wq;
    KvStream S; S.kp = 2816; S.kpc = 512;
    if (sample) { S.Kc = CK + (size_t)b * 512 * 512 + h * 128; S.Vc = CV + (size_t)b * 512 * 512 + h * 128; S.ncache = 8; S.nown = 32; }
    else { S.Kc = nullptr; S.Vc = nullptr; S.ncache = 0; S.nown = 4; }
    S.Kb = HB + (size_t)rowbase * 2816 + 512 + h * 128; S.Vb = HB + (size_t)rowbase * 2816 + 1024 + h * 128;
    ATT_LAS float* wsf = (ATT_LAS float*)(lds + EVEN_WSF) + wid * 64;
    f32x16 o[4];
    const float l = attn_core<128, 128>(lds, wsf, HB + (size_t)(rowbase + q0) * 2816 + h * 128 + mp * 64, 2816, mp, S, false, 0, 0, -INFINITY, 0.0f, o);
    float rli[16]; row_recips(wsf, l, r32, hi, rli);
    ATT_LAS float* stage = (ATT_LAS float*)lds;
    __syncthreads();
    if (mp == 1) {
#pragma unroll
        for (int r = 0; r < 16; ++r) { const int row = 32 * wq + crow(r, hi);
#pragma unroll
            for (int d = 0; d < 4; ++d) stage[row * EVEN_SROW + d * 32 + r32] = o[d][r] * rli[r]; }
    }
    __syncthreads();
    if (mp == 0) {
#pragma unroll
        for (int r = 0; r < 16; ++r) { const int row = 32 * wq + crow(r, hi);
#pragma unroll
            for (int d = 0; d < 4; ++d) { ATT_LAS float* p = stage + row * EVEN_SROW + d * 32 + r32; *p = o[d][r] * rli[r] - lam * (*p); } }
        const int row = 32 * wq + (lane >> 1), half = lane & 1;
        const ATT_LAS float* rp = stage + row * EVEN_SROW + half * 4;
        float ss = 0.f;
#pragma unroll
        for (int i = 0; i < 16; ++i) { const f32x4 v = *(const ATT_LAS f32x4*)(rp + i * 8); ss += (v[0] * v[0] + v[1] * v[1]) + (v[2] * v[2] + v[3] * v[3]); }
        ss += __shfl_xor(ss, 1);
        const float rs = post / sqrtf(ss * (1.0f / 128.0f) + 1e-6f);
        bf16_t* Ow = O + (size_t)(rowbase + qb * 128 + row) * 1024 + h * 128 + half * 4;
#pragma unroll
        for (int i = 0; i < 16; ++i) { const f32x4 v = *(const ATT_LAS f32x4*)(rp + i * 8); const f32x4 gsub = *(const f32x4*)(subln + half * 4 + i * 8);
            u32x2 w; w.x = cvtpk(v[0] * rs * gsub[0], v[1] * rs * gsub[1]); w.y = cvtpk(v[2] * rs * gsub[2], v[3] * rs * gsub[3]); *(u32x2*)(Ow + i * 8) = w; }
    }
    __syncthreads();
}
#undef ATT_LAS
}

#define GAS __attribute__((address_space(1)))
#define LAS __attribute__((address_space(3)))
typedef unsigned short bf16;
typedef unsigned v4u __attribute__((ext_vector_type(4)));
typedef float f32x4 __attribute__((ext_vector_type(4)));
typedef short bf16x8 __attribute__((ext_vector_type(8)));
typedef GAS unsigned gu32;
typedef GAS unsigned long long gu64;
#define RLX_AGENT __ATOMIC_RELAXED, __HIP_MEMORY_SCOPE_AGENT
#define LDS_WAIT() asm volatile("s_waitcnt lgkmcnt(0)" ::: "memory")
#define VM_WAIT() asm volatile("s_waitcnt vmcnt(0)" ::: "memory")
__device__ __forceinline__ unsigned long long rt() { return __builtin_amdgcn_s_memrealtime(); }
__device__ __forceinline__ unsigned f2bf(float f) { unsigned u = __builtin_bit_cast(unsigned, f); return (u + 0x7fffu + ((u >> 16) & 1u)) >> 16; }
__device__ __forceinline__ unsigned pk2(float lo, float hi) { return f2bf(lo) | (f2bf(hi) << 16); }

#define XB_TMO      128
#define XB_XCNT(j)  (256  + 64 * (j))
#define XB_XSUB(j)  (1280 + 64 * (j))
#define XB_XGEN(j)  (2304 + 64 * (j))
#define XB_TOP      3328
#define XB_TOPGEN   3392
#define XCD_BAR_WORDS 3456
#define XB_SPIN_CAP (1u << 18)

__device__ __forceinline__ unsigned xb_ld(unsigned* p)              { return __hip_atomic_load(p, __ATOMIC_RELAXED, __HIP_MEMORY_SCOPE_AGENT); }
__device__ __forceinline__ unsigned xb_add(unsigned* p, unsigned v) { return __hip_atomic_fetch_add(p, v, __ATOMIC_RELAXED, __HIP_MEMORY_SCOPE_AGENT); }
__device__ __forceinline__ unsigned xb_xcc_id() { return (unsigned)__builtin_amdgcn_s_getreg((3 << 11) | 20) & 0xFu; }
#define XB_SPIN(cond, bar) do { unsigned _sp = 0; while (cond) { __builtin_amdgcn_s_sleep(1); \
    if ((++_sp & 255u) == 0u) { if (xb_ld(&(bar)[XB_TMO])) break; if (_sp > XB_SPIN_CAP) { atomicAdd(&(bar)[XB_TMO], 1u); break; } } } } while (0)

struct XcdBarrier {
    unsigned* bar; unsigned x;
    volatile LAS unsigned* st;
};

__device__ __forceinline__ XcdBarrier xcd_barrier_post(unsigned* bar, volatile LAS unsigned* st) {
    XcdBarrier b; b.bar = bar; b.x = xb_xcc_id(); b.st = st;
    if (threadIdx.x == 0) (void)xb_add(&bar[XB_XCNT(b.x)], 1u);
    return b;
}
__device__ __forceinline__ void xcd_barrier_complete(unsigned* bar, unsigned x, unsigned& nloc, unsigned& nx) {
    const unsigned G = gridDim.x * gridDim.y * gridDim.z;
    unsigned sum, cnt, mine, sp = 0u;
    for (;;) {
        sum = 0u; cnt = 0u; mine = 0u;
#pragma unroll
        for (unsigned j = 0; j < 16; ++j) { const unsigned c = xb_ld(&bar[XB_XCNT(j)]); sum += c; cnt += (c > 0u) ? 1u : 0u; mine = (j == x) ? c : mine; }
        if (sum == G) break;
        __builtin_amdgcn_s_sleep(1);
        if ((++sp & 255u) == 0u) { if (xb_ld(&bar[XB_TMO])) break; if (sp > XB_SPIN_CAP) { atomicAdd(&bar[XB_TMO], 1u); break; } }
    }
    nloc = mine > 0u ? mine : 1u; nx = cnt > 0u ? cnt : 1u;
}

__device__ __forceinline__ void xcd_barrier(const XcdBarrier& b) {
    asm volatile("s_waitcnt vmcnt(0)" ::: "memory");
    __syncthreads();
    if (threadIdx.x == 0) {
        unsigned* bar = b.bar;
        __builtin_amdgcn_s_waitcnt(0);
        unsigned nloc = b.st[0], nx = b.st[1];
        if (nloc == 0u) { xcd_barrier_complete(bar, b.x, nloc, nx); b.st[0] = nloc; b.st[1] = nx; }
        const unsigned old = xb_add(&bar[XB_XSUB(b.x)], 1u);
        const unsigned gen = old / nloc;
        if (old + 1u == (gen + 1u) * nloc) {
            __builtin_amdgcn_fence(__ATOMIC_RELEASE, "agent");
            asm volatile("s_waitcnt vmcnt(0)" ::: "memory");
            const unsigned og = xb_add(&bar[XB_TOP], 1u);
            const unsigned tg = og / nx;
            if (og + 1u == (tg + 1u) * nx) xb_add(&bar[XB_TOPGEN], 1u);
            else XB_SPIN(xb_ld(&bar[XB_TOPGEN]) == tg, bar);
            __builtin_amdgcn_fence(__ATOMIC_ACQUIRE, "agent");
            xb_add(&bar[XB_XGEN(b.x)], 1u);
            asm volatile("s_waitcnt vmcnt(0)" ::: "memory");
        } else {
            XB_SPIN(xb_ld(&bar[XB_XGEN(b.x)]) == gen, bar);
            __builtin_amdgcn_fence(__ATOMIC_ACQUIRE, "agent");
            asm volatile("s_waitcnt vmcnt(0)" ::: "memory");
        }
    }
    __syncthreads();
}

__device__ __forceinline__ float wave_sum(float v) {
#pragma unroll
    for (int o = 1; o < 64; o <<= 1) v += __shfl_xor(v, o);
    return v;
}

constexpr int NWAVES = 8;
constexpr int DM = 1024, DFF = 2816, NPROMPT = 4096, NSAMPLE = 16384, MT = NPROMPT + NSAMPLE;
constexpr int N_PHASES = 22;
#ifndef MK_PER_PHASE
#define MK_PER_PHASE 0
#endif

constexpr size_t MiB = 1u << 20;
constexpr size_t WS_CTL = 0, CTL_ZERO_BYTES = 64 * 1024;
constexpr size_t WS_MOD = 1 * MiB;
constexpr size_t WS_W13 = 2 * MiB;
constexpr size_t WS_W2 = 46 * MiB;
constexpr size_t WS_EWIN = 68 * MiB, WS_EWOUT = 74 * MiB, WS_OWIN = 76 * MiB, WS_OWOUT = 79 * MiB;
constexpr size_t WS_CEK = 81 * MiB, WS_CEV = 85 * MiB, WS_COK = 89 * MiB, WS_COV = 91 * MiB;
constexpr size_t WS_XN = 96 * MiB;
constexpr size_t WS_OB = WS_XN;
constexpr size_t WS_DA = 136 * MiB, WS_DB = 286 * MiB;
constexpr size_t WS_HB = 176 * MiB;
constexpr size_t WS_END = 326 * MiB;
constexpr size_t QKV_SLAB = (size_t)MT * 512 * 2;
constexpr size_t OUT_YP = 0, OUT_YS = 4194304, OUT_EK = 20971520, OUT_EV = 23068672, OUT_OK = 25165824, OUT_OV = 26214400, OUT_TOTAL = 27262976;
constexpr int CW_BAR = 4096;

constexpr int RING_BYTES = 131072;
constexpr int LDSCTL_OFF = 139264, MISC_OFF = LDSCTL_OFF + 320;
constexpr int LDS_BYTES = 147456;

struct Frame {
    LAS unsigned char* lds;
    int tid, lane, wave, vcu, G;
};

__device__ __forceinline__ void p0_transpose_item(const float* W, int K, int N, bf16* WT, int k0, int n0, int drow_lo, int drow_hi, LAS float* scr, int lane) {
    const int lr = lane >> 4, lc = (lane & 15) * 4;
    const float* src = W + (size_t)(k0 + lr) * N + n0 + lc;
#pragma unroll
    for (int h = 0; h < 2; ++h) {
        f32x4 v[8];
#pragma unroll
        for (int i = 0; i < 8; ++i) v[i] = *(const f32x4*)(src + (size_t)(4 * (8 * h + i)) * N);
#pragma unroll
        for (int i = 0; i < 8; ++i) { LAS float* d = scr + (4 * (8 * h + i) + lr) * 65 + lc; d[0] = v[i][0]; d[1] = v[i][1]; d[2] = v[i][2]; d[3] = v[i][3]; }
    }
    LDS_WAIT(); asm volatile("" ::: "memory");
    const int c = lane & 7;
#pragma unroll
    for (int j = 0; j < 8; ++j) { const int n = (lane >> 3) + 8 * j; const LAS float* s = scr + (8 * c) * 65 + n;
        v4u o; o.x = pk2(s[0 * 65], s[1 * 65]); o.y = pk2(s[2 * 65], s[3 * 65]); o.z = pk2(s[4 * 65], s[5 * 65]); o.w = pk2(s[6 * 65], s[7 * 65]);
        const int dr = (n < 32 ? drow_lo : drow_hi) + (n & 31);
        *(GAS v4u*)(WT + (size_t)dr * K + k0 + 8 * c) = o; }
    LDS_WAIT(); asm volatile("" ::: "memory");
}
__device__ __forceinline__ int drow_swiglu(int n0) { const bool up = n0 >= DFF; const int c = up ? n0 - DFF : n0; return 256 * (c >> 7) + (up ? 128 : 0) + (c & 127); }
__device__ __forceinline__ int drow_heads(int n0) { const int pn = n0 >> 8, x = n0 & 255, wc = x >> 6, bj = (x & 63) >> 5; return 256 * pn + 128 * bj + 32 * wc; }
__device__ __forceinline__ int drow_even_in(int n0) {
    if (n0 < 1024) return drow_heads(n0);
    if (n0 < 2048) return n0;
    if (n0 < 2560) { const int c = n0 - 2048; return 2048 + 256 * (c >> 7) + (c & 127); }
    const int c = n0 - 2560; return 2048 + 256 * (c >> 7) + 128 + (c & 127);
}
__device__ __forceinline__ int drow_odd_in(int n0) { return n0 < 1280 ? drow_heads(n0) : n0; }

struct Ptrs {
    const float *x_prompt, *x_sample, *cek, *cev, *cok, *cov, *c, *c_ctx, *w_mod, *b_mod, *norm_g, *w13, *w2, *ewin, *ewout, *eqk, *elam, *esub, *econv, *owin, *owout, *oqk, *osink;
    float* out; unsigned char* ws;
};

__device__ __forceinline__ void cvt_cache(const Frame& F, const float* src, unsigned char* dst, size_t n8) {
    const size_t gt = (size_t)F.vcu * (NWAVES * 64) + F.tid, NGT = (size_t)F.G * NWAVES * 64;
    for (size_t i = gt; i < n8; i += NGT) { const f32x4 v0 = *(const f32x4*)(src + i * 8), v1 = *(const f32x4*)(src + i * 8 + 4);
        v4u o; o.x = pk2(v0[0], v0[1]); o.y = pk2(v0[2], v0[3]); o.z = pk2(v1[0], v1[1]); o.w = pk2(v1[2], v1[3]); *(v4u*)(dst + i * 16) = o; }
}
__device__ __forceinline__ void p0_prologue(const Frame& F0, const Ptrs& P) {
    Frame F = F0; F.tid = pg8::opaque_tid(); F.lane = F.tid & 63;
    {   LAS float* sil = (LAS float*)F.lds;
        LAS float* red = (LAS float*)(F.lds + 40960);
        bool have_sil = false;
        for (int item = blockIdx.x; item < 2 * 144; item += F.G) {
            if (!have_sil) {
                for (int i = F.tid; i < 9 * 1024; i += NWAVES * 64) { const int cnd = i >> 10, k = i & 1023; const float v = cnd < 8 ? P.c[cnd * 1024 + k] : P.c_ctx[k]; sil[i] = v / (1.0f + expf(-v)); }
                __syncthreads(); have_sil = true;
            }
            const int l = item / 144, cb = item % 144;
            const int lg = F.lane >> 4, l16 = F.lane & 15;
            const float* wp = P.w_mod + (size_t)l * 1024 * 9216 + cb * 64 + l16 * 4;
            f32x4 a[9];
#pragma unroll
            for (int cnd = 0; cnd < 9; ++cnd) a[cnd] = (f32x4){0.f, 0.f, 0.f, 0.f};
#pragma unroll 4
            for (int i = 0; i < 32; ++i) { const int k = F.wave * 4 + lg + 32 * i; const f32x4 wv = *(const f32x4*)(wp + (size_t)k * 9216);
#pragma unroll
                for (int cnd = 0; cnd < 9; ++cnd) a[cnd] += wv * sil[cnd * 1024 + k]; }
#pragma unroll
            for (int cnd = 0; cnd < 9; ++cnd)
#pragma unroll
                for (int e = 0; e < 4; ++e) { float v = a[cnd][e]; v += __shfl_xor(v, 16); v += __shfl_xor(v, 32); a[cnd][e] = v; }
            if (lg == 0) {
#pragma unroll
                for (int cnd = 0; cnd < 9; ++cnd) *(LAS f32x4*)(red + (F.wave * 9 + cnd) * 64 + l16 * 4) = a[cnd];
            }
            __syncthreads();
            for (int i = F.tid; i < 9 * 64; i += NWAVES * 64) { const int cnd = i >> 6, col = i & 63; float s = 0.f;
#pragma unroll
                for (int w = 0; w < 8; ++w) s += red[(w * 9 + cnd) * 64 + col];
                ((float*)(P.ws + WS_MOD))[(size_t)(l * 9 + cnd) * 9216 + cb * 64 + col] = s + P.b_mod[l * 9216 + cb * 64 + col]; }
            __syncthreads();
        }
        __syncthreads();
    }
    LAS float* scr = (LAS float*)(F.lds + F.wave * 16640);
    const int gw = F.vcu * NWAVES + F.wave, NGW = F.G * NWAVES;
    constexpr int I_W13 = 16 * 88, I_W2 = 44 * 16, I_EIN = 16 * 48, I_SQ = 16 * 16, I_OIN = 16 * 24;
    constexpr int NITEMS = 4 * I_W13 + 4 * I_W2 + I_EIN + I_SQ + I_OIN + I_SQ;
    for (int it = gw; it < NITEMS; it += NGW) {
        int r = it;
        if (r < 4 * I_W13) { const int mi = r / I_W13, q = r % I_W13, kb = q / 88, nb = q % 88;
            p0_transpose_item(P.w13 + (size_t)mi * 1024 * 5632, 1024, 5632, (bf16*)(P.ws + WS_W13) + (size_t)mi * 5632 * 1024, 64 * kb, 64 * nb, drow_swiglu(64 * nb), drow_swiglu(64 * nb + 32), scr, F.lane); continue; }
        r -= 4 * I_W13;
        if (r < 4 * I_W2) { const int mi = r / I_W2, q = r % I_W2, kb = q / 16, nb = q % 16;
            p0_transpose_item(P.w2 + (size_t)mi * 2816 * 1024, 2816, 1024, (bf16*)(P.ws + WS_W2) + (size_t)mi * 1024 * 2816, 64 * kb, 64 * nb, 64 * nb, 64 * nb + 32, scr, F.lane); continue; }
        r -= 4 * I_W2;
        if (r < I_EIN) { const int kb = r / 48, nb = r % 48; p0_transpose_item(P.ewin, 1024, 3072, (bf16*)(P.ws + WS_EWIN), 64 * kb, 64 * nb, drow_even_in(64 * nb), drow_even_in(64 * nb + 32), scr, F.lane); continue; }
        r -= I_EIN;
        if (r < I_SQ) { const int kb = r / 16, nb = r % 16; p0_transpose_item(P.ewout, 1024, 1024, (bf16*)(P.ws + WS_EWOUT), 64 * kb, 64 * nb, 64 * nb, 64 * nb + 32, scr, F.lane); continue; }
        r -= I_SQ;
        if (r < I_OIN) { const int kb = r / 24, nb = r % 24; p0_transpose_item(P.owin, 1024, 1536, (bf16*)(P.ws + WS_OWIN), 64 * kb, 64 * nb, drow_odd_in(64 * nb), drow_odd_in(64 * nb + 32), scr, F.lane); continue; }
        r -= I_OIN;
        { const int kb = r / 16, nb = r % 16; p0_transpose_item(P.owout, 1024, 1024, (bf16*)(P.ws + WS_OWOUT), 64 * kb, 64 * nb, 64 * nb, 64 * nb + 32, scr, F.lane); }
    }
    cvt_cache(F, P.cek, P.ws + WS_CEK, 2097152 / 8); cvt_cache(F, P.cev, P.ws + WS_CEV, 2097152 / 8);
    cvt_cache(F, P.cok, P.ws + WS_COK, 1048576 / 8); cvt_cache(F, P.cov, P.ws + WS_COV, 1048576 / 8);
}

__device__ __forceinline__ void norm_rows(const Frame& F0, const float* xP, const float* xS, const float* g, const float* mod  , int jshift, bf16* XN, int row0, int row1, int pidx, int pcount, int npend, const bf16* pd0, const bf16* pd1, float* xwb = nullptr) {
    Frame F = F0; F.tid = pg8::opaque_tid(); F.lane = F.tid & 63;
    if (pidx < 0) return;
    const int gw = pidx * NWAVES + F.wave, NGW = pcount * NWAVES;
    const int per = (row1 - row0 + NGW - 1) / NGW;
    int r0 = row0 + gw * per, r1 = r0 + per; if (r1 > row1) r1 = row1;
    int cur_cond = -1; f32x4 gs[4], sh[4];
    f32x4 nv[4]; unsigned long long nd0[4], nd1[4];
#define NORM_LOAD(rw) do { const float* xr_ = (rw) < NPROMPT ? xP + (size_t)(rw) * DM : xS + (size_t)((rw) - NPROMPT) * DM; \
        _Pragma("unroll") for (int j = 0; j < 4; ++j) { nv[j] = *(const f32x4*)(xr_ + 4 * F.lane + 256 * j); \
            if (npend > 0) nd0[j] = *(const unsigned long long*)(pd0 + (size_t)(rw) * DM + 4 * F.lane + 256 * j); \
            if (npend > 1) nd1[j] = *(const unsigned long long*)(pd1 + (size_t)(rw) * DM + 4 * F.lane + 256 * j); } } while (0)
    if (r0 < r1) NORM_LOAD(r0);
    for (int row = r0; row < r1; ++row) {
        const int cond = row < NPROMPT ? 8 : ((row - NPROMPT) >> 11);
        if (cond != cur_cond) { cur_cond = cond; const float* mp = mod + (size_t)cond * 9216;
#pragma unroll
            for (int j = 0; j < 4; ++j) { const int col = 4 * F.lane + 256 * j; const f32x4 gg = *(const f32x4*)(g + col), sc = *(const f32x4*)(mp + (jshift + 1) * 1024 + col); sh[j] = *(const f32x4*)(mp + jshift * 1024 + col); gs[j] = gg * (sc + 1.0f); } }
        f32x4 v[4]; float s = 0.f;
#pragma unroll
        for (int j = 0; j < 4; ++j) { v[j] = nv[j];
            if (npend > 0) { const unsigned lo = (unsigned)nd0[j], hi = (unsigned)(nd0[j] >> 32);
                v[j] += (f32x4){__builtin_bit_cast(float, lo << 16), __builtin_bit_cast(float, lo & 0xffff0000u), __builtin_bit_cast(float, hi << 16), __builtin_bit_cast(float, hi & 0xffff0000u)}; }
            if (npend > 1) { const unsigned lo = (unsigned)nd1[j], hi = (unsigned)(nd1[j] >> 32);
                v[j] += (f32x4){__builtin_bit_cast(float, lo << 16), __builtin_bit_cast(float, lo & 0xffff0000u), __builtin_bit_cast(float, hi << 16), __builtin_bit_cast(float, hi & 0xffff0000u)}; }
            s += (v[j][0] * v[j][0] + v[j][1] * v[j][1]) + (v[j][2] * v[j][2] + v[j][3] * v[j][3]); }
        if (row + 1 < r1) NORM_LOAD(row + 1);
        if (xwb) {
#pragma unroll
            for (int j = 0; j < 4; ++j) *(f32x4*)(xwb + (size_t)row * DM + 4 * F.lane + 256 * j) = v[j]; }
        const float rstd = 1.0f / sqrtf(wave_sum(s) * (1.0f / DM) + 1e-6f);
#pragma unroll
        for (int j = 0; j < 4; ++j) { const f32x4 y = v[j] * rstd * gs[j] + sh[j];
            *(unsigned long long*)(XN + (size_t)row * DM + 4 * F.lane + 256 * j) = (unsigned long long)pk2(y[0], y[1]) | ((unsigned long long)pk2(y[2], y[3]) << 32); }
    }
#undef NORM_LOAD
}

__device__ __forceinline__ float bf2f(unsigned short b) { return __builtin_bit_cast(float, (unsigned)b << 16); }
__device__ __forceinline__ void conv_rows(const Frame& F0, const bf16* HB, const float* cw, bf16* OB, int row0, int row1, int pidx, int pcount) {
    Frame F = F0; F.tid = pg8::opaque_tid(); F.lane = F.tid & 63;
    if (pidx < 0) return;
    const int gw = pidx * NWAVES + F.wave, NGW = pcount * NWAVES;
    const int c0 = 8 * F.lane;
    f32x4 w0[2], w1[2], w2[2];
#pragma unroll
    for (int h = 0; h < 2; ++h) { w0[h] = *(const f32x4*)(cw + c0 + 4 * h); w1[h] = *(const f32x4*)(cw + 512 + c0 + 4 * h); w2[h] = *(const f32x4*)(cw + 1024 + c0 + 4 * h); }
    for (int row = row0 + gw; row < row1; row += NGW) {
        const int t = row < NPROMPT ? (row & 255) : ((row - NPROMPT) & 2047), len = row < NPROMPT ? 256 : 2048;
        const v4u zero = (v4u){0u, 0u, 0u, 0u};
        const bf16* up_ = HB + (size_t)row * 2816 + 2048 + c0;
        const v4u uc = *(const v4u*)up_;
        const v4u up = t > 0 ? *(const v4u*)(up_ - 2816) : zero;
        const v4u un = t < len - 1 ? *(const v4u*)(up_ + 2816) : zero;
        const v4u bg = *(const v4u*)(HB + (size_t)row * 2816 + 1536 + c0);
        float y[8];
#pragma unroll
        for (int e = 0; e < 8; ++e) { const int wi = e >> 1, sft = (e & 1) * 16;
            const float a = bf2f((unsigned short)(up[wi] >> sft)), b = bf2f((unsigned short)(uc[wi] >> sft)), c = bf2f((unsigned short)(un[wi] >> sft)), gte = bf2f((unsigned short)(bg[wi] >> sft));
            y[e] = gte * (w0[e >> 2][e & 3] * a + w1[e >> 2][e & 3] * b + w2[e >> 2][e & 3] * c); }
        v4u o; o.x = pk2(y[0], y[1]); o.y = pk2(y[2], y[3]); o.z = pk2(y[4], y[5]); o.w = pk2(y[6], y[7]);
        *(v4u*)(OB + (size_t)row * DM + 512 + c0) = o;
    }
}

struct Args { const float* in[23]; float* out; unsigned char* ws; int ph_lo, ph_hi; };
__global__ void __launch_bounds__(NWAVES * 64, 2) mega_fwd(Args args) {
    extern __shared__ __attribute__((aligned(16))) unsigned char lds_raw[];
    Frame F;
    F.lds = (LAS unsigned char*)lds_raw;
    volatile LAS unsigned* MISC = (volatile LAS unsigned*)(F.lds + MISC_OFF);
    F.tid = threadIdx.x; F.lane = F.tid & 63; F.wave = __builtin_amdgcn_readfirstlane(F.tid >> 6);
    F.G = gridDim.x; { const int bx = blockIdx.x; F.vcu = (F.G % 8 == 0) ? (bx % 8) * (F.G / 8) + bx / 8 : bx; }
    typedef const __attribute__((address_space(4))) Args* KArgs;
    const KArgs KA0 = (KArgs)__builtin_amdgcn_kernarg_segment_ptr();
    unsigned char* ws = KA0->ws;
    for (int u = F.tid; u < (LDS_BYTES - LDSCTL_OFF) / 4; u += NWAVES * 64) ((LAS unsigned*)(F.lds + LDSCTL_OFF))[u] = 0u;
    __syncthreads();
    XcdBarrier bar; bar.bar = (unsigned*)(ws + WS_CTL) + CW_BAR; bar.x = 0; bar.st = nullptr;
    if (!MK_PER_PHASE) bar = xcd_barrier_post((unsigned*)(ws + WS_CTL) + CW_BAR, MISC + 8);

    const float* MODP = (const float*)(ws + WS_MOD);
    bf16* XN = (bf16*)(ws + WS_XN); bf16* OB = (bf16*)(ws + WS_OB); bf16* HB = (bf16*)(ws + WS_HB);
    float* xout = KA0->out;

    const int ph_lo = KA0->ph_lo, ph_hi = KA0->ph_hi;
    for (int ph = ph_lo; ph < ph_hi; ++ph) {
      if (ph == 0) {
        KArgs ka = KA0; asm volatile("" : "+s"(ka));
        Ptrs P;
        P.x_prompt = ka->in[0]; P.x_sample = ka->in[1]; P.cek = ka->in[2]; P.cev = ka->in[3]; P.cok = ka->in[4]; P.cov = ka->in[5]; P.c = ka->in[6]; P.c_ctx = ka->in[7];
        P.w_mod = ka->in[8]; P.b_mod = ka->in[9]; P.norm_g = ka->in[10]; P.w13 = ka->in[11]; P.w2 = ka->in[12]; P.ewin = ka->in[13]; P.ewout = ka->in[14]; P.eqk = ka->in[15];
        P.elam = ka->in[16]; P.esub = ka->in[17]; P.econv = ka->in[18]; P.owin = ka->in[19]; P.owout = ka->in[20]; P.oqk = ka->in[21]; P.osink = ka->in[22];
        P.out = ka->out; P.ws = ka->ws;
        p0_prologue(F, P);
      } else {
        const int opS = ph - 2, opP = ph - 1;
        const bool validS = opS >= 0 && opS < 20, validP = opP >= 0 && opP < 20;
        const int kS = validS ? opS % 10 : -1, kP = validP ? opP % 10 : -1;
        const bool pfirst = !(kS == 2 || kS == 6 || kS == 9);
        for (int slot = 0; slot < 2; ++slot) {
            const bool isP = (slot == 0) == pfirst;
            if (isP ? !validP : !validS) continue;
            KArgs ka = KA0; asm volatile("" : "+s"(ka));
            Ptrs P;
            P.x_prompt = ka->in[0]; P.x_sample = ka->in[1]; P.cek = ka->in[2]; P.cev = ka->in[3]; P.cok = ka->in[4]; P.cov = ka->in[5]; P.c = ka->in[6]; P.c_ctx = ka->in[7];
            P.w_mod = ka->in[8]; P.b_mod = ka->in[9]; P.norm_g = ka->in[10]; P.w13 = ka->in[11]; P.w2 = ka->in[12]; P.ewin = ka->in[13]; P.ewout = ka->in[14]; P.eqk = ka->in[15];
            P.elam = ka->in[16]; P.esub = ka->in[17]; P.econv = ka->in[18]; P.owin = ka->in[19]; P.owout = ka->in[20]; P.oqk = ka->in[21]; P.osink = ka->in[22];
            P.out = ka->out; P.ws = ka->ws;
            const int op = isP ? opP : opS, l = op / 10, s = op % 10, ko = isP ? kS : kP;
            const int pm0 = isP ? 0 : 16, nM = isP ? 16 : 64, row0 = isP ? 0 : NPROMPT, row1 = isP ? NPROMPT : MT;
            const float* modl = MODP + (size_t)l * 9 * 9216;
            const bool fromin = isP ? (op <= 3) : (op <= 6);
            const float* xP = fromin ? P.x_prompt : xout; const float* xS = fromin ? P.x_sample : xout + (size_t)NPROMPT * DM;
            const bf16* DA = (const bf16*)(ws + WS_DA); const bf16* DB = (const bf16*)(ws + WS_DB);
            int npend = 0; const bf16 *pd0 = DA, *pd1 = DA;
            if (isP) { npend = (op > 0 && (s == 0 || s == 3 || s == 7)) ? 1 : 0; }
            else if (s <= 6) { if (l >= 1) { pd0 = DB; npend = 1; } if (s >= 3) { if (npend) pd1 = DA; else pd0 = DA; ++npend; } }
            if (s == 0 || s == 3 || s == 7) {
                const int sub = s == 0 ? 0 : (s == 3 ? 1 : 2);
                int pidx = F.vcu, pcount = F.G;
                if (!isP && F.G == 256 && (ko == 1 || ko == 8)) { pidx = (int)blockIdx.x - 96; pcount = 160; }
                int ra = row0, rb = row1;
                if (!isP && F.G == 256 && ko == 4) {
                    const int bx = (int)blockIdx.x;
                    if (l == 0) { if (bx < 192) { ra = row0 + bx * 40; rb = ra + 40; } else { ra = row0 + 7680 + (bx - 192) * 136; rb = ra + 136; } pidx = 0; pcount = 1; }
                    else { pidx = bx - 96; pcount = 160; }
                }
                norm_rows(F, xP, xS, P.norm_g + (size_t)(l * 3 + sub) * DM, modl, 3 * sub, XN, ra, rb, pidx, pcount, npend, pd0, pd1, (isP && npend > 0) ? xout : nullptr);
            } else if (s == 1 || s == 8) {
                const int fi = l * 2 + (s == 8 ? 1 : 0);
                pg8::Gemm g{XN, (const bf16*)(ws + WS_W13) + (size_t)fi * 5632 * 1024, MT, 2 * DFF, DM};
                const bool bigother = !isP && (ko == 2 || ko == 9) && F.G == 256;
                pg8::GroupOrder S; S.init(pm0, nM, 2 * DFF, F.G, (int)blockIdx.x, bigother ? 64 : 0, bigother ? 2 : 0);
                pg8::EpiSwiGLU E{HB, DFF};
                pg8::gemm_phase<pg8::EpiSwiGLU, pg8::GroupOrder, true, true>(F.lds, g, S, E);
            } else if (s == 2 || s == 9 || s == 6) {
                pg8::Gemm g; const float* gate; int hg, defer; bf16* dout = (bf16*)(ws + WS_DA);
                if (s == 6) { g = pg8::Gemm{OB, (const bf16*)(ws + (l == 0 ? WS_EWOUT : WS_OWOUT)), MT, DM, DM}; gate = modl + 5 * 1024; hg = 0; defer = 0; }
                else { const int fi = l * 2 + (s == 9 ? 1 : 0); g = pg8::Gemm{HB, (const bf16*)(ws + WS_W2) + (size_t)fi * 1024 * 2816, MT, DM, DFF}; gate = modl + (s == 2 ? 2 : 8) * 1024; hg = 1;
                       defer = (s == 2 || l == 0) ? 1 : 0; if (s == 9) dout = (bf16*)(ws + WS_DB); }
                pg8::GroupOrder S; S.init(pm0, nM, DM, F.G, (int)blockIdx.x, 0, 0);
                if (isP) { defer = (op == 19) ? 0 : 1; dout = (bf16*)(ws + WS_DA); npend = 0; }
                pg8::EpiResid E{xP, xS, xout, gate, hg, defer, dout, defer ? 0 : npend, pd0, pd1};
                pg8::gemm_phase<pg8::EpiResid, pg8::GroupOrder, true, true>(F.lds, g, S, E);
            } else if (s == 4) {
                if (l == 0) {
                    pg8::Gemm g{XN, (const bf16*)(ws + WS_EWIN), MT, 3072, DM};
                    pg8::GroupOrder S; S.init(pm0, nM, 3072, F.G, (int)blockIdx.x, 0, 0);
                    pg8::EpiQKVEven E{HB, P.out + OUT_EK, P.out + OUT_EV, P.eqk, ROPE_COS, ROPE_SIN};
                    pg8::gemm_phase<pg8::EpiQKVEven, pg8::GroupOrder, true, true>(F.lds, g, S, E);
                } else {
                    pg8::Gemm g{XN, (const bf16*)(ws + WS_OWIN), MT, 1536, DM};
                    pg8::GroupOrder S; S.init(pm0, nM, 1536, F.G, (int)blockIdx.x, 0, 0);
                    pg8::EpiQKVOdd E{HB, P.out + OUT_OK, P.out + OUT_OV, P.oqk, ROPE_COS, ROPE_SIN};
                    pg8::gemm_phase<pg8::EpiQKVOdd, pg8::GroupOrder, true, true>(F.lds, g, S, E);
                }
            } else {
                if (l == 0) {
                    const float a = wave_sum(P.elam[F.lane] * P.elam[64 + F.lane]), b2 = wave_sum(P.elam[128 + F.lane] * P.elam[192 + F.lane]);
                    const float lam_init = 0.8f - 0.6f * expf(-0.3f * (float)l);
                    const float lam = expf(a) - expf(b2) + lam_init;
                    const int nunits = isP ? 128 : 512;
                    if (isP) { for (int pu = F.vcu; pu < nunits; pu += F.G) { const int bh = pu >> 1; att::even_unit(F.lds, HB, nullptr, nullptr, OB, P.esub, lam, 1.0f - lam_init, false, bh >> 2, bh & 3, pu & 1); } }
                    else { for (int w = F.vcu; w < 256; w += F.G) for (int i = 0; i < 2; ++i) { const int su = w * 2 + i; const int bh = su >> 4; att::even_unit(F.lds, HB, (const bf16*)(ws + WS_CEK), (const bf16*)(ws + WS_CEV), OB, P.esub, lam, 1.0f - lam_init, true, bh >> 2, bh & 3, su & 15); } }
                    {   int pidx = F.vcu, pcount = F.G;
                        if (F.G == 256) { if (isP) { pidx = F.vcu - 128; pcount = 128; } else { pidx = (int)blockIdx.x - 64; pcount = 192; } }
                        conv_rows(F, HB, P.econv, OB, row0, row1, pidx, pcount); }
                } else {
                    if (isP) { for (int pu = F.vcu; pu < 256; pu += F.G) { const int bg = pu >> 2; att::odd_unit(F.lds, HB, nullptr, nullptr, OB, P.osink, false, bg >> 2, bg & 3, pu & 3); } }
                    else { for (int w = F.vcu; w < 256; w += F.G) for (int su = w * 4; su < w * 4 + 4; ++su) { const int bg = su >> 5; att::odd_unit(F.lds, HB, (const bf16*)(ws + WS_COK), (const bf16*)(ws + WS_COV), OB, P.osink, true, bg >> 2, bg & 3, su & 31); } }
                }
            }
        }
      }
        if (ph + 1 < ph_hi) xcd_barrier(bar);
    }
}

extern "C" void kernel_launch(void* const* d_in, const int* in_sizes, int n_in, void* d_out, int out_size, void* d_ws, size_t ws_size, hipStream_t stream) {
    static int grid = 0;
    if (grid == 0) {
        if (n_in != 23 || in_sizes[0] != NPROMPT * DM || in_sizes[1] != NSAMPLE * DM || (size_t)out_size != OUT_TOTAL || ws_size < WS_END) {
            fprintf(stderr, "kernel_launch: shape mismatch: n_in %d in0 %d in1 %d out %d ws %zu (need %zu); nothing launched\n", n_in, n_in > 0 ? in_sizes[0] : -1, n_in > 1 ? in_sizes[1] : -1, out_size, ws_size, (size_t)WS_END); grid = -1; return; }
        int dev = 0, cus = 0, per_cu = 0;
        if (hipGetDevice(&dev) != hipSuccess || hipDeviceGetAttribute(&cus, hipDeviceAttributeMultiprocessorCount, dev) != hipSuccess) { fprintf(stderr, "kernel_launch: device query failed\n"); grid = -1; return; }
        if (hipFuncSetAttribute((const void*)mega_fwd, hipFuncAttributeMaxDynamicSharedMemorySize, LDS_BYTES) != hipSuccess) { fprintf(stderr, "kernel_launch: hipFuncSetAttribute failed\n"); grid = -1; return; }
        if (hipOccupancyMaxActiveBlocksPerMultiprocessor(&per_cu, (const void*)mega_fwd, NWAVES * 64, LDS_BYTES) != hipSuccess || per_cu < 1) { fprintf(stderr, "kernel_launch: occupancy query says %d blocks per CU; nothing launched\n", per_cu); (void)hipGetLastError(); grid = -1; return; }
        grid = cus;
        if (grid % 8 != 0 || grid < 8) fprintf(stderr, "kernel_launch: note: %d CUs\n", grid);
    }
    if (grid < 0) return;
    if (hipMemsetAsync((char*)d_ws + WS_CTL, 0, CTL_ZERO_BYTES, stream) != hipSuccess) { fprintf(stderr, "kernel_launch: memset failed\n"); return; }
    Args a{};
    for (int i = 0; i < 23; ++i) a.in[i] = (const float*)d_in[i];
    a.out = (float*)d_out; a.ws = (unsigned char*)d_ws;
#if MK_PER_PHASE
    for (int ph = 0; ph < N_PHASES; ++ph) { a.ph_lo = ph; a.ph_hi = ph + 1; hipLaunchKernelGGL(mega_fwd, dim3(grid), dim3(NWAVES * 64), LDS_BYTES, stream, a); }
#else
    a.ph_lo = 0; a.ph_hi = N_PHASES;
    hipLaunchKernelGGL(mega_fwd, dim3(grid), dim3(NWAVES * 64), LDS_BYTES, stream, a);
#endif
    const hipError_t le = hipPeekAtLastError();
    if (le != hipSuccess) fprintf(stderr, "kernel_launch: launch failed: %s\n", hipGetErrorName(le));
}
```

```cpp
#include <hip/hip_runtime.h>
#include <cstdio>
#include <cstdint>
#include <cmath>

__device__ const float ROPE_COS[64 * 16] = {
  1.000000000e+00f, 1.000000000e+00f, 1.000000000e+00f, 1.000000000e+00f, 1.000000000e+00f, 1.000000000e+00f, 1.000000000e+00f, 1.000000000e+00f, 1.000000000e+00f, 1.000000000e+00f, 1.000000000e+00f, 1.000000000e+00f, 1.000000000e+00f, 1.000000000e+00f, 1.000000000e+00f, 1.000000000e+00f,
  5.403023059e-01f, 8.460091103e-01f, 9.504152803e-01f, 9.842302345e-01f, 9.950041653e-01f, 9.984192778e-01f, 9.995000417e-01f, 9.998418903e-01f, 9.999500004e-01f, 9.999841887e-01f, 9.999950000e-01f, 9.999984189e-01f, 9.999995000e-01f, 9.999998419e-01f, 9.999999500e-01f, 9.999999842e-01f,
  -4.161468365e-01f, 4.314628294e-01f, 8.065784099e-01f, 9.374183089e-01f, 9.800665778e-01f, 9.936821085e-01f, 9.980006666e-01f, 9.993676111e-01f, 9.998000067e-01f, 9.999367551e-01f, 9.999800001e-01f, 9.999936755e-01f, 9.999980000e-01f, 9.999993675e-01f, 9.999998000e-01f, 9.999999368e-01f,
  -9.899924966e-01f, -1.159661415e-01f, 5.827536107e-01f, 8.610406494e-01f, 9.553364891e-01f, 9.858034685e-01f, 9.955033740e-01f, 9.985773125e-01f, 9.995500337e-01f, 9.998577009e-01f, 9.999550003e-01f, 9.999857698e-01f, 9.999955000e-01f, 9.999985770e-01f, 9.999995500e-01f, 9.999998577e-01f,
  -6.536436209e-01f, -6.276796538e-01f, 3.011374626e-01f, 7.575061717e-01f, 9.210609940e-01f, 9.748082656e-01f, 9.920106610e-01f, 9.974712444e-01f, 9.992001067e-01f, 9.997470285e-01f, 9.999200011e-01f, 9.999747019e-01f, 9.999920000e-01f, 9.999974702e-01f, 9.999992000e-01f, 9.999997470e-01f,
  2.836621855e-01f, -9.460792693e-01f, -1.034231891e-02f, 6.300803045e-01f, 8.775825619e-01f, 9.607312606e-01f, 9.875260200e-01f, 9.960497564e-01f, 9.987502604e-01f, 9.996047413e-01f, 9.998750026e-01f, 9.999604718e-01f, 9.999875000e-01f, 9.999960472e-01f, 9.999987500e-01f, 9.999996047e-01f,
  9.601702867e-01f, -9.731037080e-01f, -3.207964584e-01f, 4.827820000e-01f, 8.253356149e-01f, 9.436169571e-01f, 9.820539352e-01f, 9.943132982e-01f, 9.982005399e-01f, 9.994308440e-01f, 9.998200054e-01f, 9.999430795e-01f, 9.999820001e-01f, 9.999943079e-01f, 9.999982000e-01f, 9.999994308e-01f,
  7.539022543e-01f, -7.004299352e-01f, -5.994373930e-01f, 3.202569776e-01f, 7.648421873e-01f, 9.235194611e-01f, 9.755998784e-01f, 9.922624187e-01f, 9.975510003e-01f, 9.992253420e-01f, 9.997550100e-01f, 9.999225252e-01f, 9.999755001e-01f, 9.999922524e-01f, 9.999975500e-01f, 9.999992252e-01f,
  -1.455000338e-01f, -2.120365045e-01f, -8.186324573e-01f, 1.476312003e-01f, 6.967067093e-01f, 9.005023096e-01f, 9.681703030e-01f, 9.898977666e-01f, 9.968017063e-01f, 9.989882418e-01f, 9.996800171e-01f, 9.998988088e-01f, 9.999680002e-01f, 9.999898807e-01f, 9.999968000e-01f, 9.999989881e-01f,
  -9.111302619e-01f, 3.416603061e-01f, -9.566441996e-01f, -2.965079584e-02f, 6.216099683e-01f, 8.746382701e-01f, 9.597726380e-01f, 9.872200896e-01f, 9.959527330e-01f, 9.987195509e-01f, 9.995950273e-01f, 9.998719305e-01f, 9.999595003e-01f, 9.999871928e-01f, 9.999959500e-01f, 9.999987193e-01f,
  -8.390715291e-01f, 7.901319677e-01f, -9.997860729e-01f, -2.059976198e-01f, 5.403023059e-01f, 8.460091103e-01f, 9.504152803e-01f, 9.842302345e-01f, 9.950041653e-01f, 9.984192778e-01f, 9.995000417e-01f, 9.998418903e-01f, 9.999500004e-01f, 9.999841887e-01f, 9.999950000e-01f, 9.999984189e-01f,
  4.425697988e-03f, 9.952573799e-01f, -9.437797217e-01f, -3.758473754e-01f, 4.535961214e-01f, 8.147053397e-01f, 9.401075865e-01f, 9.809291466e-01f, 9.939560980e-01f, 9.980874320e-01f, 9.993950610e-01f, 9.998086883e-01f, 9.999395006e-01f, 9.999808683e-01f, 9.999939500e-01f, 9.999980868e-01f,
  8.438539587e-01f, 8.938616532e-01f, -7.941792645e-01f, -5.338430810e-01f, 3.623577545e-01f, 7.808259235e-01f, 9.288598634e-01f, 9.773178698e-01f, 9.928086359e-01f, 9.977240240e-01f, 9.992800864e-01f, 9.997723246e-01f, 9.999280009e-01f, 9.999772317e-01f, 9.999928000e-01f, 9.999977232e-01f,
  9.074467815e-01f, 5.171728240e-01f, -5.658204948e-01f, -6.750016262e-01f, 2.674988286e-01f, 7.444779696e-01f, 9.166833580e-01f, 9.733975461e-01f, 9.915618937e-01f, 9.973290652e-01f, 9.991551190e-01f, 9.997327994e-01f, 9.999155012e-01f, 9.999732789e-01f, 9.999915500e-01f, 9.999973279e-01f,
  1.367372182e-01f, -1.879581181e-02f, -2.813496238e-01f, -7.948709366e-01f, 1.699671429e-01f, 7.057763899e-01f, 9.035902455e-01f, 9.691694153e-01f, 9.902159962e-01f, 9.969025682e-01f, 9.990201601e-01f, 9.996901128e-01f, 9.999020016e-01f, 9.999690098e-01f, 9.999902000e-01f, 9.999969010e-01f,
  -7.596879129e-01f, -5.489756801e-01f, 3.102253171e-02f, -8.896703905e-01f, 7.073720167e-02f, 6.648435374e-01f, 8.895936181e-01f, 9.646348142e-01f, 9.887710779e-01f, 9.964445465e-01f, 9.988752109e-01f, 9.996442649e-01f, 9.998875021e-01f, 9.999644246e-01f, 9.999887500e-01f, 9.999964424e-01f,
  -9.576594803e-01f, -9.100810415e-01f, 3.403182001e-01f, -9.564100574e-01f, -2.919952230e-02f, 6.218088190e-01f, 8.747074712e-01f, 9.597951768e-01f, 9.872272834e-01f, 9.959550145e-01f, 9.987202730e-01f, 9.995952558e-01f, 9.998720027e-01f, 9.999595231e-01f, 9.999872000e-01f, 9.999959523e-01f,
  -2.751633381e-01f, -9.908980244e-01f, 6.158647034e-01f, -9.929849996e-01f, -1.288444943e-01f, 5.768082866e-01f, 8.589466897e-01f, 9.546520336e-01f, 9.855847669e-01f, 9.954339878e-01f, 9.985553480e-01f, 9.995430857e-01f, 9.998555035e-01f, 9.999543054e-01f, 9.999855500e-01f, 9.999954305e-01f,
  6.603167082e-01f, -7.665364704e-01f, 8.303362493e-01f, -9.982416606e-01f, -2.272020947e-01f, 5.299842069e-01f, 8.423270331e-01f, 9.492070108e-01f, 9.838436928e-01f, 9.948814827e-01f, 9.983804374e-01f, 9.994877548e-01f, 9.998380044e-01f, 9.999487715e-01f, 9.999838000e-01f, 9.999948771e-01f,
  9.887046182e-01f, -3.060956503e-01f, 9.624638147e-01f, -9.720142477e-01f, -3.232895669e-01f, 4.814846115e-01f, 8.248651197e-01f, 9.434618303e-01f, 9.820042351e-01f, 9.942975168e-01f, 9.981955429e-01f, 9.994292632e-01f, 9.998195054e-01f, 9.999429214e-01f, 9.999819501e-01f, 9.999942921e-01f,
  4.080820618e-01f, 2.486170528e-01f, 9.991443830e-01f, -9.151299613e-01f, -4.161468365e-01f, 4.314628294e-01f, 8.065784099e-01f, 9.374183089e-01f, 9.800665778e-01f, 9.936821085e-01f, 9.980006666e-01f, 9.993676111e-01f, 9.998000067e-01f, 9.999367551e-01f, 9.999800001e-01f, 9.999936755e-01f,
  -5.477292602e-01f, 7.267602337e-01f, 9.367403630e-01f, -8.293829050e-01f, -5.048461046e-01f, 3.800770014e-01f, 7.874851889e-01f, 9.310783576e-01f, 9.780309147e-01f, 9.930352774e-01f, 9.977958102e-01f, 9.993027988e-01f, 9.997795081e-01f, 9.999302726e-01f, 9.999779501e-01f, 9.999930272e-01f,
  -9.999608264e-01f, 9.810745045e-01f, 7.814403262e-01f, -7.174775009e-01f, -5.885011173e-01f, 3.274895812e-01f, 7.676045483e-01f, 9.244439812e-01f, 9.758974493e-01f, 9.923570438e-01f, 9.975809759e-01f, 9.992348264e-01f, 9.997580098e-01f, 9.999234739e-01f, 9.999758001e-01f, 9.999923473e-01f,
  -5.328330203e-01f, 9.332357037e-01f, 5.486452902e-01f, -5.829431928e-01f, -6.662760213e-01f, 2.738668208e-01f, 7.469563671e-01f, 9.175172776e-01f, 9.736663950e-01f, 9.916474291e-01f, 9.973561658e-01f, 9.991636942e-01f, 9.997355117e-01f, 9.999163589e-01f, 9.999735501e-01f, 9.999916358e-01f,
  4.241790073e-01f, 5.979773102e-01f, 2.614414084e-01f, -4.300231298e-01f, -7.373937155e-01f, 2.193782457e-01f, 7.255612918e-01f, 9.103004373e-01f, 9.713379749e-01f, 9.909064559e-01f, 9.971213821e-01f, 9.990894023e-01f, 9.997120138e-01f, 9.999089278e-01f, 9.999712001e-01f, 9.999908927e-01f,
  9.912028119e-01f, 7.855280068e-02f, -5.168947139e-02f, -2.635403389e-01f, -8.011436155e-01f, 1.641961185e-01f, 7.034407157e-01f, 9.027957423e-01f, 9.689124217e-01f, 9.901341476e-01f, 9.968766273e-01f, 9.990119510e-01f, 9.996875163e-01f, 9.999011805e-01f, 9.999687502e-01f, 9.999901179e-01f,
  6.469193223e-01f, -4.650645402e-01f, -3.596943353e-01f, -8.874560929e-02f, -8.568887534e-01f, 1.084948944e-01f, 6.806167575e-01f, 8.950055657e-01f, 9.663899781e-01f, 9.893305286e-01f, 9.966219036e-01f, 9.989313405e-01f, 9.996620190e-01f, 9.998931169e-01f, 9.999662002e-01f, 9.999893115e-01f,
  -2.921388087e-01f, -8.654504764e-01f, -6.320285135e-01f, 8.884811520e-02f, -9.040721420e-01f, 5.245066969e-02f, 6.571122393e-01f, 8.869323709e-01f, 9.637708964e-01f, 9.884956243e-01f, 9.963572138e-01f, 9.988475712e-01f, 9.996355221e-01f, 9.998847372e-01f, 9.999635502e-01f, 9.999884735e-01f,
  -9.626058663e-01f, -9.992934349e-01f, -8.416847784e-01f, 2.636396118e-01f, -9.422223407e-01f, -3.759374883e-03f, 6.329506635e-01f, 8.785787110e-01f, 9.610554383e-01f, 9.876294611e-01f, 9.960825604e-01f, 9.987606432e-01f, 9.996080256e-01f, 9.998760413e-01f, 9.999608003e-01f, 9.999876039e-01f,
  -7.480575297e-01f, -8.253722231e-01f, -9.678716355e-01f, 4.301160387e-01f, -9.709581651e-01f, -5.995753440e-02f, 6.081561899e-01f, 8.699472273e-01f, 9.582438755e-01f, 9.867320664e-01f, 9.957979462e-01f, 9.986705569e-01f, 9.995795295e-01f, 9.998670292e-01f, 9.999579503e-01f, 9.999867027e-01f,
  1.542514499e-01f, -3.972514054e-01f, -9.980752051e-01f, 5.830268074e-01f, -9.899924966e-01f, -1.159661415e-01f, 5.827536107e-01f, 8.610406494e-01f, 9.553364891e-01f, 9.858034685e-01f, 9.955033740e-01f, 9.985773125e-01f, 9.995500337e-01f, 9.998577009e-01f, 9.999550003e-01f, 9.999857698e-01f,
  9.147423578e-01f, 1.532156071e-01f, -9.293002159e-01f, 7.175491840e-01f, -9.991351503e-01f, -1.716081281e-01f, 5.567683265e-01f, 8.518617938e-01f, 9.523335699e-01f, 9.848436969e-01f, 9.951988468e-01f, 9.984809103e-01f, 9.995195385e-01f, 9.998480564e-01f, 9.999519504e-01f, 9.999848053e-01f,
  8.342233605e-01f, 6.564950042e-01f, -7.683670453e-01f, 8.294403958e-01f, -9.982947758e-01f, -2.267075851e-01f, 5.302263203e-01f, 8.424135629e-01f, 9.492354181e-01f, 9.838527819e-01f, 9.948843676e-01f, 9.983813507e-01f, 9.994880437e-01f, 9.998380958e-01f, 9.999488004e-01f, 9.999838092e-01f,
  -1.327674722e-02f, 9.575859018e-01f, -5.312353455e-01f, 9.151714465e-01f, -9.874797699e-01f, -2.810903188e-01f, 5.031541321e-01f, 8.326989444e-01f, 9.460423435e-01f, 9.828307548e-01f, 9.945599395e-01f, 9.982786339e-01f, 9.994555494e-01f, 9.998278189e-01f, 9.999455505e-01f, 9.999827814e-01f,
  -8.485702748e-01f, 9.637577894e-01f, -2.414213342e-01f, 9.720384190e-01f, -9.667981926e-01f, -3.345844009e-01f, 4.755788316e-01f, 8.227210104e-01f, 9.427546655e-01f, 9.817776480e-01f, 9.942255659e-01f, 9.981727603e-01f, 9.994220557e-01f, 9.998172259e-01f, 9.999422006e-01f, 9.999817221e-01f,
  -9.036922051e-01f, 6.731098380e-01f, 7.233429552e-02f, 9.982477555e-01f, -9.364566873e-01f, -3.870207132e-01f, 4.475279919e-01f, 8.124829160e-01f, 9.393727128e-01f, 9.806934947e-01f, 9.938812501e-01f, 9.980637301e-01f, 9.993875625e-01f, 9.998063167e-01f, 9.999387506e-01f, 9.999806311e-01f,
  -1.279636896e-01f, 1.751563210e-01f, 3.789165737e-01f, 9.929728260e-01f, -8.967584163e-01f, -4.382334809e-01f, 4.190296615e-01f, 8.019878987e-01f, 9.358968237e-01f, 9.795783292e-01f, 9.935269954e-01f, 9.979515438e-01f, 9.993520700e-01f, 9.997950914e-01f, 9.999352007e-01f, 9.999795085e-01f,
  7.654140519e-01f, -3.767421515e-01f, 6.479219076e-01f, 9.563799991e-01f, -8.481000317e-01f, -4.880607978e-01f, 3.901123364e-01f, 7.912392773e-01f, 9.323273456e-01f, 9.784321869e-01f, 9.931628054e-01f, 9.978362017e-01f, 9.993155781e-01f, 9.997835499e-01f, 9.999315508e-01f, 9.999783543e-01f,
  9.550736440e-01f, -8.126109057e-01f, 8.526731891e-01f, 8.896233956e-01f, -7.909677119e-01f, -5.363451377e-01f, 3.608049314e-01f, 7.802404506e-01f, 9.286646356e-01f, 9.772551038e-01f, 9.927886839e-01f, 9.977177042e-01f, 9.992780869e-01f, 9.997716922e-01f, 9.999278009e-01f, 9.999771684e-01f,
  2.666429324e-01f, -9.982103072e-01f, 9.728653484e-01f, 7.948084874e-01f, -7.259323042e-01f, -5.829338522e-01f, 3.311367516e-01f, 7.689948967e-01f, 9.249090599e-01f, 9.760471174e-01f, 9.924046345e-01f, 9.975960516e-01f, 9.992395964e-01f, 9.997595184e-01f, 9.999239510e-01f, 9.999759510e-01f,
  -6.669380617e-01f, -8.763791221e-01f, 9.965789963e-01f, 6.749256921e-01f, -6.536436209e-01f, -6.276796538e-01f, 3.011374626e-01f, 7.575061717e-01f, 9.210609940e-01f, 9.748082656e-01f, 9.920106610e-01f, 9.974712444e-01f, 9.992001067e-01f, 9.997470285e-01f, 9.999200011e-01f, 9.999747019e-01f,
  -9.873392775e-01f, -4.846391354e-01f, 9.214624639e-01f, 5.337560571e-01f, -5.748239465e-01f, -6.704410810e-01f, 2.708370612e-01f, 7.457779085e-01f, 9.171208228e-01f, 9.735385879e-01f, 9.916067674e-01f, 9.973432828e-01f, 9.991596177e-01f, 9.997342223e-01f, 9.999159512e-01f, 9.999734212e-01f,
  -3.999853150e-01f, 5.636087450e-02f, 7.549650153e-01f, 3.757520063e-01f, -4.902608213e-01f, -7.110829460e-01f, 2.402658454e-01f, 7.338138159e-01f, 9.130889403e-01f, 9.722381242e-01f, 9.911929578e-01f, 9.972121674e-01f, 9.991181296e-01f, 9.997211001e-01f, 9.999118013e-01f, 9.999721088e-01f,
  5.551133015e-01f, 5.800027620e-01f, 5.135981094e-01f, 2.058969135e-01f, -4.007991721e-01f, -7.494767618e-01f, 2.094543837e-01f, 7.216176770e-01f, 9.089657497e-01f, 9.709069157e-01f, 9.907692362e-01f, 9.970778985e-01f, 9.990756424e-01f, 9.997076617e-01f, 9.999075514e-01f, 9.999707649e-01f,
  9.998433086e-01f, 9.250143668e-01f, 2.212979668e-01f, 2.954792850e-02f, -3.073328700e-01f, -7.855011484e-01f, 1.784334851e-01f, 7.091933487e-01f, 9.047516632e-01f, 9.695450046e-01f, 9.903356070e-01f, 9.969404766e-01f, 9.990321562e-01f, 9.996939071e-01f, 9.999032016e-01f, 9.999693893e-01f,
  5.253219888e-01f, 9.851384009e-01f, -9.294817111e-02f, -1.477329843e-01f, -2.107957994e-01f, -8.190422169e-01f, 1.472341679e-01f, 6.965447596e-01f, 9.004471024e-01f, 9.681524338e-01f, 9.898920744e-01f, 9.967999021e-01f, 9.989876708e-01f, 9.996798365e-01f, 9.998987517e-01f, 9.999679821e-01f,
  -4.321779449e-01f, 7.418577573e-01f, -3.979766910e-01f, -3.203544680e-01f, -1.121525269e-01f, -8.499939289e-01f, 1.158876288e-01f, 6.836759095e-01f, 8.960524975e-01f, 9.667292474e-01f, 9.894386429e-01f, 9.966561754e-01f, 9.989421865e-01f, 9.996654497e-01f, 9.998942019e-01f, 9.999665433e-01f,
  -9.923354692e-01f, 2.700984415e-01f, -6.635380855e-01f, -4.828721220e-01f, -1.238866346e-02f, -8.782584324e-01f, 8.442521171e-02f, 6.705908678e-01f, 8.915682882e-01f, 9.652754904e-01f, 9.889753170e-01f, 9.965092971e-01f, 9.988957033e-01f, 9.996507468e-01f, 9.998895520e-01f, 9.999650728e-01f,
  -6.401443395e-01f, -2.848462729e-01f, -8.632967800e-01f, -6.301602158e-01f, 8.749898344e-02f, -9.037463706e-01f, 5.287837645e-02f, 6.572937723e-01f, 8.869949228e-01f, 9.637912089e-01f, 9.885021014e-01f, 9.963592674e-01f, 9.988482212e-01f, 9.996357277e-01f, 9.998848022e-01f, 9.999635708e-01f,
  3.005925437e-01f, -7.520635254e-01f, -9.774428167e-01f, -7.575733518e-01f, 1.865123694e-01f, -9.263771649e-01f, 2.127866722e-02f, 6.437888276e-01f, 8.823328586e-01f, 9.622764496e-01f, 9.880190008e-01f, 9.962060871e-01f, 9.987997402e-01f, 9.996203926e-01f, 9.998799524e-01f, 9.999620371e-01f,
  9.649660285e-01f, -9.876589150e-01f, -9.946563971e-01f, -8.610929796e-01f, 2.836621855e-01f, -9.460792693e-01f, -1.034231891e-02f, 6.300803045e-01f, 8.775825619e-01f, 9.607312606e-01f, 9.875260200e-01f, 9.960497564e-01f, 9.987502604e-01f, 9.996047413e-01f, 9.998750026e-01f, 9.999604718e-01f,
  7.421541968e-01f, -9.190733545e-01f, -9.132304601e-01f, -9.374541386e-01f, 3.779777427e-01f, -9.627903967e-01f, -4.195296357e-02f, 6.161725377e-01f, 8.727445076e-01f, 9.591556907e-01f, 9.870231639e-01f, 9.958902760e-01f, 9.986997819e-01f, 9.995887740e-01f, 9.998699528e-01f, 9.999588749e-01f,
  -1.629907808e-01f, -5.674299469e-01f, -7.412399703e-01f, -9.842484337e-01f, 4.685166713e-01f, -9.764577158e-01f, -7.352165877e-02f, 6.020699252e-01f, 8.678191797e-01f, 9.575497897e-01f, 9.865104376e-01f, 9.957276462e-01f, 9.986483046e-01f, 9.995724905e-01f, 9.998648030e-01f, 9.999572463e-01f,
  -9.182827862e-01f, -4.102845452e-02f, -4.957411282e-01f, -9.999999947e-01f, 5.543743362e-01f, -9.870380181e-01f, -1.050168384e-01f, 5.877769265e-01f, 8.628070705e-01f, 9.559136084e-01f, 9.859878462e-01f, 9.955618678e-01f, 9.985958287e-01f, 9.995558910e-01f, 9.998595533e-01f, 9.999555861e-01f,
  -8.293098329e-01f, 4.980090543e-01f, -2.010799162e-01f, -9.842120249e-01f, 6.346928759e-01f, -9.944978545e-01f, -1.364070100e-01f, 5.732980613e-01f, 8.577086814e-01f, 9.542471985e-01f, 9.854553950e-01f, 9.953929410e-01f, 9.985423543e-01f, 9.995389753e-01f, 9.998542035e-01f, 9.999538943e-01f,
  2.212675626e-02f, 8.836688484e-01f, 1.135222784e-01f, -9.373824693e-01f, 7.086697743e-01f, -9.988136413e-01f, -1.676607860e-01f, 5.586379081e-01f, 8.525245221e-01f, 9.525506128e-01f, 9.849130892e-01f, 9.952208666e-01f, 9.984878812e-01f, 9.995217436e-01f, 9.998487538e-01f, 9.999521709e-01f,
  8.532201077e-01f, 9.971747381e-01f, 4.168665323e-01f, -8.609883102e-01f, 7.755658785e-01f, -9.999717342e-01f, -1.987469151e-01f, 5.438011027e-01f, 8.472551110e-01f, 9.508239048e-01f, 9.843609343e-01f, 9.950456450e-01f, 9.984324097e-01f, 9.995041958e-01f, 9.998432041e-01f, 9.999504159e-01f,
  8.998668270e-01f, 8.035689776e-01f, 6.788703658e-01f, -7.574389836e-01f, 8.347127848e-01f, -9.979684721e-01f, -2.296343139e-01f, 5.287923369e-01f, 8.419009752e-01f, 9.490671292e-01f, 9.837989357e-01f, 9.948672768e-01f, 9.983759398e-01f, 9.994863320e-01f, 9.998375544e-01f, 9.999486292e-01f,
  1.191801354e-01f, 3.624786135e-01f, 8.735510056e-01f, -6.300003866e-01f, 8.855195169e-01f, -9.928101881e-01f, -2.602920974e-01f, 5.136163566e-01f, 8.364626499e-01f, 9.472803416e-01f, 9.832270992e-01f, 9.946857625e-01f, 9.983184715e-01f, 9.994681520e-01f, 9.998318047e-01f, 9.999468110e-01f,
  -7.710802230e-01f, -1.902485591e-01f, 9.816020819e-01f, -4.826918728e-01f, 9.274784307e-01f, -9.845131900e-01f, -2.906896106e-01f, 4.982779609e-01f, 8.309406791e-01f, 9.454635984e-01f, 9.826454305e-01f, 9.945011028e-01f, 9.982600048e-01f, 9.994496561e-01f, 9.998259550e-01f, 9.999449611e-01f,
  -9.524129804e-01f, -6.843826418e-01f, 9.923082299e-01f, -3.201594838e-01f, 9.601702867e-01f, -9.731037080e-01f, -3.207964584e-01f, 4.827820000e-01f, 8.253356149e-01f, 9.436169571e-01f, 9.820539352e-01f, 9.943132982e-01f, 9.982005399e-01f, 9.994308440e-01f, 9.998200054e-01f, 9.999430795e-01f,
  -2.581016359e-01f, -9.677393408e-01f, 9.046077269e-01f, -1.475294147e-01f, 9.832684384e-01f, -9.586178129e-01f, -3.505825365e-01f, 4.671333740e-01f, 8.196480178e-01f, 9.417404761e-01f, 9.814526195e-01f, 9.941223493e-01f, 9.981400768e-01f, 9.994117159e-01f, 9.998139558e-01f, 9.999411664e-01f,
  6.735071623e-01f, -9.530499555e-01f, 7.271977827e-01f, 2.975366287e-02f, 9.965420970e-01f, -9.411013007e-01f, -3.800180612e-01f, 4.513370314e-01f, 8.138784567e-01f, 9.398342148e-01f, 9.808414892e-01f, 9.939282566e-01f, 9.980786156e-01f, 9.993922718e-01f, 9.998078062e-01f, 9.999392216e-01f,
  9.858965816e-01f, -6.448385490e-01f, 4.776720420e-01f, 2.060983239e-01f, 9.998586364e-01f, -9.206095492e-01f, -4.090735996e-01f, 4.353979673e-01f, 8.080275083e-01f, 9.378982333e-01f, 9.802205506e-01f, 9.937310210e-01f, 9.980161563e-01f, 9.993725116e-01f, 9.998015566e-01f, 9.999372453e-01f,
};
__device__ const float ROPE_SIN[64 * 16] = {
  0.000000000e+00f, 0.000000000e+00f, 0.000000000e+00f, 0.000000000e+00f, 0.000000000e+00f, 0.000000000e+00f, 0.000000000e+00f, 0.000000000e+00f, 0.000000000e+00f, 0.000000000e+00f, 0.000000000e+00f, 0.000000000e+00f, 0.000000000e+00f, 0.000000000e+00f, 0.000000000e+00f, 0.000000000e+00f,
  8.414709848e-01f, 5.331684399e-01f, 3.109835929e-01f, 1.768921862e-01f, 9.983341665e-02f, 5.620449921e-02f, 3.161750640e-02f, 1.778185688e-02f, 9.999833334e-03f, 5.623383614e-03f, 3.162272390e-03f, 1.778278473e-03f, 9.999998333e-04f, 5.623412956e-04f, 3.162277607e-04f, 1.778279401e-04f,
  9.092974268e-01f, 9.021307150e-01f, 5.911271172e-01f, 3.482052759e-01f, 1.986693308e-01f, 1.122313110e-01f, 6.320339793e-02f, 3.555809079e-02f, 1.999866669e-02f, 1.124658940e-02f, 6.324513157e-03f, 3.556551322e-03f, 1.999998667e-03f, 1.124682413e-03f, 6.324554899e-04f, 3.556558745e-04f,
  1.411200081e-01f, 9.932531671e-01f, 8.126488966e-01f, 5.085361344e-01f, 2.955202067e-01f, 1.679033098e-01f, 9.472609133e-02f, 5.332308054e-02f, 2.999550020e-02f, 1.686943954e-02f, 9.486690679e-03f, 5.334812925e-03f, 2.999995500e-03f, 1.687023175e-03f, 9.486831557e-04f, 5.334837977e-04f,
  -7.568024953e-01f, 7.784717415e-01f, 9.535807405e-01f, 6.528280017e-01f, 3.894183423e-01f, 2.230444916e-01f, 1.261540665e-01f, 7.107120850e-02f, 3.998933419e-02f, 2.249175622e-02f, 1.264877333e-02f, 7.113057657e-03f, 3.999989333e-03f, 2.249363404e-03f, 1.264910727e-03f, 7.113117040e-04f,
  -9.589242747e-01f, 3.239352036e-01f, 9.999465168e-01f, 7.765299800e-01f, 4.794255386e-01f, 2.774805306e-01f, 1.574558982e-01f, 8.879686236e-02f, 4.997916927e-02f, 2.811336166e-02f, 1.581072950e-02f, 8.891279896e-03f, 4.999979167e-03f, 2.811702921e-03f, 1.581138171e-03f, 8.891395879e-04f,
  -2.794154982e-01f, -2.303674747e-01f, 9.471481575e-01f, 8.757405669e-01f, 5.646424734e-01f, 3.310393303e-01f, 1.886002871e-01f, 1.064944369e-01f, 5.996400648e-02f, 3.373407807e-02f, 1.897252756e-02f, 1.066947402e-02f, 5.999964000e-03f, 3.374041549e-03f, 1.897365458e-03f, 1.066967444e-03f,
  6.569865987e-01f, -7.137211682e-01f, 8.004216463e-01f, 9.473307069e-01f, 6.442176872e-01f, 3.835515676e-01f, 2.195560914e-01f, 1.241583359e-01f, 6.994284734e-02f, 3.935372772e-02f, 2.213413590e-02f, 1.244763440e-02f, 6.999942833e-03f, 3.936379111e-03f, 2.213592554e-03f, 1.244795266e-03f,
  9.893582466e-01f, -9.772617463e-01f, 5.743177691e-01f, 9.890424807e-01f, 7.173560909e-01f, 4.348512280e-01f, 2.502923579e-01f, 1.417829736e-01f, 7.991469397e-02f, 4.497213290e-02f, 2.529552289e-02f, 1.422575542e-02f, 7.999914667e-03f, 4.498715427e-03f, 2.529819430e-03f, 1.422623048e-03f,
  4.121184852e-01f, -9.398235128e-01f, 2.912591207e-01f, 9.995603185e-01f, 7.833269096e-01f, 4.847761303e-01f, 2.807783529e-01f, 1.593627767e-01f, 8.987854920e-02f, 5.058911594e-02f, 2.845665693e-02f, 1.600383145e-02f, 8.999878500e-03f, 5.061050321e-03f, 2.846046052e-03f, 1.600450786e-03f,
  -5.440211109e-01f, -6.129367615e-01f, -2.068353153e-02f, 9.785524925e-01f, 8.414709848e-01f, 5.331684399e-01f, 3.109835929e-01f, 1.768921862e-01f, 9.983341665e-02f, 5.620449921e-02f, 3.161750640e-02f, 1.778185688e-02f, 9.999833334e-03f, 5.623383614e-03f, 3.162272390e-03f, 1.778278473e-03f,
  -9.999902066e-01f, -9.727665569e-02f, -3.305750095e-01f, 9.266815798e-01f, 8.912073601e-01f, 5.798751671e-01f, 3.408778753e-01f, 1.943656590e-01f, 1.097783008e-01f, 6.181810515e-02f, 3.477803970e-02f, 1.955982607e-02f, 1.099977817e-02f, 6.185715129e-03f, 3.478498411e-03f, 1.956106104e-03f,
  -5.365729180e-01f, 4.483428876e-01f, -6.076835491e-01f, 8.455835647e-01f, 9.320390860e-01f, 6.247486512e-01f, 3.704313082e-01f, 2.117776696e-01f, 1.197122073e-01f, 6.742975624e-02f, 3.793822522e-02f, 2.133773341e-02f, 1.199971200e-02f, 6.748044688e-03f, 3.794724085e-03f, 2.133933673e-03f,
  4.201670368e-01f, 8.558809906e-01f, -8.245284517e-01f, 7.378162404e-01f, 9.635581854e-01f, 6.676470271e-01f, 3.996143406e-01f, 2.291227120e-01f, 1.296341426e-01f, 7.303927501e-02f, 4.109803135e-02f, 2.311557328e-02f, 1.299963384e-02f, 7.310372113e-03f, 4.110949379e-03f, 2.311761174e-03f,
  9.906073557e-01f, 9.998233431e-01f, -9.596053299e-01f, 6.067785379e-01f, 9.854497300e-01f, 7.084346741e-01f, 4.283977921e-01f, 2.463953013e-01f, 1.395431146e-01f, 7.864648408e-02f, 4.425742651e-02f, 2.489334005e-02f, 1.399954267e-02f, 7.872697226e-03f, 4.427174262e-03f, 2.489588602e-03f,
  6.502878402e-01f, 8.358383233e-01f, -9.995186854e-01f, 4.566033249e-01f, 9.974949866e-01f, 7.469826442e-01f, 4.567528814e-01f, 2.635899757e-01f, 1.494381325e-01f, 8.425120614e-02f, 4.741637909e-02f, 2.667102809e-02f, 1.499943751e-02f, 8.435019850e-03f, 4.743398702e-03f, 2.667415952e-03f,
  -2.879033167e-01f, 4.144303293e-01f, -9.403103332e-01f, 2.920270571e-01f, 9.995736030e-01f, 7.831690702e-01f, 4.846512559e-01f, 2.807012978e-01f, 1.593182066e-01f, 8.985326395e-02f, 5.057485751e-02f, 2.844863180e-02f, 1.599931734e-02f, 8.997339806e-03f, 5.059622668e-03f, 2.845243217e-03f,
  -9.613974919e-01f, -1.346146549e-01f, -7.878519322e-01f, 1.182403929e-01f, 9.916648105e-01f, 8.168795508e-01f, 5.120650195e-01f, 2.977238566e-01f, 1.691823491e-01f, 9.545248036e-02f, 5.373283018e-02f, 3.022614554e-02f, 1.699918118e-02f, 9.559656917e-03f, 5.375846129e-03f, 3.023070392e-03f,
  -7.509872468e-01f, -6.422007782e-01f, -5.572626967e-01f, -5.927551787e-02f, 9.738476309e-01f, 8.480075120e-01f, 5.389667608e-01f, 3.146522694e-01f, 1.790295734e-01f, 1.010486783e-01f, 5.689026552e-02f, 3.200356370e-02f, 1.799902802e-02f, 1.012197101e-02f, 5.692069051e-03f, 3.200897472e-03f,
  1.498772097e-01f, -9.520007631e-01f, -2.714100320e-01f, -2.349219066e-01f, 9.463000877e-01f, 8.764545447e-01f, 5.653295802e-01f, 3.314811830e-01f, 1.888588950e-01f, 1.066416808e-01f, 6.004713196e-02f, 3.378088066e-02f, 1.899885685e-02f, 1.068428189e-02f, 6.008291404e-03f, 3.378724451e-03f,
  9.129452507e-01f, -9.686018589e-01f, 4.135821352e-02f, -4.031589686e-01f, 9.092974268e-01f, 9.021307150e-01f, 5.911271172e-01f, 3.482052759e-01f, 1.986693308e-01f, 1.122313110e-01f, 6.320339793e-02f, 3.555809079e-02f, 1.999866669e-02f, 1.124658940e-02f, 6.324513157e-03f, 3.556551322e-03f,
  8.366556385e-01f, -6.868912307e-01f, 3.500249882e-01f, -5.586805857e-01f, 8.632093666e-01f, 9.249548492e-01f, 6.163335763e-01f, 3.648192595e-01f, 2.084598998e-01f, 1.178173922e-01f, 6.635903187e-02f, 3.733518848e-02f, 2.099845653e-02f, 1.180889335e-02f, 6.640734277e-03f, 3.734378081e-03f,
  -8.851309290e-03f, -1.936306189e-01f, 6.239799809e-01f, -6.965816792e-01f, 8.084964038e-01f, 9.448547900e-01f, 6.409237532e-01f, 3.813178801e-01f, 2.182296231e-01f, 1.233997476e-01f, 6.951400222e-02f, 3.911216810e-02f, 2.199822538e-02f, 1.237119357e-02f, 6.956954733e-03f, 3.912204722e-03f,
  -8.462204042e-01f, 3.592646954e-01f, 8.360552287e-01f, -8.125129131e-01f, 7.457052122e-01f, 9.617676250e-01f, 6.648730598e-01f, 3.976959206e-01f, 2.279775235e-01f, 1.289782009e-01f, 7.266827742e-02f, 4.088902404e-02f, 2.299797222e-02f, 1.293348988e-02f, 7.273174493e-03f, 4.090031240e-03f,
  -9.055783620e-01f, 8.015130295e-01f, 9.652193481e-01f, -9.028178708e-01f, 6.754631806e-01f, 9.756398851e-01f, 6.881575487e-01f, 4.139482019e-01f, 2.377026264e-01f, 1.345525755e-01f, 7.582182595e-02f, 4.266575068e-02f, 2.399769607e-02f, 1.349578209e-02f, 7.589393526e-03f, 4.267857628e-03f,
  -1.323517501e-01f, 9.969099546e-01f, 9.986632058e-01f, -9.646483762e-01f, 5.984721441e-01f, 9.864277139e-01f, 7.107539373e-01f, 4.300695848e-01f, 2.474039593e-01f, 1.401226951e-01f, 7.897461625e-02f, 4.444234239e-02f, 2.499739591e-02f, 1.405807004e-02f, 7.905611800e-03f, 4.445683881e-03f,
  7.625584505e-01f, 8.852767779e-01f, 9.330701931e-01f, -9.960543242e-01f, 5.155013718e-01f, 9.940970063e-01f, 7.326396313e-01f, 4.460549713e-01f, 2.570805519e-01f, 1.456883837e-01f, 8.212661682e-02f, 4.621879357e-02f, 2.599707077e-02f, 1.462035354e-02f, 8.221829283e-03f, 4.623509993e-03f,
  9.563759284e-01f, 5.009944839e-01f, 7.749451323e-01f, -9.960451859e-01f, 4.273798802e-01f, 9.986235163e-01f, 7.537927467e-01f, 4.618993065e-01f, 2.667314367e-01f, 1.512494653e-01f, 8.527779611e-02f, 4.799509859e-02f, 2.699671962e-02f, 1.518263242e-02f, 8.538045944e-03f, 4.801335960e-03f,
  2.709057883e-01f, -3.758498280e-02f, 5.399691971e-01f, -9.646212496e-01f, 3.349881502e-01f, 9.999929335e-01f, 7.741921322e-01f, 4.775975802e-01f, 2.763556486e-01f, 1.568057639e-01f, 8.842812263e-02f, 4.977125184e-02f, 2.799634148e-02f, 1.574490650e-02f, 8.854261752e-03f, 4.979161774e-03f,
  -6.636338842e-01f, -5.645889596e-01f, 2.514448194e-01f, -9.027736113e-01f, 2.392493292e-01f, 9.982009287e-01f, 7.938173900e-01f, 4.931448283e-01f, 2.859522251e-01f, 1.623571039e-01f, 9.157756487e-02f, 5.154724769e-02f, 2.899593534e-02f, 1.630717560e-02f, 9.170476674e-03f, 5.156987431e-03f,
  -9.880316241e-01f, -9.177098239e-01f, -6.201520023e-02f, -8.124529167e-01f, 1.411200081e-01f, 9.932531671e-01f, 8.126488966e-01f, 5.085361344e-01f, 2.955202067e-01f, 1.679033098e-01f, 9.472609133e-02f, 5.332308054e-02f, 2.999550020e-02f, 1.686943954e-02f, 9.486690679e-03f, 5.334812925e-03f,
  -4.040376453e-01f, -9.881927837e-01f, -3.693252072e-01f, -6.965078381e-01f, 4.158066243e-02f, 9.851652909e-01f, 8.306678221e-01f, 5.237666315e-01f, 3.050586364e-01f, 1.734442061e-01f, 9.787367054e-02f, 5.509874477e-02f, 3.099503507e-02f, 1.743169815e-02f, 9.802903735e-03f, 5.512638250e-03f,
  5.514266812e-01f, -7.543303715e-01f, -6.400094403e-01f, -5.585952289e-01f, -5.837414343e-02f, 9.739628693e-01f, 8.478561489e-01f, 5.388315034e-01f, 3.145665606e-01f, 1.789796176e-01f, 1.010202710e-01f, 5.687423476e-02f, 3.199453895e-02f, 1.799395124e-02f, 1.011911581e-02f, 5.690463401e-03f,
  9.999118601e-01f, -2.881479492e-01f, -8.472242960e-01f, -4.030647882e-01f, -1.577456941e-01f, 9.596813183e-01f, 8.641966902e-01f, 5.537259863e-01f, 3.240430284e-01f, 1.845093693e-01f, 1.041658613e-01f, 5.864954490e-02f, 3.299401083e-02f, 1.855619865e-02f, 1.043532687e-02f, 5.868288372e-03f,
  5.290826861e-01f, 2.667787912e-01f, -9.704203931e-01f, -2.348218730e-01f, -2.555411020e-01f, 9.423657881e-01f, 8.796731069e-01f, 5.684453703e-01f, 3.334870921e-01f, 1.900332863e-01f, 1.073104099e-01f, 6.042466957e-02f, 3.399344971e-02f, 1.911844019e-02f, 1.075153690e-02f, 6.046113157e-03f,
  -4.281826695e-01f, 7.395425248e-01f, -9.973804438e-01f, -5.917278607e-02f, -3.507832277e-01f, 9.220710209e-01f, 8.942699237e-01f, 5.829850008e-01f, 3.428978075e-01f, 1.955511940e-01f, 1.104538854e-01f, 6.219960316e-02f, 3.499285460e-02f, 1.968067568e-02f, 1.106774584e-02f, 6.223937751e-03f,
  -9.917788534e-01f, 9.845406356e-01f, -9.254308349e-01f, 1.183425828e-01f, -4.425204433e-01f, 8.988611774e-01f, 9.079725452e-01f, 5.973402802e-01f, 3.522742333e-01f, 2.010629178e-01f, 1.135962563e-01f, 6.397434006e-02f, 3.599222450e-02f, 2.024290495e-02f, 1.138395368e-02f, 6.401762149e-03f,
  -6.435381334e-01f, 9.263181696e-01f, -7.617067688e-01f, 2.921254821e-01f, -5.298361409e-01f, 8.728096342e-01f, 9.207672697e-01f, 6.115066689e-01f, 3.616154320e-01f, 2.065682834e-01f, 1.167374914e-01f, 6.574887465e-02f, 3.699155841e-02f, 2.080512781e-02f, 1.170016038e-02f, 6.579586343e-03f,
  2.963685787e-01f, 5.828065854e-01f, -5.224446694e-01f, 4.566948806e-01f, -6.118578909e-01f, 8.439987519e-01f, 9.326413038e-01f, 6.254796874e-01f, 3.709204694e-01f, 2.120671168e-01f, 1.198775590e-01f, 6.752320133e-02f, 3.799085533e-02f, 2.136734410e-02f, 1.201636591e-02f, 6.757410330e-03f,
  9.637953863e-01f, 5.980119189e-02f, -2.313720250e-01f, 6.068603368e-01f, -6.877661592e-01f, 8.125196145e-01f, 9.435827742e-01f, 6.392549170e-01f, 3.801884151e-01f, 2.175592441e-01f, 1.230164278e-01f, 6.929731449e-02f, 3.899011425e-02f, 2.192955363e-02f, 1.233257024e-02f, 6.935234103e-03f,
  7.451131605e-01f, -4.816218791e-01f, 8.264565347e-02f, 7.378857026e-01f, -7.568024953e-01f, 7.784717415e-01f, 9.535807405e-01f, 6.528280017e-01f, 3.894183423e-01f, 2.230444916e-01f, 1.261540665e-01f, 7.107120850e-02f, 3.998933419e-02f, 2.249175622e-02f, 1.264877333e-02f, 7.113057657e-03f,
  -1.586226688e-01f, -8.747141867e-01f, 3.884674088e-01f, 8.456384993e-01f, -8.182771111e-01f, 7.419627733e-01f, 9.626252055e-01f, 6.661946496e-01f, 3.986093280e-01f, 2.285226858e-01f, 1.292904437e-01f, 7.284487777e-02f, 4.098851413e-02f, 2.305395171e-02f, 1.296497516e-02f, 7.290880986e-03f,
  -9.165215479e-01f, -9.984104626e-01f, 6.557650689e-01f, 9.267202543e-01f, -8.715757724e-01f, 7.031081310e-01f, 9.707071255e-01f, 6.793506338e-01f, 4.077604531e-01f, 2.339936535e-01f, 1.324255279e-01f, 7.461831668e-02f, 4.198765309e-02f, 2.361613990e-02f, 1.328117570e-02f, 7.468704084e-03f,
  -8.317747426e-01f, -8.146145076e-01f, 8.580308748e-01f, 9.785736871e-01f, -9.161659367e-01f, 6.620306515e-01f, 9.778184193e-01f, 6.922917941e-01f, 4.168708024e-01f, 2.394572216e-01f, 1.355592879e-01f, 7.639151963e-02f, 4.298675006e-02f, 2.417832062e-02f, 1.359737490e-02f, 7.646526947e-03f,
  1.770192511e-02f, -3.799321270e-01f, 9.752062397e-01f, 9.995633646e-01f, -9.516020739e-01f, 6.188601989e-01f, 9.839519762e-01f, 7.050140383e-01f, 4.259394651e-01f, 2.449132175e-01f, 1.386916923e-01f, 7.816448100e-02f, 4.398580404e-02f, 2.474049370e-02f, 1.391357275e-02f, 7.824349567e-03f,
  8.509035245e-01f, 1.717624261e-01f, 9.956709484e-01f, 9.890272824e-01f, -9.775301177e-01f, 5.737332542e-01f, 9.891016630e-01f, 7.175133434e-01f, 4.349655341e-01f, 2.503614686e-01f, 1.418227098e-01f, 7.993719520e-02f, 4.498481404e-02f, 2.530265896e-02f, 1.422976920e-02f, 8.002171940e-03f,
  9.017883476e-01f, 6.705572816e-01f, 9.173955273e-01f, 9.472977435e-01f, -9.936910036e-01f, 5.267924836e-01f, 9.932623307e-01f, 7.297857568e-01f, 4.439481070e-01f, 2.558018026e-01f, 1.449523091e-01f, 8.170965662e-02f, 4.598377905e-02f, 2.586481621e-02f, 1.454596424e-02f, 8.179994060e-03f,
  1.235731227e-01f, 9.628327123e-01f, 7.481425059e-01f, 8.756908780e-01f, -9.999232576e-01f, 4.781862879e-01f, 9.964298187e-01f, 7.418273977e-01f, 4.528862854e-01f, 2.612340474e-01f, 1.480804588e-01f, 8.348185965e-02f, 4.698269808e-02f, 2.642696529e-02f, 1.486215781e-02f, 8.357815921e-03f,
  -7.682546613e-01f, 9.585732110e-01f, 5.046966116e-01f, 7.764651328e-01f, -9.961646088e-01f, 4.280683329e-01f, 9.986009600e-01f, 7.536344584e-01f, 4.617791755e-01f, 2.666580314e-01f, 1.512071278e-01f, 8.525379868e-02f, 4.798157012e-02f, 2.698910600e-02f, 1.517834990e-02f, 8.535637518e-03f,
  -9.537526528e-01f, 6.590906264e-01f, 2.112002371e-01f, 6.527500415e-01f, -9.824526126e-01f, 3.765970636e-01f, 9.997735835e-01f, 7.652032053e-01f, 4.706258882e-01f, 2.720735828e-01f, 1.543322846e-01f, 8.702546812e-02f, 4.898039419e-02f, 2.755123819e-02f, 1.549454048e-02f, 8.713458845e-03f,
  -2.623748537e-01f, 1.566201379e-01f, -1.032407464e-01f, 5.084475199e-01f, -9.589242747e-01f, 3.239352036e-01f, 9.999465168e-01f, 7.765299800e-01f, 4.794255386e-01f, 2.774805306e-01f, 1.574558982e-01f, 8.879686236e-02f, 4.997916927e-02f, 2.811336166e-02f, 1.581072950e-02f, 8.891279896e-03f,
  6.702291758e-01f, -3.940864994e-01f, -4.074434030e-01f, 3.481088020e-01f, -9.258146823e-01f, 2.702492405e-01f, 9.991195869e-01f, 7.876112009e-01f, 4.881772469e-01f, 2.828787037e-01f, 1.605779372e-01f, 9.056797580e-02f, 5.097789438e-02f, 2.867547624e-02f, 1.612691694e-02f, 9.069100666e-03f,
  9.866275920e-01f, -8.234216753e-01f, -6.712401257e-01f, 1.767908958e-01f, -8.834546557e-01f, 2.157088994e-01f, 9.972936206e-01f, 7.984433638e-01f, 4.968801378e-01f, 2.882679314e-01f, 1.636983704e-01f, 9.233880284e-02f, 5.197656850e-02f, 2.923758175e-02f, 1.644310277e-02f, 9.246921150e-03f,
  3.959251502e-01f, -9.991579785e-01f, -8.684703414e-01f, -1.029124367e-04f, -8.322674422e-01f, 1.604866066e-01f, 9.944704438e-01f, 8.090230434e-01f, 5.055333412e-01f, 2.936480433e-01f, 1.668171666e-01f, 9.410933788e-02f, 5.297519065e-02f, 2.979967802e-02f, 1.675928696e-02f, 9.424741341e-03f,
  -5.587890489e-01f, -8.671718295e-01f, -9.795748401e-01f, -1.769934748e-01f, -7.727644876e-01f, 1.047569444e-01f, 9.906528795e-01f, 8.193468942e-01f, 5.141359917e-01f, 2.990188692e-01f, 1.699342947e-01f, 9.587957531e-02f, 5.397375983e-02f, 3.036176486e-02f, 1.707546947e-02f, 9.602561234e-03f,
  -9.997551734e-01f, -4.681125574e-01f, -9.935354510e-01f, -3.483017460e-01f, -7.055403256e-01f, 4.869609889e-02f, 9.858447448e-01f, 8.294116515e-01f, 5.226872289e-01f, 3.043802394e-01f, 1.730497234e-01f, 9.764950955e-02f, 5.497227503e-02f, 3.092384210e-02f, 1.739165027e-02f, 9.780380823e-03f,
  -5.215510021e-01f, 7.511685313e-02f, -9.089677080e-01f, -5.086247435e-01f, -6.312666379e-01f, -7.518696635e-03f, 9.800508475e-01f, 8.392141328e-01f, 5.311861979e-01f, 3.097319842e-01f, 1.761634216e-01f, 9.941913500e-02f, 5.597073526e-02f, 3.148590956e-02f, 1.770782933e-02f, 9.958200103e-03f,
  4.361647552e-01f, 5.952116415e-01f, -7.342581470e-01f, -6.529059551e-01f, -5.506855426e-01f, -6.370972221e-02f, 9.732769811e-01f, 8.487512383e-01f, 5.396320487e-01f, 3.150739345e-01f, 1.792753582e-01f, 1.011884461e-01f, 5.696913951e-02f, 3.204796707e-02f, 1.802400663e-02f, 1.013601907e-02f,
  9.928726481e-01f, 9.319920894e-01f, -4.867326171e-01f, -7.765948190e-01f, -4.646021794e-01f, -1.196993330e-01f, 9.655299188e-01f, 8.580199521e-01f, 5.480239368e-01f, 3.204059213e-01f, 1.823855020e-01f, 1.029574371e-01f, 5.796748680e-02f, 3.261001444e-02f, 1.834018212e-02f, 1.031383771e-02f,
  6.367380071e-01f, 9.817359552e-01f, -1.909380864e-01f, -8.757902465e-01f, -3.738766648e-01f, -1.753105211e-01f, 9.568174070e-01f, 8.670173434e-01f, 5.563610229e-01f, 3.257277760e-01f, 1.854938220e-01f, 1.047261026e-01f, 5.896577612e-02f, 3.317205150e-02f, 1.865635577e-02f, 1.049165603e-02f,
  -3.048106211e-01f, 7.291230346e-01f, 1.237916674e-01f, -9.473636604e-01f, -2.794154982e-01f, -2.303674747e-01f, 9.471481575e-01f, 8.757405669e-01f, 5.646424734e-01f, 3.310393303e-01f, 1.886002871e-01f, 1.064944369e-01f, 5.996400648e-02f, 3.373407807e-02f, 1.897252756e-02f, 1.066947402e-02f,
  -9.661177700e-01f, 2.519535043e-01f, 4.262450708e-01f, -9.890576686e-01f, -1.821625043e-01f, -2.846961343e-01f, 9.365318388e-01f, 8.841868642e-01f, 5.728674601e-01f, 3.363404163e-01f, 1.917048661e-01f, 1.082624345e-01f, 6.096217687e-02f, 3.429609397e-02f, 1.928869745e-02f, 1.084729167e-02f,
  -7.391806966e-01f, -3.028131145e-01f, 6.864279895e-01f, -9.995572618e-01f, -8.308940282e-02f, -3.381247429e-01f, 9.249790663e-01f, 8.923535645e-01f, 5.810351605e-01f, 3.416308663e-01f, 1.948075281e-01f, 1.100300897e-01f, 6.196028630e-02f, 3.485809903e-02f, 1.960486542e-02f, 1.102510897e-02f,
  1.673557003e-01f, -7.643188115e-01f, 8.785382293e-01f, -9.785312876e-01f, 1.681390048e-02f, -3.904843889e-01f, 9.125013918e-01f, 9.002380852e-01f, 5.891447579e-01f, 3.469105129e-01f, 1.979082420e-01f, 1.117973969e-01f, 6.295833377e-02f, 3.542009306e-02f, 1.992103142e-02f, 1.120292593e-02f,
};

namespace pg8 {
#define PG8_LAS __attribute__((address_space(3)))
typedef unsigned short bf16_t;
typedef short bf16x8 __attribute__((ext_vector_type(8)));
typedef float f32x4 __attribute__((ext_vector_type(4)));
typedef unsigned u32x4 __attribute__((ext_vector_type(4)));
constexpr int BM = 256, BK = 64, HALF = 128, HTB = HALF * BK * 2  , STAGE_BYTES = 8 * HTB, NXCD = 8, WGM = 8;

__host__ __device__ __forceinline__ int lds_byte(int r, int c) { const int st = (r >> 4) * 2 + (c >> 5), rr = r & 15, cc = c & 31, ob = rr * 64 + cc * 2; return st * 1024 + (ob ^ (((ob >> 9) & 1) << 5)); }
__host__ __device__ __forceinline__ void stage_rc(int b, int& R, int& C) { const int st = b / 1024, sb = b % 1024, swz = sb ^ (((sb >> 9) & 1) << 5); R = (st >> 1) * 16 + swz / 64; C = (st & 1) * 32 + (swz % 64) / 2; }
__host__ __device__ __forceinline__ int perm32(int rho) { const int n = rho >> 4, i = rho & 15; return 8 * (i >> 2) + 4 * n + (i & 3); }

struct Unit { int pm, pn, kh; };
struct Gemm { const bf16_t* A; const bf16_t* Bt; int M, N, K; int KL; };

struct StaticOrder {
    int nM, nN, nwg, G, c;
    __host__ __device__ void init(int M, int N, int G_, int c_) { nM = M / BM; nN = N / BM; nwg = nM * nN; G = G_; c = c_; }
    __host__ __device__ bool next(int i, Unit& u) const {
        const long L = (long)i * G + c; if (L >= nwg) return false;
        int wgid = (int)L; { const int q = nwg / NXCD, r = nwg % NXCD, xcd = wgid % NXCD, off = wgid / NXCD; wgid = (xcd < r ? xcd * (q + 1) : r * (q + 1) + (xcd - r) * q) + off; }
        const int nig = WGM * nN, gid = wgid / nig, fm = gid * WGM, gsz = (nM - fm) < WGM ? (nM - fm) : WGM;
        u.pm = fm + ((wgid % nig) % gsz); u.pn = (wgid % nig) / gsz; u.kh = 0; return true;
    }
    __device__ __forceinline__ void a_ready(const Unit&) const {}
    __device__ __forceinline__ void done(const Unit&) const {}
};

__device__ __forceinline__ unsigned cvt_pk_bf16(float lo, float hi) { unsigned r; asm volatile("v_cvt_pk_bf16_f32 %0, %1, %2" : "=v"(r) : "v"(lo), "v"(hi)); return r; }
typedef float f32x2 __attribute__((ext_vector_type(2)));

__device__ __forceinline__ int opaque_tid() { int t = threadIdx.x; asm volatile("" : "+v"(t)); return t; }
#define EPI_FENCE() asm volatile("" ::: "memory")
constexpr int MOD_STRIDE = 9 * 1024;
__device__ __forceinline__ int cond_of_panel(int pm) { return pm < 16 ? 8 : ((pm - 16) >> 3); }
__device__ __forceinline__ f32x2 silu_mul_pk(f32x2 g, f32x2 u) {
    const f32x2 t = g * (-1.4426950408889634f);
    f32x2 e; e.x = __builtin_amdgcn_exp2f(t.x); e.y = __builtin_amdgcn_exp2f(t.y);
    const f32x2 d = e + 1.0f;
    f32x2 r; r.x = __builtin_amdgcn_rcpf(d.x); r.y = __builtin_amdgcn_rcpf(d.y);
    return (g * u) * r;
}
__device__ __forceinline__ float fast_silu(float g) { return g * __builtin_amdgcn_rcpf(1.0f + __builtin_amdgcn_exp2f(-1.4426950408889634f * g)); }

struct EpiSwiGLU {
    static constexpr bool PERM = true, AFTER_DRAIN = false;
    bf16_t* H; int ldh;
    __device__ __forceinline__ void operator()(const f32x4 (&acc)[2][2][4][2], const Unit& u, int wr, int wc, int fr, int fq) const {
        const int row0 = u.pm * BM + wr * 64 + fr, col0 = u.pn * HALF + wc * 32 + 8 * fq;
#pragma unroll
        for (int ai = 0; ai < 2; ++ai)
#pragma unroll
            for (int m = 0; m < 4; ++m) {
                bf16_t* rowp = H + (size_t)(row0 + ai * HALF + m * 16) * ldh + col0;
                const f32x4 g0 = acc[ai][0][m][0], g1 = acc[ai][0][m][1], u0 = acc[ai][1][m][0], u1 = acc[ai][1][m][1];
                const f32x2 h0 = silu_mul_pk((f32x2){g0[0], g0[1]}, (f32x2){u0[0], u0[1]}), h1 = silu_mul_pk((f32x2){g0[2], g0[3]}, (f32x2){u0[2], u0[3]});
                const f32x2 h2 = silu_mul_pk((f32x2){g1[0], g1[1]}, (f32x2){u1[0], u1[1]}), h3 = silu_mul_pk((f32x2){g1[2], g1[3]}, (f32x2){u1[2], u1[3]});
                u32x4 w;
                w.x = cvt_pk_bf16(h0.x, h0.y); w.y = cvt_pk_bf16(h1.x, h1.y); w.z = cvt_pk_bf16(h2.x, h2.y); w.w = cvt_pk_bf16(h3.x, h3.y);
                *(u32x4*)rowp = w;
            }
    }
};

__device__ __forceinline__ float bflo(unsigned w) { return __builtin_bit_cast(float, w << 16); }
__device__ __forceinline__ float bfhi(unsigned w) { return __builtin_bit_cast(float, w & 0xffff0000u); }
struct EpiResid {
    static constexpr bool PERM = true, AFTER_DRAIN = false;
    const float* gate; int half_gate;
    bf16_t* dout; bf16_t* dout1;
    __device__ __forceinline__ void operator()(const f32x4 (&acc)[2][2][4][2], const Unit& u, int wr, int wc, int fr, int fq) const {
        const float gs = half_gate ? 0.5f : 1.0f;
        const int cl = u.pn * BM + wc * 32 + 8 * fq;
        const float* gp = gate + (size_t)cond_of_panel(u.pm) * MOD_STRIDE + cl;
        f32x4 gv[2][2];
#pragma unroll
        for (int bj = 0; bj < 2; ++bj)
#pragma unroll
            for (int n = 0; n < 2; ++n) gv[bj][n] = *(const f32x4*)(gp + bj * HALF + 4 * n) * gs;
        const size_t r0 = (size_t)(u.pm * BM + wr * 64 + fr) * 1024 + cl;
        bf16_t* dq = u.kh ? dout1 : dout;
#pragma unroll
        for (int ai = 0; ai < 2; ++ai)
#pragma unroll
            for (int m = 0; m < 4; ++m)
#pragma unroll
                for (int bj = 0; bj < 2; ++bj) { const f32x4 v0 = gv[bj][0] * acc[ai][bj][m][0], v1 = gv[bj][1] * acc[ai][bj][m][1];
                    u32x4 w; w.x = cvt_pk_bf16(v0[0], v0[1]); w.y = cvt_pk_bf16(v0[2], v0[3]); w.z = cvt_pk_bf16(v1[0], v1[1]); w.w = cvt_pk_bf16(v1[2], v1[3]);
                    *(u32x4*)(dq + r0 + (size_t)(ai * HALF + m * 16) * 1024 + bj * HALF) = w; }
    }
};

template <bool FIN, bool FOUT>
struct EpiResidB {
    static constexpr bool PERM = true, AFTER_DRAIN = false;
    const float* xf; const bf16_t* xb; bf16_t* outb; float* outf; const float* gate; int half_gate;
    int npend; const bf16_t* pd0; const bf16_t* pd1;
    __device__ __forceinline__ void operator()(const f32x4 (&acc)[2][2][4][2], const Unit& u, int wr, int wc, int fr, int fq) const {
        const float gs = half_gate ? 0.5f : 1.0f;
        const int cl = u.pn * BM + wc * 32 + 8 * fq;
        const float* gp = gate + (size_t)cond_of_panel(u.pm) * MOD_STRIDE + cl;
        f32x4 gv[2][2];
#pragma unroll
        for (int bj = 0; bj < 2; ++bj)
#pragma unroll
            for (int n = 0; n < 2; ++n) gv[bj][n] = *(const f32x4*)(gp + bj * HALF + 4 * n) * gs;
        const size_t r0 = (size_t)(u.pm * BM + wr * 64 + fr) * 1024 + cl;
        constexpr bool fin = FIN, fout = FOUT;
        const float* xfp = xf + (r0 - (size_t)4096 * 1024);
#pragma unroll
        for (int ai = 0; ai < 2; ++ai)
#pragma unroll
            for (int mp = 0; mp < 2; ++mp) {
                EPI_FENCE();
                f32x4 xv[2][2][2]; u32x4 xr[2][2], p0[2][2], p1[2][2];
#pragma unroll
                for (int mm = 0; mm < 2; ++mm)
#pragma unroll
                    for (int bj = 0; bj < 2; ++bj) { const size_t o = (size_t)(ai * HALF + (2 * mp + mm) * 16) * 1024 + bj * HALF;
                        if constexpr (fin) { xv[mm][bj][0] = __builtin_nontemporal_load((const f32x4*)(xfp + o)); xv[mm][bj][1] = __builtin_nontemporal_load((const f32x4*)(xfp + o + 4)); }
                        else xr[mm][bj] = __builtin_nontemporal_load((const u32x4*)(xb + r0 + o));
                        if (npend > 0) p0[mm][bj] = __builtin_nontemporal_load((const u32x4*)(pd0 + r0 + o));
                        if (npend > 1) p1[mm][bj] = __builtin_nontemporal_load((const u32x4*)(pd1 + r0 + o)); }
                EPI_FENCE();
#pragma unroll
                for (int mm = 0; mm < 2; ++mm)
#pragma unroll
                    for (int bj = 0; bj < 2; ++bj) { const int m = 2 * mp + mm; const size_t o = (size_t)(ai * HALF + m * 16) * 1024 + bj * HALF;
                        f32x4 a = gv[bj][0] * acc[ai][bj][m][0], b = gv[bj][1] * acc[ai][bj][m][1];
                        if constexpr (fin) { a += xv[mm][bj][0]; b += xv[mm][bj][1]; }
                        else { const u32x4 w = xr[mm][bj]; a += (f32x4){bflo(w.x), bfhi(w.x), bflo(w.y), bfhi(w.y)}; b += (f32x4){bflo(w.z), bfhi(w.z), bflo(w.w), bfhi(w.w)}; }
                        if (npend > 0) { const u32x4 w = p0[mm][bj]; a += (f32x4){bflo(w.x), bfhi(w.x), bflo(w.y), bfhi(w.y)}; b += (f32x4){bflo(w.z), bfhi(w.z), bflo(w.w), bfhi(w.w)}; }
                        if (npend > 1) { const u32x4 w = p1[mm][bj]; a += (f32x4){bflo(w.x), bfhi(w.x), bflo(w.y), bfhi(w.y)}; b += (f32x4){bflo(w.z), bfhi(w.z), bflo(w.w), bfhi(w.w)}; }
                        if constexpr (fout) { *(f32x4*)(outf + r0 + o) = a; *(f32x4*)(outf + r0 + o + 4) = b; }
                        else { u32x4 w; w.x = cvt_pk_bf16(a[0], a[1]); w.y = cvt_pk_bf16(a[2], a[3]); w.z = cvt_pk_bf16(b[0], b[1]); w.w = cvt_pk_bf16(b[2], b[3]); *(u32x4*)(outb + r0 + o) = w; } }
            }
    }
};

typedef unsigned u32x2 __attribute__((ext_vector_type(2)));
__device__ __forceinline__ void store_bf16x4(bf16_t* p, f32x4 v) { u32x2 w; w.x = cvt_pk_bf16(v[0], v[1]); w.y = cvt_pk_bf16(v[2], v[3]); *(u32x2*)p = w; }

__device__ __forceinline__ u32x4 pack8(const f32x4 a, const f32x4 b) { u32x4 w; w.x = cvt_pk_bf16(a[0], a[1]); w.y = cvt_pk_bf16(a[2], a[3]); w.z = cvt_pk_bf16(b[0], b[1]); w.w = cvt_pk_bf16(b[2], b[3]); return w; }
__device__ __forceinline__ void plain_tile(const f32x4 (&acc)[2][2][4][2], int pm, int wr, int wc, int fr, int fq, bf16_t* dst, int dpitch, int dcol0, float* fdst, int fpitch, int fcol0) {
    const int row0 = pm * BM + wr * 64 + fr, c0 = wc * 32 + 8 * fq;
#pragma unroll
    for (int ai = 0; ai < 2; ++ai)
#pragma unroll
        for (int m = 0; m < 4; ++m) {
            EPI_FENCE();
            int row = row0 + ai * HALF + m * 16; asm volatile("" : "+v"(row));
#pragma unroll
            for (int bj = 0; bj < 2; ++bj) {
                const int c = c0 + bj * HALF;
                *(u32x4*)(dst + (size_t)row * dpitch + dcol0 + c) = pack8(acc[ai][bj][m][0], acc[ai][bj][m][1]);
                if (fdst) { *(f32x4*)(fdst + (size_t)row * fpitch + fcol0 + c) = acc[ai][bj][m][0]; *(f32x4*)(fdst + (size_t)row * fpitch + fcol0 + c + 4) = acc[ai][bj][m][1]; }
            }
        }
}
__device__ __forceinline__ void prod_tile(const f32x4 (&acc)[2][2][4][2], int pm, int wr, int wc, int fr, int fq, bf16_t* dst, int dpitch, int dcol0) {
    const int row0 = pm * BM + wr * 64 + fr, c0 = wc * 32 + 8 * fq;
#pragma unroll
    for (int ai = 0; ai < 2; ++ai)
#pragma unroll
        for (int m = 0; m < 4; ++m) {
            const int row = row0 + ai * HALF + m * 16;
            *(u32x4*)(dst + (size_t)row * dpitch + dcol0 + c0) = pack8(acc[ai][0][m][0] * acc[ai][1][m][0], acc[ai][0][m][1] * acc[ai][1][m][1]);
        }
}
__device__ __forceinline__ float fq_sum(float x) {
    auto a = __builtin_amdgcn_permlane16_swap(__float_as_uint(x), __float_as_uint(x), false, false); x = __uint_as_float(a[0]) + __uint_as_float(a[1]);
    auto b = __builtin_amdgcn_permlane32_swap(__float_as_uint(x), __float_as_uint(x), false, false); return __uint_as_float(b[0]) + __uint_as_float(b[1]);
}
__device__ __forceinline__ float other32(float x, bool upper) {
    auto r = __builtin_amdgcn_permlane32_swap(__float_as_uint(x), __float_as_uint(x), false, false); return __uint_as_float(upper ? r[0] : r[1]);
}
__device__ __forceinline__ void head_tile(const f32x4 (&acc)[2][2][4][2], int pm, int wr, int wc, int fr, int fq, const float* gq, bool rope, float outscale,
                                          bf16_t* dst, int dpitch, int dcol, float* fdst, int fpitch, int fcol, const float* rcos, const float* rsin) {
    f32x4 gv[2][2];
#pragma unroll
    for (int bj = 0; bj < 2; ++bj)
#pragma unroll
        for (int n = 0; n < 2; ++n) gv[bj][n] = *(const f32x4*)(gq + 32 * bj + 8 * fq + 4 * n) * outscale;
    const bool upper = fq >= 2; const float sgn = upper ? 1.0f : -1.0f; const int fo = 8 * (fq & 1);
    const int rbase = pm * BM + wr * 64;
#pragma unroll
    for (int ai = 0; ai < 2; ++ai) {
        const int prow = (((rbase + ai * HALF) - 4096) & 2047) >> 6;
#pragma unroll
        for (int m = 0; m < 4; ++m) {
            EPI_FENCE();
            int row = rbase + ai * HALF + m * 16 + fr; asm volatile("" : "+v"(row));
            f32x4 v[2][2]; float ss = 0.f;
#pragma unroll
            for (int bj = 0; bj < 2; ++bj)
#pragma unroll
                for (int n = 0; n < 2; ++n) { v[bj][n] = acc[ai][bj][m][n]; const f32x4 q = v[bj][n] * v[bj][n]; ss += (q[0] + q[1]) + (q[2] + q[3]); }
            ss = fq_sum(ss);
            const float r = 1.0f / sqrtf(ss * (1.0f / 64.0f) + 1e-6f);
#pragma unroll
            for (int bj = 0; bj < 2; ++bj)
#pragma unroll
                for (int n = 0; n < 2; ++n) v[bj][n] = v[bj][n] * r * gv[bj][n];
            if (fdst) {
#pragma unroll
                for (int bj = 0; bj < 2; ++bj)
#pragma unroll
                    for (int n = 0; n < 2; ++n) *(f32x4*)(fdst + (size_t)row * fpitch + fcol + 32 * bj + 8 * fq + 4 * n) = v[bj][n];
            }
            if (rope) {
                const int p = 16 * m + fr;
#pragma unroll
                for (int n = 0; n < 2; ++n) {
                    {   const f32x4 cr = *(const f32x4*)(rcos + prow * 16 + fo + 4 * n), sr = *(const f32x4*)(rsin + prow * 16 + fo + 4 * n) * sgn;
                        f32x4 o0;
#pragma unroll
                        for (int i = 0; i < 4; ++i) o0[i] = other32(v[0][n][i], upper);
                        v[0][n] = v[0][n] * cr + o0 * sr; }
                    {   const f32x4 cc = *(const f32x4*)(rcos + p * 16 + fo + 4 * n), sc = *(const f32x4*)(rsin + p * 16 + fo + 4 * n) * sgn;
                        f32x4 o1;
#pragma unroll
                        for (int i = 0; i < 4; ++i) o1[i] = other32(v[1][n][i], upper);
                        v[1][n] = v[1][n] * cc + o1 * sc; }
                }
            }
#pragma unroll
            for (int bj = 0; bj < 2; ++bj) *(u32x4*)(dst + (size_t)row * dpitch + dcol + 32 * bj + 8 * fq) = pack8(v[bj][0], v[bj][1]);
        }
    }
}
constexpr float QSCALE = 0.125f * 1.4426950408889634f;

constexpr int HBP = 2816;
struct EpiQKVEven {
    static constexpr bool PERM = true, AFTER_DRAIN = false;
    bf16_t* HB;
    float *newk, *newv;
    const float* qkg;
    const float *rcos, *rsin;
    __device__ __forceinline__ void operator()(const f32x4 (&acc)[2][2][4][2], const Unit& u, int wr, int wc, int fr, int fq) const {
        const int pn = u.pn; const bool sample = u.pm >= 16;
        if (pn < 2)      head_tile(acc, u.pm, wr, wc, fr, fq, qkg, sample, QSCALE, HB, HBP, 64 * (4 * pn + wc), nullptr, 0, 0, rcos, rsin);
        else if (pn < 4) head_tile(acc, u.pm, wr, wc, fr, fq, qkg + 64, sample, 1.0f, HB, HBP, 512 + 64 * (4 * (pn - 2) + wc), sample ? nullptr : newk, 512, 64 * (4 * (pn - 2) + wc), rcos, rsin);
        else if (pn < 6) plain_tile(acc, u.pm, wr, wc, fr, fq, HB, HBP, 1024 + 256 * (pn - 4), sample ? nullptr : newv, 512, 256 * (pn - 4));
        else if (pn < 8) plain_tile(acc, u.pm, wr, wc, fr, fq, HB, HBP, 1536 + 256 * (pn - 6), nullptr, 0, 0);
        else             prod_tile(acc, u.pm, wr, wc, fr, fq, HB, HBP, 2048 + 128 * (pn - 8));
    }
};
struct EpiQKVOdd {
    static constexpr bool PERM = true, AFTER_DRAIN = false;
    bf16_t* HB;
    float *newk, *newv;
    const float* qkg; const float *rcos, *rsin;
    __device__ __forceinline__ void operator()(const f32x4 (&acc)[2][2][4][2], const Unit& u, int wr, int wc, int fr, int fq) const {
        const int pn = u.pn; const bool sample = u.pm >= 16;
        if (pn < 4)       head_tile(acc, u.pm, wr, wc, fr, fq, qkg, sample, QSCALE, HB, HBP, 64 * (4 * pn + wc), nullptr, 0, 0, rcos, rsin);
        else if (pn == 4) head_tile(acc, u.pm, wr, wc, fr, fq, qkg + 64, sample, 1.0f, HB, HBP, 1024 + 64 * wc, sample ? nullptr : newk, 256, 64 * wc, rcos, rsin);
        else              plain_tile(acc, u.pm, wr, wc, fr, fq, HB, HBP, 1280, sample ? nullptr : newv, 256, 0);
    }
};

struct GroupOrder {
    int nM, nN, nwg, G, c, pm0, nbig, skip, ksplit, wgm;
    __device__ void init(int pm0_, int nM_, int N, int G_, int c_, int nbig_, int skip_, int ksplit_ = 1, int wgm_ = WGM) { pm0 = pm0_; nM = nM_; nN = N / BM; nwg = nM * nN; G = G_; c = c_; nbig = nbig_; skip = skip_; ksplit = ksplit_; wgm = wgm_; }
    __device__ bool next(int i, Unit& u) const {
        int L;
        if (c < nbig) L = skip * (256 - nbig) + i * 256 + c;
        else if (i < skip) L = i * (256 - nbig) + (c - nbig);
        else L = skip * (256 - nbig) + (i - skip) * 256 + c;
        if (L >= nwg * ksplit) return false;
        const int kh = L >= nwg ? 1 : 0, t = L - kh * nwg, xcd = t & 7, off = t >> 3;
        u.kh = kh; u.pm = pm0 + xcd * wgm + (off & (wgm - 1)); u.pn = wgm == 8 ? (off >> 3) : (off >> 1); return true;
    }
    __device__ __forceinline__ void a_ready(const Unit&) const {}
    __device__ __forceinline__ void done(const Unit&) const {}
};

template <class Epi, class Sched, bool ALIGN_EPI = false, bool SP2 = false>
__device__ __forceinline__ void gemm_phase(PG8_LAS unsigned char* lds, const Gemm g, const Sched& S, const Epi& E) {
    const int tid = opaque_tid(), wid = __builtin_amdgcn_readfirstlane(tid >> 6), lane = tid & 63, wr = wid >> 2, wc = wid & 3, fr = lane & 15, fq = lane >> 4;
    const int K = g.K, nt = g.KL / BK; const size_t khstep = (size_t)g.KL * 2;
    unsigned voffA[2], voffB[2];
#pragma unroll
    for (int i = 0; i < 2; ++i) { int R, C; stage_rc(tid * 16 + i * 8192, R, C); const int Rb = Epi::PERM ? ((R & ~31) + perm32(R & 31)) : R;
        voffA[i] = (unsigned)(R * K + C) * 2u; voffB[i] = (unsigned)(Rb * K + C) * 2u; }
    const size_t kstep = (size_t)(BK * 2);
    const size_t hstep = (size_t)HALF * K * 2;
    const size_t tstep = 2 * hstep;
    const unsigned ldsw = (unsigned)wid * 1024u;
    const int aoff = lds_byte(wr * 64 + fr, fq * 8), boff = lds_byte(wc * 32 + fr, fq * 8);
#define PG8_SA(b, h) (((b) * 2 + (h)) * HTB)
#define PG8_SB(b, h) ((4 + (b) * 2 + (h)) * HTB)
#define PG8_STAGE(bufoff, gbase, voff) do { _Pragma("unroll") for (int _i = 0; _i < 2; ++_i) \
        __builtin_amdgcn_global_load_lds((const unsigned*)((const char*)(gbase) + (voff)[_i]), (PG8_LAS unsigned*)(lds + (bufoff) + ldsw + _i * 8192), 16, 0, 0); } while (0)
#define PG8_LDA(dst, b, h) do { _Pragma("unroll") for (int m = 0; m < 4; ++m) _Pragma("unroll") for (int k = 0; k < 2; ++k) dst[m][k] = *(const PG8_LAS bf16x8*)(lds + PG8_SA(b, h) + aoff + m * 2048 + k * 1024); } while (0)
#define PG8_LDB(dst, b, h) do { _Pragma("unroll") for (int n = 0; n < 2; ++n) _Pragma("unroll") for (int k = 0; k < 2; ++k) dst[n][k] = *(const PG8_LAS bf16x8*)(lds + PG8_SB(b, h) + boff + n * 2048 + k * 1024); } while (0)
#define PG8_MMA(ai, bj, At, Bt) do { __builtin_amdgcn_s_setprio(1); _Pragma("unroll") for (int m = 0; m < 4; ++m) _Pragma("unroll") for (int n = 0; n < 2; ++n) _Pragma("unroll") for (int k = 0; k < 2; ++k) \
        acc[ai][bj][m][n] = __builtin_amdgcn_mfma_f32_16x16x32_bf16(Bt[n][k], At[m][k], acc[ai][bj][m][n], 0, 0, 0); __builtin_amdgcn_s_setprio(0); } while (0)
#define PG8_WAIT_V(n) asm volatile("s_waitcnt vmcnt(" #n ")" ::: "memory")
#define PG8_WAIT_L(n) asm volatile("s_waitcnt lgkmcnt(" #n ")" ::: "memory")
#define PG8_BAR __builtin_amdgcn_s_barrier()
#define PG8_SCHED __builtin_amdgcn_sched_barrier(0)
    Unit cur, nxt; int ui = 0;
    if (!S.next(0, cur)) return;
    f32x4 acc[2][2][4][2];
#pragma unroll
    for (int a = 0; a < 2; ++a)
#pragma unroll
        for (int b = 0; b < 2; ++b)
#pragma unroll
            for (int m = 0; m < 4; ++m)
#pragma unroll
                for (int n = 0; n < 2; ++n) acc[a][b][m][n] = (f32x4){0.f, 0.f, 0.f, 0.f};
    bf16x8 At[4][2], B0[2][2], B1[2][2];
    const char* cA = (const char*)g.A + (size_t)cur.pm * tstep + (size_t)cur.kh * khstep; const char* cB = (const char*)g.Bt + (size_t)cur.pn * tstep + (size_t)cur.kh * khstep;
    S.a_ready(cur);
    if constexpr (SP2) {
        PG8_STAGE(PG8_SB(0, 0), cB, voffB); PG8_STAGE(PG8_SB(0, 1), cB + hstep, voffB); PG8_STAGE(PG8_SA(0, 0), cA, voffA); PG8_STAGE(PG8_SA(0, 1), cA + hstep, voffA);
        if (wr == 1) PG8_BAR;
        PG8_WAIT_V(2); PG8_BAR;
        PG8_STAGE(PG8_SB(1, 0), cB + kstep, voffB); PG8_STAGE(PG8_SA(1, 0), cA + kstep, voffA); PG8_STAGE(PG8_SB(1, 1), cB + hstep + kstep, voffB);
        PG8_WAIT_V(6); PG8_BAR;
    } else {
        PG8_STAGE(PG8_SB(0, 0), cB, voffB); PG8_STAGE(PG8_SA(0, 0), cA, voffA); PG8_STAGE(PG8_SB(0, 1), cB + hstep, voffB); PG8_STAGE(PG8_SA(0, 1), cA + hstep, voffA);
        if (wr == 1) PG8_BAR;
        PG8_WAIT_V(4); PG8_BAR;
        PG8_STAGE(PG8_SB(1, 0), cB + kstep, voffB); PG8_STAGE(PG8_SA(1, 0), cA + kstep, voffA); PG8_STAGE(PG8_SB(1, 1), cB + hstep + kstep, voffB);
        PG8_WAIT_V(6); PG8_BAR;
    }
    for (;;) {
        const bool has_next = S.next(ui + 1, nxt);
        const char* nA = has_next ? (const char*)g.A + (size_t)nxt.pm * tstep + (size_t)nxt.kh * khstep : cA; const char* nB = has_next ? (const char*)g.Bt + (size_t)nxt.pn * tstep + (size_t)nxt.kh * khstep : cB;
        for (int t = 0; t < nt; t += 2) {
            const bool last = (t == nt - 2);
            const char* a1 = cA + (size_t)(t + 1) * kstep;
            const char* a2 = last ? nA : cA + (size_t)(t + 2) * kstep; const char* b2 = last ? nB : cB + (size_t)(t + 2) * kstep;
            const char* a3 = a2 + kstep; const char* b3 = b2 + kstep;
            if (last && has_next) S.a_ready(nxt);
            if constexpr (SP2) {
            PG8_LDB(B0, 0, 0); PG8_LDB(B1, 0, 1); PG8_SCHED; PG8_LDA(At, 0, 0); PG8_STAGE(PG8_SA(1, 1), a1 + hstep, voffA);
            PG8_WAIT_V(8); PG8_WAIT_L(0); PG8_BAR; PG8_MMA(0, 0, At, B0); PG8_MMA(0, 1, At, B1); PG8_BAR; PG8_SCHED;
            PG8_LDA(At, 0, 1); PG8_STAGE(PG8_SB(0, 0), b2, voffB); PG8_STAGE(PG8_SB(0, 1), b2 + hstep, voffB); PG8_STAGE(PG8_SA(0, 0), a2, voffA);
            PG8_WAIT_V(8); PG8_WAIT_L(0); PG8_BAR; PG8_MMA(1, 0, At, B0); PG8_MMA(1, 1, At, B1); PG8_BAR; PG8_SCHED;
            PG8_LDB(B0, 1, 0); PG8_LDB(B1, 1, 1); PG8_SCHED; PG8_LDA(At, 1, 0); PG8_STAGE(PG8_SA(0, 1), a2 + hstep, voffA);
            PG8_WAIT_V(8); PG8_WAIT_L(0); PG8_BAR; PG8_MMA(0, 0, At, B0); PG8_MMA(0, 1, At, B1); PG8_BAR; PG8_SCHED;
            PG8_LDA(At, 1, 1); PG8_STAGE(PG8_SB(1, 0), b3, voffB); PG8_STAGE(PG8_SB(1, 1), b3 + hstep, voffB); PG8_STAGE(PG8_SA(1, 0), a3, voffA);
            PG8_WAIT_V(8); PG8_WAIT_L(0); PG8_BAR; PG8_MMA(1, 0, At, B0); PG8_MMA(1, 1, At, B1); PG8_BAR; PG8_SCHED;
            } else {
            PG8_LDB(B0, 0, 0); PG8_SCHED; PG8_LDA(At, 0, 0); PG8_STAGE(PG8_SA(1, 1), a1 + hstep, voffA);
            PG8_WAIT_L(8); PG8_BAR; PG8_WAIT_L(0); PG8_MMA(0, 0, At, B0); PG8_BAR; PG8_SCHED;
            PG8_LDB(B1, 0, 1); PG8_STAGE(PG8_SB(0, 0), b2, voffB);
            PG8_BAR; PG8_WAIT_L(0); PG8_MMA(0, 1, At, B1); PG8_BAR;
            PG8_LDA(At, 0, 1); PG8_STAGE(PG8_SA(0, 0), a2, voffA);
            PG8_BAR; PG8_WAIT_L(0); PG8_MMA(1, 0, At, B0); PG8_BAR; PG8_SCHED;
            PG8_STAGE(PG8_SB(0, 1), b2 + hstep, voffB);
            PG8_WAIT_V(6); PG8_BAR; PG8_MMA(1, 1, At, B1); PG8_BAR;
            PG8_LDB(B0, 1, 0); PG8_SCHED; PG8_LDA(At, 1, 0); PG8_STAGE(PG8_SA(0, 1), a2 + hstep, voffA);
            PG8_WAIT_L(8); PG8_BAR; PG8_WAIT_L(0); PG8_MMA(0, 0, At, B0); PG8_BAR; PG8_SCHED;
            PG8_LDB(B1, 1, 1); PG8_STAGE(PG8_SB(1, 0), b3, voffB);
            PG8_BAR; PG8_WAIT_L(0); PG8_MMA(0, 1, At, B1); PG8_BAR;
            PG8_LDA(At, 1, 1); PG8_STAGE(PG8_SA(1, 0), a3, voffA);
            PG8_BAR; PG8_WAIT_L(0); PG8_MMA(1, 0, At, B0); PG8_BAR; PG8_SCHED;
            PG8_STAGE(PG8_SB(1, 1), b3 + hstep, voffB);
            PG8_WAIT_V(6); PG8_BAR; PG8_MMA(1, 1, At, B1); PG8_BAR;
            }
        }
        if constexpr (ALIGN_EPI) { if (wr == 0) PG8_BAR; }
        if constexpr (!Epi::AFTER_DRAIN) { E(acc, cur, wr, wc, fr, fq); S.done(cur); }
        if (!has_next) break;
#pragma unroll
        for (int a = 0; a < 2; ++a)
#pragma unroll
            for (int b = 0; b < 2; ++b)
#pragma unroll
                for (int m = 0; m < 4; ++m)
#pragma unroll
                    for (int n = 0; n < 2; ++n) acc[a][b][m][n] = (f32x4){0.f, 0.f, 0.f, 0.f};
        cur = nxt; cA = nA; cB = nB; ++ui;
        if constexpr (ALIGN_EPI) { if (wr == 1) PG8_BAR; }
    }
    PG8_WAIT_V(0);
    if constexpr (!ALIGN_EPI) { if (wr == 0) PG8_BAR; }
    PG8_BAR;
    if constexpr (Epi::AFTER_DRAIN) { E.fused(acc, cur, wr, wc, fr, fq, lds, wid, lane); S.done(cur); }
#undef PG8_SA
#undef PG8_SB
#undef PG8_STAGE
#undef PG8_LDA
#undef PG8_LDB
#undef PG8_MMA
#undef PG8_WAIT_V
#undef PG8_WAIT_L
#undef PG8_BAR
#undef PG8_SCHED
}
}

namespace att {
typedef unsigned short bf16_t;
typedef short bf16x8 __attribute__((ext_vector_type(8)));
typedef short s16x4 __attribute__((ext_vector_type(4)));
typedef short v4i16_t __attribute__((ext_vector_type(4)));
typedef float f32x16 __attribute__((ext_vector_type(16)));
typedef float f32x4 __attribute__((ext_vector_type(4)));
typedef unsigned u32x4 __attribute__((ext_vector_type(4)));
typedef unsigned u32x2 __attribute__((ext_vector_type(2)));
#define ATT_LAS __attribute__((address_space(3)))
__device__ __forceinline__ int crow(int r, int hi) { return (r & 3) + 8 * (r >> 2) + 4 * hi; }
typedef float f32x2_t __attribute__((ext_vector_type(2))); typedef __bf16 bf16x2_t __attribute__((ext_vector_type(2)));
__device__ __forceinline__ unsigned cvtpk(float lo, float hi) { f32x2_t v = {lo, hi}; bf16x2_t b = __builtin_convertvector(v, bf16x2_t); return __builtin_bit_cast(unsigned, b); }
__device__ __forceinline__ s16x4 vtr(const ATT_LAS unsigned char* p) { return __builtin_bit_cast(s16x4, __builtin_amdgcn_ds_read_tr16_b64_v4i16((ATT_LAS v4i16_t*)p)); }
__device__ __forceinline__ float max3f(float a, float b, float c) { float r; asm("v_max3_f32 %0, %1, %2, %3" : "=v"(r) : "v"(a), "v"(b), "v"(c)); return r; }
constexpr float THR = 6.0f;
constexpr float NEG_BIG = -1.0e30f;

struct KvStream {
    const bf16_t *Kc, *Vc, *Kb, *Vb; int ncache, nown, kp, kpc;
};

template <int KW, int DV>
__device__ __forceinline__ float attn_core(ATT_LAS unsigned char* lds, ATT_LAS float* wsf, const bf16_t* Qw, int qpitch, int kslice, const KvStream& S,
                                           bool masked, int qpos, int kpos0, float m_init, float l_init, f32x16 (&o)[DV / 32]) {
    constexpr int KB = 64 * KW * 2, VB = 64 * DV * 2, TB = KB + VB, NKC = KW / 64, NVC = DV / 64;
    const int tid = pg8::opaque_tid(), lane = tid & 63, r32 = lane & 31, hi = lane >> 5;
    static_assert(KW == DV, "K and V tiles share one staging map");
    int skey[NKC], scol[NKC], kdoff[NKC], vdoff[NVC];
#pragma unroll
    for (int q = 0; q < NKC; ++q) { const int L = q * 512 + tid, cw = L >> 8, key = (L & 255) >> 2, c4 = L & 3; skey[q] = key; scol[q] = cw * 32 + c4 * 8; kdoff[q] = cw * 4096 + key * 64 + ((c4 ^ ((key >> 2) & 3)) << 4); vdoff[q] = KB + cw * 4096 + key * 64 + (c4 << 4); }
    int kaoff[4];
#pragma unroll
    for (int d0 = 0; d0 < 4; ++d0) kaoff[d0] = (kslice * 2 + (d0 >> 1)) * 4096 + r32 * 64 + (((((d0 & 1) << 1) | hi) ^ ((r32 >> 2) & 3)) << 4);
    const int vb0 = KB + ((lane >> 4) & 1) * 32 + (lane & 3) * 8 + (4 * hi + ((lane & 15) >> 2)) * 64;
    bf16x8 qr[4];
#pragma unroll
    for (int d0 = 0; d0 < 4; ++d0) qr[d0] = *(const bf16x8*)(Qw + (size_t)r32 * qpitch + d0 * 16 + hi * 8);
#pragma unroll
    for (int d = 0; d < DV / 32; ++d) o[d] = f32x16{};
    const bool nosink = !(m_init > -1.0e37f);
    float mhat = nosink ? 0.0f : m_init, l = l_init;
    f32x16 negm;
#pragma unroll
    for (int r = 0; r < 16; ++r) negm[r] = -mhat;
    const int NT = S.ncache + S.nown;
    u32x4 kreg[NKC], vreg[NVC];
    const int half = __builtin_amdgcn_readfirstlane(tid >> 8);
#define ATT_LOAD(tn) do { const bool cch_ = (tn) < S.ncache; const int pt_ = cch_ ? S.kpc : S.kp; \
        const bf16_t* ks_ = cch_ ? S.Kc + (size_t)(tn) * 64 * pt_ : S.Kb + (size_t)((tn) - S.ncache) * 64 * pt_; \
        const bf16_t* vs_ = cch_ ? S.Vc + (size_t)(tn) * 64 * pt_ : S.Vb + (size_t)((tn) - S.ncache) * 64 * pt_; \
        _Pragma("unroll") for (int q = 0; q < NKC; ++q) { kreg[q] = *(const u32x4*)(ks_ + skey[q] * pt_ + scol[q]); vreg[q] = *(const u32x4*)(vs_ + skey[q] * pt_ + scol[q]); } } while (0)
#define ATT_WRITE(tn) do { ATT_LAS unsigned char* wb_ = lds + ((tn) & 1) * TB; \
        _Pragma("unroll") for (int q = 0; q < NKC; ++q) *(ATT_LAS u32x4*)(wb_ + kdoff[q]) = kreg[q]; \
        _Pragma("unroll") for (int q = 0; q < NVC; ++q) *(ATT_LAS u32x4*)(wb_ + vdoff[q]) = vreg[q]; } while (0)
#define ATT_STAGE(t) do { if ((t) + 1 < NT) { ATT_WRITE((t) + 1); if ((t) + 2 < NT) ATT_LOAD((t) + 2); } } while (0)
    ATT_LOAD(0);
    ATT_WRITE(0);
    if (NT > 1) ATT_LOAD(1);
    __syncthreads();
    if (half == 1) __syncthreads();
    for (int t = 0; t < NT; ++t) {
        ATT_LAS unsigned char* buf = lds + (t & 1) * TB;
        if (half == 1) ATT_STAGE(t);
        __builtin_amdgcn_s_setprio(1);
        f32x16 p0 = negm, p1 = negm;
        {   bf16x8 kf[8];
#pragma unroll
            for (int d0 = 0; d0 < 4; ++d0) { kf[2 * d0] = *(const ATT_LAS bf16x8*)(buf + kaoff[d0]); kf[2 * d0 + 1] = *(const ATT_LAS bf16x8*)(buf + kaoff[d0] + 2048); }
            __builtin_amdgcn_sched_barrier(0);
#pragma unroll
            for (int d0 = 0; d0 < 4; ++d0) {
                p0 = __builtin_amdgcn_mfma_f32_32x32x16_bf16(kf[2 * d0], qr[d0], p0, 0, 0, 0);
                p1 = __builtin_amdgcn_mfma_f32_32x32x16_bf16(kf[2 * d0 + 1], qr[d0], p1, 0, 0, 0);
            }
        }
        asm volatile("s_nop 15\n\ts_nop 7" : "+v"(p0), "+v"(p1));
        if (masked && t >= S.ncache) {
            const int kb = kpos0 + (t - S.ncache) * 64, qlo = qpos - r32;
            if (kb + 63 - qlo > 128 || qlo + 31 - kb > 128) {
#pragma unroll
                for (int r = 0; r < 16; ++r) { const int k0 = kb + crow(r, hi); int dd = qpos - k0; if (dd < 0) dd = -dd; if (dd > 128) p0[r] = NEG_BIG; dd = qpos - (k0 + 32); if (dd < 0) dd = -dd; if (dd > 128) p1[r] = NEG_BIG; }
            }
        }
        float rm;
        {   float ma = max3f(p0[0], p0[1], p1[0]), mb = max3f(p0[2], p0[3], p1[1]); ma = max3f(ma, p1[2], p1[3]);
#pragma unroll
            for (int r = 4; r < 16; r += 4) { ma = max3f(ma, p0[r], p0[r + 1]); mb = max3f(mb, p0[r + 2], p0[r + 3]); ma = max3f(ma, p1[r], p1[r + 1]); mb = max3f(mb, p1[r + 2], p1[r + 3]); }
            rm = max3f(ma, mb, mb);
            auto rr = __builtin_amdgcn_permlane32_swap(__float_as_uint(rm), __float_as_uint(rm), false, false); rm = max3f(__uint_as_float(rr[0]), __uint_as_float(rr[1]), __uint_as_float(rr[1])); }
        if (__any(rm > THR) || (nosink && t == 0)) {
            const float dl = (nosink && t == 0) ? rm : fmaxf(rm, 0.0f);
            const float f = (nosink && t == 0) ? 0.0f : __builtin_amdgcn_exp2f(-dl);
            l *= f; mhat += dl;
#pragma unroll
            for (int r = 0; r < 16; ++r) { p0[r] -= dl; p1[r] -= dl; negm[r] = -mhat; }
            if (hi == 0) wsf[r32] = f;
#pragma unroll
            for (int r = 0; r < 16; ++r) { const float fr_ = wsf[crow(r, hi)];
#pragma unroll
                for (int d = 0; d < DV / 32; ++d) o[d][r] *= fr_; }
        }
        float ls = 0.f;
#pragma unroll
        for (int r = 0; r < 16; ++r) { p0[r] = __builtin_amdgcn_exp2f(p0[r]); p1[r] = __builtin_amdgcn_exp2f(p1[r]); ls += p0[r] + p1[r]; }
        l += ls;
        bf16x8 pa[4];
        { u32x4 w;
          w.x = cvtpk(p0[0], p0[1]); w.y = cvtpk(p0[2], p0[3]); w.z = cvtpk(p0[4], p0[5]); w.w = cvtpk(p0[6], p0[7]); pa[0] = __builtin_bit_cast(bf16x8, w);
          w.x = cvtpk(p0[8], p0[9]); w.y = cvtpk(p0[10], p0[11]); w.z = cvtpk(p0[12], p0[13]); w.w = cvtpk(p0[14], p0[15]); pa[1] = __builtin_bit_cast(bf16x8, w);
          w.x = cvtpk(p1[0], p1[1]); w.y = cvtpk(p1[2], p1[3]); w.z = cvtpk(p1[4], p1[5]); w.w = cvtpk(p1[6], p1[7]); pa[2] = __builtin_bit_cast(bf16x8, w);
          w.x = cvtpk(p1[8], p1[9]); w.y = cvtpk(p1[10], p1[11]); w.z = cvtpk(p1[12], p1[13]); w.w = cvtpk(p1[14], p1[15]); pa[3] = __builtin_bit_cast(bf16x8, w); }
        __builtin_amdgcn_s_setprio(0);
        __syncthreads();
        if (half == 0) ATT_STAGE(t);
#pragma unroll
        for (int g = 0; g < DV / 64; ++g) {
            s16x4 lo[8], hh[8];
#pragma unroll
            for (int i = 0; i < 8; ++i) { const int d = 2 * g + (i >> 2), ks = i & 3; lo[i] = vtr(buf + vb0 + d * 4096 + ks * 1024); hh[i] = vtr(buf + vb0 + d * 4096 + ks * 1024 + 512); }
            __builtin_amdgcn_sched_barrier(0);
#pragma unroll
            for (int i = 0; i < 8; ++i) { const int d = 2 * g + (i >> 2), ks = i & 3;
                const bf16x8 vf = (bf16x8){lo[i][0], lo[i][1], lo[i][2], lo[i][3], hh[i][0], hh[i][1], hh[i][2], hh[i][3]};
                o[d] = __builtin_amdgcn_mfma_f32_32x32x16_bf16(pa[ks], vf, o[d], 0, 0, 0); }
        }
        __syncthreads();
    }
    if (half == 0) __syncthreads();
#undef ATT_LOAD
#undef ATT_WRITE
#undef ATT_STAGE
    { auto rr = __builtin_amdgcn_permlane32_swap(__float_as_uint(l), __float_as_uint(l), false, false); l = __uint_as_float(rr[0]) + __uint_as_float(rr[1]); }
    return l;
}

__device__ __forceinline__ void row_recips(ATT_LAS float* wsf, float l, int r32, int hi, float (&rli)[16]) {
    if (hi == 0) wsf[32 + r32] = l;
#pragma unroll
    for (int r = 0; r < 16; ++r) rli[r] = 1.0f / wsf[32 + crow(r, hi)];
}

constexpr int ODD_KV = 2 * (64 + 64) * 64 * 2;
constexpr int ODD_WSF = ODD_KV, ODD_STG = ODD_WSF + 8 * 256;
__device__ __forceinline__ void odd_unit(ATT_LAS unsigned char* lds, const bf16_t* HB, const bf16_t* CK, const bf16_t* CV, bf16_t* O, const float* sink,
                                         bool sample, int b, int g, int qb) {
    const int tid = pg8::opaque_tid(), lane = tid & 63, r32 = lane & 31, hi = lane >> 5; const int wid = __builtin_amdgcn_readfirstlane(tid >> 6);
    const int head = 4 * g + (wid >> 1);
    const int rowbase = sample ? 4096 + b * 2048 : b * 256;
    const int q0 = qb * 64 + 32 * (wid & 1);
    KvStream S; S.kp = 2816; S.kpc = 256;
    int kpos0 = 0;
    if (sample) { const int ts = qb - 2 < 0 ? 0 : qb - 2, te = qb + 3 > 32 ? 32 : qb + 3; kpos0 = ts * 64;
        S.Kc = CK + (size_t)b * 512 * 256 + g * 64; S.Vc = CV + (size_t)b * 512 * 256 + g * 64; S.ncache = 8;
        S.Kb = HB + (size_t)(rowbase + kpos0) * 2816 + 1024 + g * 64; S.Vb = HB + (size_t)(rowbase + kpos0) * 2816 + 1280 + g * 64; S.nown = te - ts; }
    else { S.Kc = nullptr; S.Vc = nullptr; S.ncache = 0; S.Kb = HB + (size_t)rowbase * 2816 + 1024 + g * 64; S.Vb = HB + (size_t)rowbase * 2816 + 1280 + g * 64; S.nown = 4; }
    ATT_LAS float* wsf = (ATT_LAS float*)(lds + ODD_WSF) + wid * 64;
    f32x16 o[2];
    const float l = attn_core<64, 64>(lds, wsf, HB + (size_t)(rowbase + q0) * 2816 + head * 64, 2816, 0, S, sample, q0 + r32, kpos0, sink[head] * 1.4426950408889634f, hi == 0 ? 1.0f : 0.0f, o);
    float rli[16]; row_recips(wsf, l, r32, hi, rli);
    ATT_LAS bf16_t* stg = (ATT_LAS bf16_t*)(lds + ODD_STG) + wid * 2048;
#pragma unroll
    for (int r = 0; r < 16; ++r) { const int orow = crow(r, hi);
#pragma unroll
        for (int d = 0; d < 2; ++d) { const float v = o[d][r] * rli[r]; stg[orow * 64 + d * 32 + r32] = (bf16_t)(cvtpk(v, v) & 0xffffu); } }
    bf16_t* Ow = O + (size_t)(rowbase + q0) * 1024 + head * 64;
#pragma unroll
    for (int i = 0; i < 4; ++i) { const int row = i * 8 + (lane >> 3), ch = lane & 7; const u32x4 v = *(const ATT_LAS u32x4*)(stg + row * 64 + ch * 8); *(u32x4*)(Ow + (size_t)row * 1024 + ch * 8) = v; }
    __syncthreads();
}

constexpr int EVEN_KV = 2 * (128 + 128) * 64 * 2;
constexpr int EVEN_WSF = 72 * 1024;
constexpr int EVEN_SROW = 136;
__device__ __forceinline__ void even_unit(ATT_LAS unsigned char* lds, const bf16_t* HB, const bf16_t* CK, const bf16_t* CV, bf16_t* O, const float* subln, float lam, float post,
                                          bool sample, int b, int h, int qb) {
    const int tid = pg8::opaque_tid(), lane = tid & 63, r32 = lane & 31, hi = lane >> 5; const int wid = __builtin_amdgcn_readfirstlane(tid >> 6);
    const int mp = wid >> 2, wq = wid & 3;
    const int rowbase = sample ? 4096 + b * 2048 : b * 256;
    const int q0 = qb * 128 + 32 * wq;
    KvStream S; S.kp = 2816; S.kpc = 512;
    if (sample) { S.Kc = CK + (size_t)b * 512 * 512 + h * 128; S.Vc = CV + (size_t)b * 512 * 512 + h * 128; S.ncache = 8; S.nown = 32; }
    else { S.Kc = nullptr; S.Vc = nullptr; S.ncache = 0; S.nown = 4; }
    S.Kb = HB + (size_t)rowbase * 2816 + 512 + h * 128; S.Vb = HB + (size_t)rowbase * 2816 + 1024 + h * 128;
    ATT_LAS float* wsf = (ATT_LAS float*)(lds + EVEN_WSF) + wid * 64;
    f32x16 o[4];
    const float l = attn_core<128, 128>(lds, wsf, HB + (size_t)(rowbase + q0) * 2816 + h * 128 + mp * 64, 2816, mp, S, false, 0, 0, -INFINITY, 0.0f, o);
    float rli[16]; row_recips(wsf, l, r32, hi, rli);
    ATT_LAS float* stage = (ATT_LAS float*)lds;
    __syncthreads();
    if (mp == 1) {
#pragma unroll
        for (int r = 0; r < 16; ++r) { const int row = 32 * wq + crow(r, hi);
#pragma unroll
            for (int d = 0; d < 4; ++d) stage[row * EVEN_SROW + d * 32 + r32] = o[d][r] * rli[r]; }
    }
    __syncthreads();
    if (mp == 0) {
#pragma unroll
        for (int r = 0; r < 16; ++r) { const int row = 32 * wq + crow(r, hi);
#pragma unroll
            for (int d = 0; d < 4; ++d) { ATT_LAS float* p = stage + row * EVEN_SROW + d * 32 + r32; *p = o[d][r] * rli[r] - lam * (*p); } }
        const int row = 32 * wq + (lane >> 1), half = lane & 1;
        const ATT_LAS float* rp = stage + row * EVEN_SROW + half * 4;
        float ss = 0.f;
#pragma unroll
        for (int i = 0; i < 16; ++i) { const f32x4 v = *(const ATT_LAS f32x4*)(rp + i * 8); ss += (v[0] * v[0] + v[1] * v[1]) + (v[2] * v[2] + v[3] * v[3]); }
        ss += __shfl_xor(ss, 1);
        const float rs = post / sqrtf(ss * (1.0f / 128.0f) + 1e-6f);
        bf16_t* Ow = O + (size_t)(rowbase + qb * 128 + row) * 1024 + h * 128 + half * 4;
#pragma unroll
        for (int i = 0; i < 16; ++i) { const f32x4 v = *(const ATT_LAS f32x4*)(rp + i * 8); const f32x4 gsub = *(const f32x4*)(subln + half * 4 + i * 8);
            u32x2 w; w.x = cvtpk(v[0] * rs * gsub[0], v[1] * rs * gsub[1]); w.y = cvtpk(v[2] * rs * gsub[2], v[3] * rs * gsub[3]); *(u32x2*)(Ow + i * 8) = w; }
    }
    __syncthreads();
}
#undef ATT_LAS
}

#define GAS __attribute__((address_space(1)))
#define LAS __attribute__((address_space(3)))
typedef unsigned short bf16;
typedef unsigned v4u __attribute__((ext_vector_type(4)));
typedef float f32x4 __attribute__((ext_vector_type(4)));
typedef short bf16x8 __attribute__((ext_vector_type(8)));
typedef GAS unsigned gu32;
typedef GAS unsigned long long gu64;
#define RLX_AGENT __ATOMIC_RELAXED, __HIP_MEMORY_SCOPE_AGENT
#define LDS_WAIT() asm volatile("s_waitcnt lgkmcnt(0)" ::: "memory")
#define VM_WAIT() asm volatile("s_waitcnt vmcnt(0)" ::: "memory")
__device__ __forceinline__ unsigned long long rt() { return __builtin_amdgcn_s_memrealtime(); }
__device__ __forceinline__ unsigned f2bf(float f) { unsigned u = __builtin_bit_cast(unsigned, f); return (u + 0x7fffu + ((u >> 16) & 1u)) >> 16; }
__device__ __forceinline__ unsigned pk2(float lo, float hi) { return f2bf(lo) | (f2bf(hi) << 16); }

#define XB_TMO      128
#define XB_XCNT(j)  (256  + 64 * (j))
#define XB_XSUB(j)  (1280 + 64 * (j))
#define XB_XGEN(j)  (2304 + 64 * (j))
#define XB_TOP      3328
#define XB_TOPGEN   3392
#define XCD_BAR_WORDS 3456
#define XB_SPIN_CAP (1u << 18)

__device__ __forceinline__ unsigned xb_ld(unsigned* p)              { return __hip_atomic_load(p, __ATOMIC_RELAXED, __HIP_MEMORY_SCOPE_AGENT); }
__device__ __forceinline__ unsigned xb_add(unsigned* p, unsigned v) { return __hip_atomic_fetch_add(p, v, __ATOMIC_RELAXED, __HIP_MEMORY_SCOPE_AGENT); }
__device__ __forceinline__ unsigned xb_xcc_id() { return (unsigned)__builtin_amdgcn_s_getreg((3 << 11) | 20) & 0xFu; }
#define XB_SPIN(cond, bar) do { unsigned _sp = 0; while (cond) { __builtin_amdgcn_s_sleep(1); \
    if ((++_sp & 255u) == 0u) { if (xb_ld(&(bar)[XB_TMO])) break; if (_sp > XB_SPIN_CAP) { atomicAdd(&(bar)[XB_TMO], 1u); break; } } } } while (0)

struct XcdBarrier {
    unsigned* bar; unsigned x;
    volatile LAS unsigned* st;
    unsigned total;
};

__device__ __forceinline__ XcdBarrier xcd_barrier_post(unsigned* bar, volatile LAS unsigned* st, unsigned total) {
    XcdBarrier b; b.bar = bar; b.x = xb_xcc_id(); b.st = st; b.total = total;
    if (threadIdx.x == 0) (void)xb_add(&bar[XB_XCNT(b.x)], 1u);
    return b;
}
__device__ __forceinline__ void xcd_barrier_complete(unsigned* bar, unsigned x, unsigned& nloc, unsigned& nx, unsigned G) {
    unsigned sum, cnt, mine, sp = 0u;
    for (;;) {
        sum = 0u; cnt = 0u; mine = 0u;
#pragma unroll
        for (unsigned j = 0; j < 16; ++j) { const unsigned c = xb_ld(&bar[XB_XCNT(j)]); sum += c; cnt += (c > 0u) ? 1u : 0u; mine = (j == x) ? c : mine; }
        if (sum == G) break;
        __builtin_amdgcn_s_sleep(1);
        if ((++sp & 255u) == 0u) { if (xb_ld(&bar[XB_TMO])) break; if (sp > XB_SPIN_CAP) { atomicAdd(&bar[XB_TMO], 1u); break; } }
    }
    nloc = mine > 0u ? mine : 1u; nx = cnt > 0u ? cnt : 1u;
}

__device__ __forceinline__ void xcd_barrier(const XcdBarrier& b) {
    asm volatile("s_waitcnt vmcnt(0)" ::: "memory");
    __syncthreads();
    if (threadIdx.x == 0) {
        unsigned* bar = b.bar;
        __builtin_amdgcn_s_waitcnt(0);
        unsigned nloc = b.st[0], nx = b.st[1];
        if (nloc == 0u) { xcd_barrier_complete(bar, b.x, nloc, nx, b.total); b.st[0] = nloc; b.st[1] = nx; }
        const unsigned old = xb_add(&bar[XB_XSUB(b.x)], 1u);
        const unsigned gen = old / nloc;
        if (nx == 1u) {
            XB_SPIN(xb_ld(&bar[XB_XSUB(b.x)]) < (gen + 1u) * nloc, bar);
            __builtin_amdgcn_fence(__ATOMIC_ACQUIRE, "agent");
            asm volatile("s_waitcnt vmcnt(0)" ::: "memory");
        } else
        if (old + 1u == (gen + 1u) * nloc) {
          if (nx == 1u) {
            __builtin_amdgcn_fence(__ATOMIC_ACQUIRE, "agent");
            xb_add(&bar[XB_XGEN(b.x)], 1u);
            asm volatile("s_waitcnt vmcnt(0)" ::: "memory");
          } else {
            __builtin_amdgcn_fence(__ATOMIC_RELEASE, "agent");
            asm volatile("s_waitcnt vmcnt(0)" ::: "memory");
            const unsigned og = xb_add(&bar[XB_TOP], 1u);
            const unsigned tg = og / nx;
            if (og + 1u == (tg + 1u) * nx) xb_add(&bar[XB_TOPGEN], 1u);
            else XB_SPIN(xb_ld(&bar[XB_TOPGEN]) == tg, bar);
            __builtin_amdgcn_fence(__ATOMIC_ACQUIRE, "agent");
            xb_add(&bar[XB_XGEN(b.x)], 1u);
            asm volatile("s_waitcnt vmcnt(0)" ::: "memory");
          }
        } else {
            XB_SPIN(xb_ld(&bar[XB_XGEN(b.x)]) == gen, bar);
            __builtin_amdgcn_fence(__ATOMIC_ACQUIRE, "agent");
            asm volatile("s_waitcnt vmcnt(0)" ::: "memory");
        }
    }
    __syncthreads();
}

__device__ __forceinline__ float wave_sum(float v) {
    v += __builtin_bit_cast(float, __builtin_amdgcn_update_dpp(0, __builtin_bit_cast(int, v), 0xB1, 0xF, 0xF, true));
    v += __builtin_bit_cast(float, __builtin_amdgcn_update_dpp(0, __builtin_bit_cast(int, v), 0x4E, 0xF, 0xF, true));
    v += __builtin_bit_cast(float, __builtin_amdgcn_update_dpp(0, __builtin_bit_cast(int, v), 0x141, 0xF, 0xF, true));
    v += __builtin_bit_cast(float, __builtin_amdgcn_update_dpp(0, __builtin_bit_cast(int, v), 0x140, 0xF, 0xF, true));
    { auto a = __builtin_amdgcn_permlane16_swap(__float_as_uint(v), __float_as_uint(v), false, false); v = __uint_as_float(a[0]) + __uint_as_float(a[1]); }
    { auto b = __builtin_amdgcn_permlane32_swap(__float_as_uint(v), __float_as_uint(v), false, false); v = __uint_as_float(b[0]) + __uint_as_float(b[1]); }
    return v;
}

constexpr int NWAVES = 8;
constexpr int DM = 1024, DFF = 2816, NPROMPT = 4096, NSAMPLE = 16384, MT = NPROMPT + NSAMPLE;
constexpr int N_PHASES = 22;
#ifndef MK_PER_PHASE
#define MK_PER_PHASE 0
#endif

constexpr size_t MiB = 1u << 20;
constexpr size_t WS_CTL = 0, CTL_ZERO_BYTES = 256 * 1024;
constexpr size_t WS_MOD = 1 * MiB;
constexpr size_t WS_W13 = 2 * MiB;
constexpr size_t WS_W2 = 46 * MiB;
constexpr size_t WS_EWIN = 68 * MiB, WS_EWOUT = 74 * MiB, WS_OWIN = 76 * MiB, WS_OWOUT = 79 * MiB;
constexpr size_t WS_CEK = 81 * MiB, WS_CEV = 85 * MiB, WS_COK = 89 * MiB, WS_COV = 91 * MiB;
constexpr size_t WS_XN = 96 * MiB;
constexpr size_t WS_OB = WS_XN;
constexpr size_t WS_DA = 136 * MiB, WS_DB = 286 * MiB;
constexpr size_t WS_HB = 176 * MiB;
constexpr size_t WS_END = 326 * MiB;
constexpr size_t QKV_SLAB = (size_t)MT * 512 * 2;
constexpr size_t OUT_YP = 0, OUT_YS = 4194304, OUT_EK = 20971520, OUT_EV = 23068672, OUT_OK = 25165824, OUT_OV = 26214400, OUT_TOTAL = 27262976;
constexpr int CW_BAR = 4096;

constexpr int RING_BYTES = 131072;
constexpr int LDSCTL_OFF = 139264, MISC_OFF = LDSCTL_OFF + 320;
constexpr int LDS_BYTES = 147456;

struct Frame {
    LAS unsigned char* lds;
    int tid, lane, wave, vcu, G;
};

__device__ __forceinline__ void p0_transpose_item(const float* W, int K, int N, bf16* WT, int k0, int n0, int drow_lo, int drow_hi, LAS float* scr, int lane) {
    const int lr = lane >> 4, lc = (lane & 15) * 4;
    const float* src = W + (size_t)(k0 + lr) * N + n0 + lc;
#pragma unroll
    for (int h = 0; h < 2; ++h) {
        f32x4 v[8];
#pragma unroll
        for (int i = 0; i < 8; ++i) v[i] = __builtin_nontemporal_load((const f32x4*)(src + (size_t)(4 * (8 * h + i)) * N));
#pragma unroll
        for (int i = 0; i < 8; ++i) { LAS float* d = scr + (4 * (8 * h + i) + lr) * 65 + lc; d[0] = v[i][0]; d[1] = v[i][1]; d[2] = v[i][2]; d[3] = v[i][3]; }
    }
    LDS_WAIT(); asm volatile("" ::: "memory");
    const int c = lane & 7;
#pragma unroll
    for (int j = 0; j < 8; ++j) { const int n = (lane >> 3) + 8 * j; const LAS float* s = scr + (8 * c) * 65 + n;
        v4u o; o.x = pk2(s[0 * 65], s[1 * 65]); o.y = pk2(s[2 * 65], s[3 * 65]); o.z = pk2(s[4 * 65], s[5 * 65]); o.w = pk2(s[6 * 65], s[7 * 65]);
        const int dr = (n < 32 ? drow_lo : drow_hi) + (n & 31);
        *(GAS v4u*)(WT + (size_t)dr * K + k0 + 8 * c) = o; }
    LDS_WAIT(); asm volatile("" ::: "memory");
}
__device__ __forceinline__ int drow_swiglu(int n0) { const bool up = n0 >= DFF; const int c = up ? n0 - DFF : n0; return 256 * (c >> 7) + (up ? 128 : 0) + (c & 127); }
__device__ __forceinline__ int drow_heads(int n0) { const int pn = n0 >> 8, x = n0 & 255, wc = x >> 6, bj = (x & 63) >> 5; return 256 * pn + 128 * bj + 32 * wc; }
__device__ __forceinline__ int drow_even_in(int n0) {
    if (n0 < 1024) return drow_heads(n0);
    if (n0 < 2048) return n0;
    if (n0 < 2560) { const int c = n0 - 2048; return 2048 + 256 * (c >> 7) + (c & 127); }
    const int c = n0 - 2560; return 2048 + 256 * (c >> 7) + 128 + (c & 127);
}
__device__ __forceinline__ int drow_odd_in(int n0) { return n0 < 1280 ? drow_heads(n0) : n0; }

struct Ptrs {
    const float *x_prompt, *x_sample, *cek, *cev, *cok, *cov, *c, *c_ctx, *w_mod, *b_mod, *norm_g, *w13, *w2, *ewin, *ewout, *eqk, *elam, *esub, *econv, *owin, *owout, *oqk, *osink;
    float* out; unsigned char* ws;
};

__device__ __forceinline__ void cvt_cache(const Frame& F, const float* src, unsigned char* dst, size_t n8) {
    const size_t gt = (size_t)F.vcu * (NWAVES * 64) + F.tid, NGT = (size_t)F.G * NWAVES * 64;
    for (size_t i = gt; i < n8; i += NGT) { const f32x4 v0 = __builtin_nontemporal_load((const f32x4*)(src + i * 8)), v1 = __builtin_nontemporal_load((const f32x4*)(src + i * 8 + 4));
        v4u o; o.x = pk2(v0[0], v0[1]); o.y = pk2(v0[2], v0[3]); o.z = pk2(v1[0], v1[1]); o.w = pk2(v1[2], v1[3]); *(v4u*)(dst + i * 16) = o; }
}
__device__ __forceinline__ void p0_prologue(const Frame& F0, const Ptrs& P) {
    Frame F = F0; F.tid = pg8::opaque_tid(); F.lane = F.tid & 63;
    {   LAS float* sil = (LAS float*)F.lds;
        LAS float* red = (LAS float*)(F.lds + 40960);
        bool have_sil = false;
        for (int item = blockIdx.x; item < 2 * 144; item += F.G) {
            if (!have_sil) {
                for (int i = F.tid; i < 9 * 1024; i += NWAVES * 64) { const int cnd = i >> 10, k = i & 1023; const float v = cnd < 8 ? P.c[cnd * 1024 + k] : P.c_ctx[k]; sil[i] = v / (1.0f + expf(-v)); }
                __syncthreads(); have_sil = true;
            }
            const int l = item / 144, cb = item % 144;
            const int lg = F.lane >> 4, l16 = F.lane & 15;
            const float* wp = P.w_mod + (size_t)l * 1024 * 9216 + cb * 64 + l16 * 4;
            f32x4 a[9];
#pragma unroll
            for (int cnd = 0; cnd < 9; ++cnd) a[cnd] = (f32x4){0.f, 0.f, 0.f, 0.f};
#pragma unroll 4
            for (int i = 0; i < 32; ++i) { const int k = F.wave * 4 + lg + 32 * i; const f32x4 wv = __builtin_nontemporal_load((const f32x4*)(wp + (size_t)k * 9216));
#pragma unroll
                for (int cnd = 0; cnd < 9; ++cnd) a[cnd] += wv * sil[cnd * 1024 + k]; }
#pragma unroll
            for (int cnd = 0; cnd < 9; ++cnd)
#pragma unroll
                for (int e = 0; e < 4; ++e) { float v = a[cnd][e]; v += __shfl_xor(v, 16); v += __shfl_xor(v, 32); a[cnd][e] = v; }
            if (lg == 0) {
#pragma unroll
                for (int cnd = 0; cnd < 9; ++cnd) *(LAS f32x4*)(red + (F.wave * 9 + cnd) * 64 + l16 * 4) = a[cnd];
            }
            __syncthreads();
            for (int i = F.tid; i < 9 * 64; i += NWAVES * 64) { const int cnd = i >> 6, col = i & 63; float s = 0.f;
#pragma unroll
                for (int w = 0; w < 8; ++w) s += red[(w * 9 + cnd) * 64 + col];
                ((float*)(P.ws + WS_MOD))[(size_t)(l * 9 + cnd) * 9216 + cb * 64 + col] = s + P.b_mod[l * 9216 + cb * 64 + col]; }
            __syncthreads();
        }
        __syncthreads();
    }
    LAS float* scr = (LAS float*)(F.lds + F.wave * 16640);
    const int gw = F.vcu * NWAVES + F.wave, NGW = F.G * NWAVES;
    constexpr int I_W13 = 16 * 88, I_W2 = 44 * 16, I_EIN = 16 * 48, I_SQ = 16 * 16, I_OIN = 16 * 24;
    constexpr int NITEMS = 4 * I_W13 + 4 * I_W2 + I_EIN + I_SQ + I_OIN + I_SQ;
    unsigned* const tick = (unsigned*)(P.ws + WS_CTL) + 1024 + 64 * ((int)blockIdx.x & 7);
    (void)gw; (void)NGW;
    auto ticket_item = [&](unsigned k) -> int { return (int)((k >> 8) * 2048u + ((unsigned)blockIdx.x & 7u) * 256u + (k & 255u)); };
    unsigned tn = 0; if (F.lane == 0) tn = __hip_atomic_fetch_add(tick, 1u, __ATOMIC_RELAXED, __HIP_MEMORY_SCOPE_AGENT);
    for (int it = ticket_item(__builtin_amdgcn_readfirstlane(tn)); it < NITEMS; it = ticket_item(__builtin_amdgcn_readfirstlane(tn))) {
        if (F.lane == 0) tn = __hip_atomic_fetch_add(tick, 1u, __ATOMIC_RELAXED, __HIP_MEMORY_SCOPE_AGENT);
        int r = it;
        if (r < 4 * I_W13) { const int mi = r / I_W13, q = r % I_W13, kb = q / 88, nb = q % 88;
            p0_transpose_item(P.w13 + (size_t)mi * 1024 * 5632, 1024, 5632, (bf16*)(P.ws + WS_W13) + (size_t)mi * 5632 * 1024, 64 * kb, 64 * nb, drow_swiglu(64 * nb), drow_swiglu(64 * nb + 32), scr, F.lane); continue; }
        r -= 4 * I_W13;
        if (r < 4 * I_W2) { const int mi = r / I_W2, q = r % I_W2, kb = q / 16, nb = q % 16;
            p0_transpose_item(P.w2 + (size_t)mi * 2816 * 1024, 2816, 1024, (bf16*)(P.ws + WS_W2) + (size_t)mi * 1024 * 2816, 64 * kb, 64 * nb, 64 * nb, 64 * nb + 32, scr, F.lane); continue; }
        r -= 4 * I_W2;
        if (r < I_EIN) { const int kb = r / 48, nb = r % 48; p0_transpose_item(P.ewin, 1024, 3072, (bf16*)(P.ws + WS_EWIN), 64 * kb, 64 * nb, drow_even_in(64 * nb), drow_even_in(64 * nb + 32), scr, F.lane); continue; }
        r -= I_EIN;
        if (r < I_SQ) { const int kb = r / 16, nb = r % 16; p0_transpose_item(P.ewout, 1024, 1024, (bf16*)(P.ws + WS_EWOUT), 64 * kb, 64 * nb, 64 * nb, 64 * nb + 32, scr, F.lane); continue; }
        r -= I_SQ;
        if (r < I_OIN) { const int kb = r / 24, nb = r % 24; p0_transpose_item(P.owin, 1024, 1536, (bf16*)(P.ws + WS_OWIN), 64 * kb, 64 * nb, drow_odd_in(64 * nb), drow_odd_in(64 * nb + 32), scr, F.lane); continue; }
        r -= I_OIN;
        { const int kb = r / 16, nb = r % 16; p0_transpose_item(P.owout, 1024, 1024, (bf16*)(P.ws + WS_OWOUT), 64 * kb, 64 * nb, 64 * nb, 64 * nb + 32, scr, F.lane); }
    }
    cvt_cache(F, P.cek, P.ws + WS_CEK, 2097152 / 8); cvt_cache(F, P.cev, P.ws + WS_CEV, 2097152 / 8);
    cvt_cache(F, P.cok, P.ws + WS_COK, 1048576 / 8); cvt_cache(F, P.cov, P.ws + WS_COV, 1048576 / 8);
}

__device__ __forceinline__ void norm_rows(const Frame& F0, const float* xP, const float* xS, const float* g, const float* mod  , int jshift, bf16* XN, int row0, int row1, int pidx, int pcount, int npend, const bf16* pd0, const bf16* pd1, float* xwb = nullptr, const bf16* xb16 = nullptr, bf16* xwb16 = nullptr) {
    Frame F = F0; F.tid = pg8::opaque_tid(); F.lane = F.tid & 63;
    if (pidx < 0) return;
    const int gw = pidx * NWAVES + F.wave, NGW = pcount * NWAVES;
    const int per = (row1 - row0 + NGW - 1) / NGW;
    int r0 = row0 + gw * per, r1 = r0 + per; if (r1 > row1) r1 = row1;
    int cur_cond = -1; f32x4 gs[4], sh[4];
    f32x4 nvA[4], nvB[4]; unsigned long long ndA0[4], ndA1[4], ndB0[4], ndB1[4];
#define NORM_LOAD(nv, nd0, nd1, rw) do { const float* xr_ = (rw) < NPROMPT ? xP + (size_t)(rw) * DM : xS + (size_t)((rw) - NPROMPT) * DM; \
        _Pragma("unroll") for (int j = 0; j < 4; ++j) { \
            if (xb16) { const unsigned long long q_ = *(const unsigned long long*)(xb16 + (size_t)(rw) * DM + 4 * F.lane + 256 * j); nv[j][0] = __builtin_bit_cast(float, (unsigned)q_); nv[j][1] = __builtin_bit_cast(float, (unsigned)(q_ >> 32)); } \
            else nv[j] = *(const f32x4*)(xr_ + 4 * F.lane + 256 * j); \
            if (npend > 0) nd0[j] = *(const unsigned long long*)(pd0 + (size_t)(rw) * DM + 4 * F.lane + 256 * j); \
            if (npend > 1) nd1[j] = *(const unsigned long long*)(pd1 + (size_t)(rw) * DM + 4 * F.lane + 256 * j); } } while (0)
#define NORM_ROW(nv, nd0, nd1, row) do { \
        const int cond = (row) < NPROMPT ? 8 : (((row) - NPROMPT) >> 11); \
        if (cond != cur_cond) { cur_cond = cond; const float* mp = mod + (size_t)cond * 9216; \
            _Pragma("unroll") for (int j = 0; j < 4; ++j) { const int col = 4 * F.lane + 256 * j; const f32x4 gg = *(const f32x4*)(g + col), sc = *(const f32x4*)(mp + (jshift + 1) * 1024 + col); sh[j] = *(const f32x4*)(mp + jshift * 1024 + col); gs[j] = gg * (sc + 1.0f); } } \
        f32x4 v[4]; float s = 0.f; \
        _Pragma("unroll") for (int j = 0; j < 4; ++j) { v[j] = nv[j]; \
            if (xb16) { const float f0_ = nv[j][0], f1_ = nv[j][1]; const unsigned lo = __builtin_bit_cast(unsigned, f0_), hi = __builtin_bit_cast(unsigned, f1_);     \
                v[j] = (f32x4){__builtin_bit_cast(float, lo << 16), __builtin_bit_cast(float, lo & 0xffff0000u), __builtin_bit_cast(float, hi << 16), __builtin_bit_cast(float, hi & 0xffff0000u)}; } \
            if (npend > 0) { const unsigned lo = (unsigned)nd0[j], hi = (unsigned)(nd0[j] >> 32); \
                v[j] += (f32x4){__builtin_bit_cast(float, lo << 16), __builtin_bit_cast(float, lo & 0xffff0000u), __builtin_bit_cast(float, hi << 16), __builtin_bit_cast(float, hi & 0xffff0000u)}; } \
            if (npend > 1) { const unsigned lo = (unsigned)nd1[j], hi = (unsigned)(nd1[j] >> 32); \
                v[j] += (f32x4){__builtin_bit_cast(float, lo << 16), __builtin_bit_cast(float, lo & 0xffff0000u), __builtin_bit_cast(float, hi << 16), __builtin_bit_cast(float, hi & 0xffff0000u)}; } \
            s += (v[j][0] * v[j][0] + v[j][1] * v[j][1]) + (v[j][2] * v[j][2] + v[j][3] * v[j][3]); } \
        if ((row) + 2 < r1) NORM_LOAD(nv, nd0, nd1, (row) + 2); \
        if (xwb) { \
            _Pragma("unroll") for (int j = 0; j < 4; ++j) *(f32x4*)(xwb + (size_t)(row) * DM + 4 * F.lane + 256 * j) = v[j]; } \
        if (xwb16) { \
            _Pragma("unroll") for (int j = 0; j < 4; ++j) *(unsigned long long*)(xwb16 + (size_t)(row) * DM + 4 * F.lane + 256 * j) = (unsigned long long)pk2(v[j][0], v[j][1]) | ((unsigned long long)pk2(v[j][2], v[j][3]) << 32); } \
        const float rstd = 1.0f / sqrtf(wave_sum(s) * (1.0f / DM) + 1e-6f); \
        _Pragma("unroll") for (int j = 0; j < 4; ++j) { const f32x4 y = v[j] * rstd * gs[j] + sh[j]; \
            *(unsigned long long*)(XN + (size_t)(row) * DM + 4 * F.lane + 256 * j) = (unsigned long long)pk2(y[0], y[1]) | ((unsigned long long)pk2(y[2], y[3]) << 32); } } while (0)
    if (r0 < r1) NORM_LOAD(nvA, ndA0, ndA1, r0);
    if (r0 + 1 < r1) NORM_LOAD(nvB, ndB0, ndB1, r0 + 1);
    for (int row = r0; row < r1; row += 2) {
        NORM_ROW(nvA, ndA0, ndA1, row);
        if (row + 1 < r1) NORM_ROW(nvB, ndB0, ndB1, row + 1);
    }
#undef NORM_ROW
#undef NORM_LOAD
}

__device__ __forceinline__ void norm_rows_b(const Frame& F0, const bf16* xb16, const float* g, const float* mod, int jshift, bf16* XN, int row0, int row1, int pidx, int pcount, int npend, const bf16* pd0, const bf16* pd1, float* xwb, bf16* xwb16) {
    Frame F = F0; F.tid = pg8::opaque_tid(); F.lane = F.tid & 63;
    if (pidx < 0) return;
    const int gw = pidx * NWAVES + F.wave, NGW = pcount * NWAVES;
    const int per = (row1 - row0 + NGW - 1) / NGW;
    int r0 = row0 + gw * per, r1 = r0 + per; if (r1 > row1) r1 = row1;
    int cur_cond = -1; f32x4 gs[4], sh[4];
    unsigned long long xA[4], xB[4], xC[4], xD[4], aA[4], aB[4], aC[4], aD[4], bA[4], bB[4], bC[4], bD[4];
#define NB_LOAD(xx, aa, bb, rw) do { \
        _Pragma("unroll") for (int j = 0; j < 4; ++j) { const size_t o_ = (size_t)(rw) * DM + 4 * F.lane + 256 * j; \
            xx[j] = *(const unsigned long long*)(xb16 + o_); \
            if (npend > 0) aa[j] = *(const unsigned long long*)(pd0 + o_); \
            if (npend > 1) bb[j] = *(const unsigned long long*)(pd1 + o_); } } while (0)
#define NB_X4(q) ((f32x4){__builtin_bit_cast(float, (unsigned)(q) << 16), __builtin_bit_cast(float, (unsigned)(q) & 0xffff0000u), __builtin_bit_cast(float, (unsigned)((q) >> 32) << 16), __builtin_bit_cast(float, (unsigned)((q) >> 32) & 0xffff0000u)})
#define NB_ROW(xx, aa, bb, row) do { \
        const int cond = (row) < NPROMPT ? 8 : (((row) - NPROMPT) >> 11); \
        if (cond != cur_cond) { cur_cond = cond; const float* mp = mod + (size_t)cond * 9216; \
            _Pragma("unroll") for (int j = 0; j < 4; ++j) { const int col = 4 * F.lane + 256 * j; const f32x4 gg = *(const f32x4*)(g + col), sc = *(const f32x4*)(mp + (jshift + 1) * 1024 + col); sh[j] = *(const f32x4*)(mp + jshift * 1024 + col); gs[j] = gg * (sc + 1.0f); } } \
        f32x4 v[4]; float s = 0.f; \
        _Pragma("unroll") for (int j = 0; j < 4; ++j) { v[j] = NB_X4(xx[j]); \
            if (npend > 0) v[j] += NB_X4(aa[j]); \
            if (npend > 1) v[j] += NB_X4(bb[j]); \
            s += (v[j][0] * v[j][0] + v[j][1] * v[j][1]) + (v[j][2] * v[j][2] + v[j][3] * v[j][3]); } \
        if ((row) + 4 < r1) NB_LOAD(xx, aa, bb, (row) + 4); \
        if (xwb) { \
            _Pragma("unroll") for (int j = 0; j < 4; ++j) *(f32x4*)(xwb + (size_t)(row) * DM + 4 * F.lane + 256 * j) = v[j]; } \
        if (xwb16) { \
            _Pragma("unroll") for (int j = 0; j < 4; ++j) *(unsigned long long*)(xwb16 + (size_t)(row) * DM + 4 * F.lane + 256 * j) = (unsigned long long)pk2(v[j][0], v[j][1]) | ((unsigned long long)pk2(v[j][2], v[j][3]) << 32); } \
        const float rstd = 1.0f / sqrtf(wave_sum(s) * (1.0f / DM) + 1e-6f); \
        _Pragma("unroll") for (int j = 0; j < 4; ++j) { const f32x4 y = v[j] * rstd * gs[j] + sh[j]; \
            *(unsigned long long*)(XN + (size_t)(row) * DM + 4 * F.lane + 256 * j) = (unsigned long long)pk2(y[0], y[1]) | ((unsigned long long)pk2(y[2], y[3]) << 32); } } while (0)
    if (r0 < r1) NB_LOAD(xA, aA, bA, r0);
    if (r0 + 1 < r1) NB_LOAD(xB, aB, bB, r0 + 1);
    if (r0 + 2 < r1) NB_LOAD(xC, aC, bC, r0 + 2);
    if (r0 + 3 < r1) NB_LOAD(xD, aD, bD, r0 + 3);
    for (int row = r0; row < r1; row += 4) {
        NB_ROW(xA, aA, bA, row);
        if (row + 1 < r1) NB_ROW(xB, aB, bB, row + 1);
        if (row + 2 < r1) NB_ROW(xC, aC, bC, row + 2);
        if (row + 3 < r1) NB_ROW(xD, aD, bD, row + 3);
    }
#undef NB_ROW
#undef NB_X4
#undef NB_LOAD
}

__device__ __forceinline__ float bf2f(unsigned short b) { return __builtin_bit_cast(float, (unsigned)b << 16); }
__device__ __forceinline__ void conv_rows(const Frame& F0, const bf16* HB, const float* cw, bf16* OB, int row0, int row1, int pidx, int pcount) {
    Frame F = F0; F.tid = pg8::opaque_tid(); F.lane = F.tid & 63;
    if (pidx < 0) return;
    const int gw = pidx * NWAVES + F.wave, NGW = pcount * NWAVES;
    const int per = (row1 - row0 + NGW - 1) / NGW;
    int r0 = row0 + gw * per, r1 = r0 + per; if (r1 > row1) r1 = row1;
    if (r0 >= r1) return;
    const int c0 = 8 * F.lane;
    f32x4 w0[2], w1[2], w2[2];
#pragma unroll
    for (int h = 0; h < 2; ++h) { w0[h] = *(const f32x4*)(cw + c0 + 4 * h); w1[h] = *(const f32x4*)(cw + 512 + c0 + 4 * h); w2[h] = *(const f32x4*)(cw + 1024 + c0 + 4 * h); }
    const v4u zero = (v4u){0u, 0u, 0u, 0u};
    const bf16* ub = HB + 2048 + c0; const bf16* gb = HB + 1536 + c0;
    v4u um = r0 > 0 ? *(const v4u*)(ub + (size_t)(r0 - 1) * 2816) : zero;
    v4u uc = *(const v4u*)(ub + (size_t)r0 * 2816);
    v4u un = r0 + 1 < MT ? *(const v4u*)(ub + (size_t)(r0 + 1) * 2816) : zero;
    v4u bgc = *(const v4u*)(gb + (size_t)r0 * 2816);
    for (int row = r0; row < r1; ++row) {
        const int t = row < NPROMPT ? (row & 255) : ((row - NPROMPT) & 2047), len = row < NPROMPT ? 256 : 2048;
        const v4u ua = (row + 1 < r1 && row + 2 < MT) ? *(const v4u*)(ub + (size_t)(row + 2) * 2816) : zero;
        const v4u bgn = row + 1 < r1 ? *(const v4u*)(gb + (size_t)(row + 1) * 2816) : zero;
        const v4u up = t > 0 ? um : zero, ux = t < len - 1 ? un : zero;
        float y[8];
#pragma unroll
        for (int e = 0; e < 8; ++e) { const int wi = e >> 1, sft = (e & 1) * 16;
            const float a = bf2f((unsigned short)(up[wi] >> sft)), b = bf2f((unsigned short)(uc[wi] >> sft)), c = bf2f((unsigned short)(ux[wi] >> sft)), gte = bf2f((unsigned short)(bgc[wi] >> sft));
            y[e] = gte * (w0[e >> 2][e & 3] * a + w1[e >> 2][e & 3] * b + w2[e >> 2][e & 3] * c); }
        v4u o; o.x = pk2(y[0], y[1]); o.y = pk2(y[2], y[3]); o.z = pk2(y[4], y[5]); o.w = pk2(y[6], y[7]);
        *(v4u*)(OB + (size_t)row * DM + 512 + c0) = o;
        um = uc; uc = un; un = ua; bgc = bgn;
    }
}

__device__ __forceinline__ void dec_arrive(unsigned* cnt) {
    asm volatile("s_waitcnt vmcnt(0)" ::: "memory");
    __syncthreads();
    if (threadIdx.x == 0) (void)__hip_atomic_fetch_add(cnt, 1u, __ATOMIC_RELAXED, __HIP_MEMORY_SCOPE_AGENT);
}
__device__ __forceinline__ void dec_wait2(unsigned* cnt, unsigned target, unsigned* cnt2, unsigned target2, unsigned* tmo, volatile LAS unsigned* flag) {
    if (threadIdx.x == 0) {
        XB_SPIN(xb_ld(cnt) < target, tmo);
        *flag = (xb_ld(cnt2) >= target2) ? 1u : 0u;
        __builtin_amdgcn_fence(__ATOMIC_ACQUIRE, "agent");
        asm volatile("s_waitcnt vmcnt(0)" ::: "memory");
    }
    __syncthreads();
}
__device__ __forceinline__ void dec_wait(unsigned* cnt, unsigned target, unsigned* tmo) {
    if (threadIdx.x == 0) {
        XB_SPIN(xb_ld(cnt) < target, tmo);
        __builtin_amdgcn_fence(__ATOMIC_ACQUIRE, "agent");
        asm volatile("s_waitcnt vmcnt(0)" ::: "memory");
    }
    __syncthreads();
}

struct Args { const float* in[23]; float* out; unsigned char* ws; int ph_lo, ph_hi; };
__global__ void __launch_bounds__(NWAVES * 64, 2) mega_fwd(Args args) {
    extern __shared__ __attribute__((aligned(16))) unsigned char lds_raw[];
    Frame F;
    F.lds = (LAS unsigned char*)lds_raw;
    volatile LAS unsigned* MISC = (volatile LAS unsigned*)(F.lds + MISC_OFF);
    F.tid = threadIdx.x; F.lane = F.tid & 63; F.wave = __builtin_amdgcn_readfirstlane(F.tid >> 6);
    F.G = gridDim.x; { const int bx = blockIdx.x; F.vcu = (F.G % 8 == 0) ? (bx % 8) * (F.G / 8) + bx / 8 : bx; }
    typedef const __attribute__((address_space(4))) Args* KArgs;
    const KArgs KA0 = (KArgs)__builtin_amdgcn_kernarg_segment_ptr();
    unsigned char* ws = KA0->ws;
    for (int u = F.tid; u < (LDS_BYTES - LDSCTL_OFF) / 4; u += NWAVES * 64) ((LAS unsigned*)(F.lds + LDSCTL_OFF))[u] = 0u;
    __syncthreads();
    XcdBarrier bar; bar.bar = (unsigned*)(ws + WS_CTL) + CW_BAR; bar.x = 0; bar.st = nullptr;
    if (!MK_PER_PHASE) bar = xcd_barrier_post((unsigned*)(ws + WS_CTL) + CW_BAR, MISC + 8, gridDim.x);
    constexpr bool sliced = !MK_PER_PHASE;
    const int sx = (int)blockIdx.x & 7, sj = (int)blockIdx.x >> 3;
    XcdBarrier gbar = bar;
    if (sliced) gbar = xcd_barrier_post((unsigned*)(ws + WS_CTL) + 16384 + sx * 4096, MISC + 12, gridDim.x / 8);

    const float* MODP = (const float*)(ws + WS_MOD);
    bf16* XN = (bf16*)(ws + WS_XN); bf16* OB = (bf16*)(ws + WS_OB); bf16* HB = (bf16*)(ws + WS_HB);
    float* xout = KA0->out;

    const int ph_lo = KA0->ph_lo, ph_hi = KA0->ph_hi;
    for (int ph = ph_lo; ph < ph_hi; ++ph) {
      if (ph == 0) {
        KArgs ka = KA0; asm volatile("" : "+s"(ka));
        Ptrs P;
        P.x_prompt = ka->in[0]; P.x_sample = ka->in[1]; P.cek = ka->in[2]; P.cev = ka->in[3]; P.cok = ka->in[4]; P.cov = ka->in[5]; P.c = ka->in[6]; P.c_ctx = ka->in[7];
        P.w_mod = ka->in[8]; P.b_mod = ka->in[9]; P.norm_g = ka->in[10]; P.w13 = ka->in[11]; P.w2 = ka->in[12]; P.ewin = ka->in[13]; P.ewout = ka->in[14]; P.eqk = ka->in[15];
        P.elam = ka->in[16]; P.esub = ka->in[17]; P.econv = ka->in[18]; P.owin = ka->in[19]; P.owout = ka->in[20]; P.oqk = ka->in[21]; P.osink = ka->in[22];
        P.out = ka->out; P.ws = ka->ws;
        p0_prologue(F, P);
      } else {
        const int opS = ph - 2, opP = ph - 1;
        const bool validS = opS >= 0 && opS < 20, validP = opP >= 0 && opP <= 20;
        const int kS = validS ? opS % 10 : -1, kP = validP ? (opP == 20 ? 10 : opP % 10) : -1;
        const bool odd_ = ((blockIdx.x >> 3) & 1) != 0;
        const bool pfirst = (!(kS == 2 || kS == 6 || kS == 9) || (odd_ && kP >= 0 && (kP == 0 || kP == 3 || kP == 7 || kP == 10))) && !(odd_ && kP >= 0 && (kS == 0 || kS == 3 || kS == 7));
        const bool dec = sliced && ph >= 2 && gbar.st[1] == 1u;
        unsigned* const cntP = gbar.bar + 3520; unsigned* const cntS = gbar.bar + 3584;
        for (int slot = 0; slot < 2; ++slot) {
            const bool isP = (slot == 0) == pfirst;
            if (isP ? !validP : !validS) continue;
            if (dec && ph >= 3) {
                if (slot == 0) dec_wait2(isP ? cntP : cntS, 32u * (unsigned)(ph - 2), isP ? cntS : cntP, 32u * (unsigned)(ph - 2), gbar.bar, MISC + 14);
                else if (MISC[14] == 0u) dec_wait(isP ? cntP : cntS, 32u * (unsigned)(ph - 2), gbar.bar);
            }
            KArgs ka = KA0; asm volatile("" : "+s"(ka));
            Ptrs P;
            P.x_prompt = ka->in[0]; P.x_sample = ka->in[1]; P.cek = ka->in[2]; P.cev = ka->in[3]; P.cok = ka->in[4]; P.cov = ka->in[5]; P.c = ka->in[6]; P.c_ctx = ka->in[7];
            P.w_mod = ka->in[8]; P.b_mod = ka->in[9]; P.norm_g = ka->in[10]; P.w13 = ka->in[11]; P.w2 = ka->in[12]; P.ewin = ka->in[13]; P.ewout = ka->in[14]; P.eqk = ka->in[15];
            P.elam = ka->in[16]; P.esub = ka->in[17]; P.econv = ka->in[18]; P.owin = ka->in[19]; P.owout = ka->in[20]; P.oqk = ka->in[21]; P.osink = ka->in[22];
            P.out = ka->out; P.ws = ka->ws;
            const int op = isP ? opP : opS, l = op / 10, s = op % 10, ko = isP ? kS : kP;
            const int pm0 = isP ? 0 : 16, nM = isP ? 16 : 64, row0 = isP ? 0 : NPROMPT, row1 = isP ? NPROMPT : MT;
            const float* modl = MODP + (size_t)l * 9 * 9216;
            const bool fromin = op <= 3;
            const float* xP = fromin ? P.x_prompt : xout; const float* xS = fromin ? P.x_sample : xout + (size_t)NPROMPT * DM;
            bf16* const ysb = (bf16*)(xout + (size_t)NPROMPT * DM) - (size_t)NPROMPT * DM;
            const bf16* DA = isP ? (const bf16*)(ws + WS_DA) : ysb; const bf16* DB = isP ? (const bf16*)(ws + WS_DB) : ysb + (size_t)NSAMPLE * DM;
            bf16* const XB = isP ? (bf16*)(ws + WS_DB + 8 * MiB) : (bf16*)(ws + WS_DA);
            int npend = 0; const bf16 *pd0 = DA, *pd1 = DA;
            if (isP) { npend = (op > 0 && (s == 0 || s == 3 || s == 7)) ? 2 : 0; pd0 = DA; pd1 = DB; }
            else if (s <= 3) { if (l >= 1) { pd0 = DB; npend = 1; } if (s >= 3) { if (npend) pd1 = DA; else pd0 = DA; ++npend; } }
            else if (s == 7) { pd0 = DA; npend = 1; }
            if (isP && op == 20) {
                norm_rows_b(F, XB, P.norm_g, MODP, 0, XN, 0, NPROMPT, F.vcu, F.G, 2, DA, DB, xout, nullptr);
            } else if (s == 0 || s == 3 || s == 7) {
                const int sub = s == 0 ? 0 : (s == 3 ? 1 : 2);
                int pidx = F.vcu, pcount = F.G;
                int ra = row0, rb = row1;
                if (!isP) {
                    ra = row0 + 2048 * sx; rb = ra + 2048; pidx = sj; pcount = 32;
                    if (ko == 1 || ko == 8) { pidx = sj - 12; pcount = 20; }
                    else if (ko == 4 && l == 0) { if (sj < 24) { ra += sj * 48; rb = ra + 48; } else { ra += 1152 + (sj - 24) * 112; rb = ra + 112; } pidx = 0; pcount = 1; }
                    else if (ko == 4) { pidx = sj - 12; pcount = 20; }
                }
                if (!fromin) norm_rows_b(F, XB, P.norm_g + (size_t)(l * 3 + sub) * DM, modl, 3 * sub, XN, ra, rb, pidx, pcount, npend, pd0, pd1, nullptr, (isP ? npend > 0 : (s == 3 || s == 7)) ? XB : nullptr);
                else norm_rows(F, xP, xS, P.norm_g + (size_t)(l * 3 + sub) * DM, modl, 3 * sub, XN, ra, rb, pidx, pcount, npend, pd0, pd1, nullptr, nullptr, (isP ? npend > 0 : (s == 3 || s == 7)) ? XB : nullptr);
            } else if (s == 1 || s == 8) {
                const int fi = l * 2 + (s == 8 ? 1 : 0);
                pg8::Gemm g{XN, (const bf16*)(ws + WS_W13) + (size_t)fi * 5632 * 1024, MT, 2 * DFF, DM, DM};
                const bool bigother = !isP && (ko == 2 || ko == 9);
                pg8::GroupOrder S; S.init(pm0, nM, 2 * DFF, 256, (int)blockIdx.x, bigother ? 128 : 0, bigother ? 1 : 0, 1, isP ? 2 : pg8::WGM);
                pg8::EpiSwiGLU E{HB, DFF};
                pg8::gemm_phase<pg8::EpiSwiGLU, pg8::GroupOrder, true, true>(F.lds, g, S, E);
            } else if (s == 2 || s == 9 || s == 6) {
                pg8::Gemm g; const float* gate; int hg, defer; bf16* dout = (bf16*)DA;
                if (s == 6) { g = pg8::Gemm{OB, (const bf16*)(ws + (l == 0 ? WS_EWOUT : WS_OWOUT)), MT, DM, DM, DM}; gate = modl + 5 * 1024; hg = 0; defer = 1; }
                else { const int fi = l * 2 + (s == 9 ? 1 : 0); g = pg8::Gemm{HB, (const bf16*)(ws + WS_W2) + (size_t)fi * 1024 * 2816, MT, DM, DFF, DFF}; gate = modl + (s == 2 ? 2 : 8) * 1024; hg = 1;
                       defer = (s == 2 || l == 0) ? 1 : 0; if (s == 9) dout = (bf16*)DB; }
                int ksplit = 1;
                if (isP) { defer = 1; dout = (bf16*)(ws + WS_DA); npend = 0;
                    if (defer) { ksplit = 2; g.KL = g.K / 2; } }
                pg8::GroupOrder S; S.init(pm0, nM, DM, 256, (int)blockIdx.x, 0, 0, ksplit, isP ? 2 : pg8::WGM);
                if (!defer) {
                    { pg8::EpiResidB<false, true> E{nullptr, XB, nullptr, xout, gate, hg, npend, pd0, pd1}; pg8::gemm_phase<pg8::EpiResidB<false, true>, pg8::GroupOrder, true, true>(F.lds, g, S, E); }
                } else {
                    pg8::EpiResid E{gate, hg, dout, (bf16*)(ws + WS_DB)};
                    pg8::gemm_phase<pg8::EpiResid, pg8::GroupOrder, true, true>(F.lds, g, S, E);
                }
            } else if (s == 4) {
                if (l == 0) {
                    pg8::Gemm g{XN, (const bf16*)(ws + WS_EWIN), MT, 3072, DM, DM};
                    pg8::GroupOrder S; S.init(pm0, nM, 3072, 256, (int)blockIdx.x, 0, 0, 1, isP ? 2 : pg8::WGM);
                    pg8::EpiQKVEven E{HB, P.out + OUT_EK, P.out + OUT_EV, P.eqk, ROPE_COS, ROPE_SIN};
                    pg8::gemm_phase<pg8::EpiQKVEven, pg8::GroupOrder, true, true>(F.lds, g, S, E);
                } else {
                    pg8::Gemm g{XN, (const bf16*)(ws + WS_OWIN), MT, 1536, DM, DM};
                    pg8::GroupOrder S; S.init(pm0, nM, 1536, 256, (int)blockIdx.x, 0, 0, 1, isP ? 2 : pg8::WGM);
                    pg8::EpiQKVOdd E{HB, P.out + OUT_OK, P.out + OUT_OV, P.oqk, ROPE_COS, ROPE_SIN};
                    pg8::gemm_phase<pg8::EpiQKVOdd, pg8::GroupOrder, true, true>(F.lds, g, S, E);
                }
            } else {
                if (l == 0) {
                    const float a = wave_sum(P.elam[F.lane] * P.elam[64 + F.lane]), b2 = wave_sum(P.elam[128 + F.lane] * P.elam[192 + F.lane]);
                    const float lam_init = 0.8f - 0.6f * expf(-0.3f * (float)l);
                    const float lam = expf(a) - expf(b2) + lam_init;
                    const int nunits = isP ? 128 : 512;
                    if (isP) {
                        if (sj < 16) { att::even_unit(F.lds, HB, nullptr, nullptr, OB, P.esub, lam, 1.0f - lam_init, false, 2 * sx + (sj >> 3), (sj >> 1) & 3, sj & 1); }
                    }
                    else { const int w = F.vcu; for (int i = 0; i < 2; ++i) { const int su = w * 2 + i; const int bh = su >> 4; att::even_unit(F.lds, HB, (const bf16*)(ws + WS_CEK), (const bf16*)(ws + WS_CEV), OB, P.esub, lam, 1.0f - lam_init, true, bh >> 2, bh & 3, su & 15); } }
                    {   int pidx = F.vcu, pcount = F.G;
                        int ra = row0, rb = row1;
                        { if (isP) { ra = 512 * sx; rb = ra + 512; pidx = sj - 16; pcount = 16; }
                                          else { ra = row0 + 2048 * sx; if (sj < 16) { ra += sj * 40; rb = ra + 40; } else { ra += 640 + (sj - 16) * 88; rb = ra + 88; } pidx = 0; pcount = 1; } }
                        conv_rows(F, HB, P.econv, OB, ra, rb, pidx, pcount); }
                } else {
                    if (isP) {
                        {
                            const int bx = (int)blockIdx.x;
                            if (bx >= 128) for (int pu = (sj - 16) * 2; pu < (sj - 16) * 2 + 2; ++pu) att::odd_unit(F.lds, HB, nullptr, nullptr, OB, P.osink, false, 2 * sx + (pu >> 4), (pu >> 2) & 3, pu & 3);
                        }
                    }
                    else { const int w = F.vcu; for (int su = w * 4; su < w * 4 + 4; ++su) { const int bg = su >> 5; att::odd_unit(F.lds, HB, (const bf16*)(ws + WS_COK), (const bf16*)(ws + WS_COV), OB, P.osink, true, bg >> 2, bg & 3, su & 31); } }
                }
            }
            if (dec) dec_arrive(isP ? cntP : cntS);
        }
      }
        if (ph + 1 < ph_hi) { const bool decp = sliced && ph >= 2 && gbar.st[1] == 1u; if (!decp) { if (sliced && ph >= 1) xcd_barrier(gbar); else xcd_barrier(bar); } }
    }
}

extern "C" void kernel_launch(void* const* d_in, const int* in_sizes, int n_in, void* d_out, int out_size, void* d_ws, size_t ws_size, hipStream_t stream) {
    static int grid = 0;
    if (grid == 0) {
        if (n_in != 23 || in_sizes[0] != NPROMPT * DM || in_sizes[1] != NSAMPLE * DM || (size_t)out_size != OUT_TOTAL || ws_size < WS_END) {
            fprintf(stderr, "kernel_launch: shape mismatch: n_in %d in0 %d in1 %d out %d ws %zu (need %zu); nothing launched\n", n_in, n_in > 0 ? in_sizes[0] : -1, n_in > 1 ? in_sizes[1] : -1, out_size, ws_size, (size_t)WS_END); grid = -1; return; }
        int dev = 0, cus = 0, per_cu = 0;
        if (hipGetDevice(&dev) != hipSuccess || hipDeviceGetAttribute(&cus, hipDeviceAttributeMultiprocessorCount, dev) != hipSuccess) { fprintf(stderr, "kernel_launch: device query failed\n"); grid = -1; return; }
        if (hipFuncSetAttribute((const void*)mega_fwd, hipFuncAttributeMaxDynamicSharedMemorySize, LDS_BYTES) != hipSuccess) { fprintf(stderr, "kernel_launch: hipFuncSetAttribute failed\n"); grid = -1; return; }
        if (hipOccupancyMaxActiveBlocksPerMultiprocessor(&per_cu, (const void*)mega_fwd, NWAVES * 64, LDS_BYTES) != hipSuccess || per_cu < 1) { fprintf(stderr, "kernel_launch: occupancy query says %d blocks per CU; nothing launched\n", per_cu); (void)hipGetLastError(); grid = -1; return; }
        grid = cus;
        if (grid != 256) { fprintf(stderr, "kernel_launch: this kernel's work assignment is written for the 256 CUs of an MI355X (one workgroup each); found %d: nothing launched\n", grid); grid = -1; return; }
    }
    if (grid < 0) return;
    if (hipMemsetAsync((char*)d_ws + WS_CTL, 0, CTL_ZERO_BYTES, stream) != hipSuccess) { fprintf(stderr, "kernel_launch: memset failed\n"); return; }
    Args a{};
    for (int i = 0; i < 23; ++i) a.in[i] = (const float*)d_in[i];
    a.out = (float*)d_out; a.ws = (unsigned char*)d_ws;
#if MK_PER_PHASE
    for (int ph = 0; ph < N_PHASES; ++ph) { a.ph_lo = ph; a.ph_hi = ph + 1; hipLaunchKernelGGL(mega_fwd, dim3(grid), dim3(NWAVES * 64), LDS_BYTES, stream, a); }
#else
    a.ph_lo = 0; a.ph_hi = N_PHASES;
    hipLaunchKernelGGL(mega_fwd, dim3(grid), dim3(NWAVES * 64), LDS_BYTES, stream, a);
#endif
    const hipError_t le = hipPeekAtLastError();
    if (le != hipSuccess) fprintf(stderr, "kernel_launch: launch failed: %s\n", hipGetErrorName(le));
}
```
